# Optimizing an MI355X kernel written in HIP

```python
import jax, jax.numpy as jnp
from jax import lax
import numpy as np

D_MODEL = 1024
BATCH = 8
SEQ = 4096
DEPTH = 1

CHUNK = 64
PLE_DIM = 256
GMLP_BLOCK = 128
GMLP_GROUPS = 12
GMLP_GROUP_DIM = 128
GMLP_WIDTH = GMLP_GROUPS * GMLP_GROUP_DIM
MLA_HEADS = 8
QK_NOPE_DIM = 128
QK_ROPE_DIM = 64
V_HEAD_DIM = 128
Q_LORA = 384
KV_LORA = 256
ROPE_THETA = 10000.0
Q_BLOCK = 128
N_GROUPS = 8
EXPERTS_PER_GROUP = 8
N_EXPERTS = N_GROUPS * EXPERTS_PER_GROUP
TOPK = 2
D_EXPERT = 256
DISPATCH_BLOCK = 128
EPS = 1e-6
IN_COLS = 2 * GMLP_WIDTH + Q_LORA + KV_LORA + QK_ROPE_DIM + 2 * D_MODEL

kernel_name = "hybrid_gmlp_mla_hmoe_ple_block"


def rmsnorm(x, g):
    xf = x.astype(jnp.float32)
    xf = xf * lax.rsqrt(jnp.mean(xf * xf, axis=-1, keepdims=True) + EPS)
    return xf.astype(x.dtype) * g


def layernorm_gain(x, g):
    xf = x.astype(jnp.float32)
    mu = jnp.mean(xf, axis=-1, keepdims=True)
    xc = xf - mu
    xf = xc * lax.rsqrt(jnp.mean(xc * xc, axis=-1, keepdims=True) + EPS)
    return xf.astype(x.dtype) * g


def rope_tables(seq_len, dtype):
    inv_freq = ROPE_THETA ** (-jnp.arange(0, QK_ROPE_DIM, 2, dtype=jnp.float32) / QK_ROPE_DIM)
    ang = jnp.arange(seq_len, dtype=jnp.float32)[:, None] * inv_freq[None, :]
    return jnp.cos(ang).astype(dtype), jnp.sin(ang).astype(dtype)


def apply_rope(x, cos, sin):
    c = cos[None, :, None, :]
    s = sin[None, :, None, :]
    x1, x2 = jnp.split(x, 2, axis=-1)
    return jnp.concatenate([x1 * c - x2 * s, x1 * s + x2 * c], axis=-1)


def gmlp_branch(u, v, g_v, w_spatial, b_spatial, w_proj):
    B, S, _ = u.shape
    nb = S // GMLP_BLOCK
    v = layernorm_gain(v, g_v)
    vb = v.reshape(B, nb, GMLP_BLOCK, GMLP_GROUPS, GMLP_GROUP_DIM)
    t = jnp.arange(GMLP_BLOCK)
    mask = (t[None, :] // CHUNK) <= (t[:, None] // CHUNK)
    w = jnp.where(mask[None], w_spatial, jnp.zeros_like(w_spatial))
    sv = jnp.einsum('gts,bnsgc->bntgc', w, vb) + b_spatial.T[None, None, :, :, None]
    y = u * sv.reshape(B, S, GMLP_WIDTH)
    return y @ w_proj


def mla_branch(c_q, c_kv, k_rope, g_cq, w_uq, g_ckv, w_ukv, w_o):
    B, S, _ = c_q.shape
    H = MLA_HEADS
    cos, sin = rope_tables(S, c_q.dtype)
    q = (rmsnorm(c_q, g_cq) @ w_uq).reshape(B, S, H, QK_NOPE_DIM + QK_ROPE_DIM)
    q_nope, q_pe = jnp.split(q, [QK_NOPE_DIM], axis=-1)
    q = jnp.concatenate([q_nope, apply_rope(q_pe, cos, sin)], axis=-1)
    kv = (rmsnorm(c_kv, g_ckv) @ w_ukv).reshape(B, S, H, QK_NOPE_DIM + V_HEAD_DIM)
    k_nope, v = jnp.split(kv, [QK_NOPE_DIM], axis=-1)
    k_pe = apply_rope(k_rope[:, :, None, :], cos, sin)
    k = jnp.concatenate([k_nope, jnp.broadcast_to(k_pe, (B, S, H, QK_ROPE_DIM))], axis=-1)
    scale = (QK_NOPE_DIM + QK_ROPE_DIM) ** -0.5
    nq = S // Q_BLOCK
    kpos_chunk = jnp.arange(S) // CHUNK
    qb_all = q.reshape(B, nq, Q_BLOCK, H, QK_NOPE_DIM + QK_ROPE_DIM).transpose(1, 0, 2, 3, 4)

    def attend(args):
        qb, i = args
        qpos_chunk = (i * Q_BLOCK + jnp.arange(Q_BLOCK)) // CHUNK
        mask = kpos_chunk[None, :] <= qpos_chunk[:, None]
        s = jnp.einsum('bqhd,bkhd->bhqk', qb, k, preferred_element_type=jnp.float32) * scale
        s = jnp.where(mask[None, None], s, -jnp.inf)
        pr = jax.nn.softmax(s, axis=-1).astype(v.dtype)
        return jnp.einsum('bhqk,bkhv->bqhv', pr, v)

    o = lax.map(attend, (qb_all, jnp.arange(nq)))
    o = o.transpose(1, 0, 2, 3, 4).reshape(B, S, H * V_HEAD_DIM)
    return o @ w_o


def hierarchical_route(xf, w_rg, b_rg, w_re, b_re):
    N = xf.shape[0]
    g_logits = (xf @ w_rg).astype(jnp.float32)
    g_prob = jax.nn.softmax(g_logits, axis=-1)
    _, g_idx = lax.top_k(g_prob + b_rg[None, :].astype(jnp.float32), 1)
    g_w = jnp.take_along_axis(g_prob, g_idx, axis=-1)
    e_logits = (xf @ w_re).astype(jnp.float32).reshape(N, N_GROUPS, EXPERTS_PER_GROUP)
    e_logits = jnp.take_along_axis(e_logits, g_idx[:, :, None], axis=1)[:, 0]
    e_prob = jax.nn.softmax(e_logits, axis=-1)
    e_bias = b_re.astype(jnp.float32)[g_idx[:, 0]]
    _, e_local = lax.top_k(e_prob + e_bias, TOPK)
    e_sel = jnp.take_along_axis(e_prob, e_local, axis=-1)
    e_sel = e_sel / jnp.sum(e_sel, axis=-1, keepdims=True)
    weights = g_w * e_sel
    expert_ids = g_idx * EXPERTS_PER_GROUP + e_local
    return expert_ids, weights


def moe_dispatch(xf, expert_ids, weights, w_gate, w_up, w_down):
    N, D = xf.shape
    A = N * TOPK
    flat_e = expert_ids.reshape(-1)
    flat_t = jnp.repeat(jnp.arange(N), TOPK)
    flat_w = weights.reshape(-1)
    order = jnp.argsort(flat_e)
    se, st, sw = flat_e[order], flat_t[order], flat_w[order]
    counts = jnp.zeros((N_EXPERTS,), jnp.int32).at[flat_e].add(1)
    padded = (counts + DISPATCH_BLOCK - 1) // DISPATCH_BLOCK * DISPATCH_BLOCK
    pad_end = jnp.cumsum(padded)
    pad_start = pad_end - padded
    start = jnp.cumsum(counts) - counts
    dest = pad_start[se] + jnp.arange(A) - start[se]
    P = A + N_EXPERTS * DISPATCH_BLOCK
    nblk = P // DISPATCH_BLOCK
    buf = jnp.zeros((P, D), xf.dtype).at[dest].set(xf[st])
    blk_e = jnp.minimum(jnp.searchsorted(pad_end, jnp.arange(nblk) * DISPATCH_BLOCK, side='right'), N_EXPERTS - 1)

    def expert_block(args):
        xb, e = args
        hdn = jax.nn.silu(xb @ w_gate[e]) * (xb @ w_up[e])
        return hdn @ w_down[e]

    ys = lax.map(expert_block, (buf.reshape(nblk, DISPATCH_BLOCK, D), blk_e)).reshape(P, D)
    return jnp.zeros_like(xf).at[st].add(ys[dest] * sw[:, None].astype(ys.dtype))


def setup_inputs(seed: int = 0) -> dict:
    key = jax.random.key(seed)
    ks = jax.random.split(key, 32)
    f32 = jnp.float32

    def nrm(k, shape, fan_in):
        return jax.random.normal(k, shape, f32) * (fan_in ** -0.5)

    def gain(k, shape):
        return 1.0 + 0.05 * jax.random.normal(k, shape, f32)

    L = DEPTH
    return {
        "x": jax.random.normal(ks[0], (BATCH, SEQ, D_MODEL), f32),
        "p": jax.random.normal(ks[1], (DEPTH, BATCH, SEQ, PLE_DIM), f32),
        "g_mix": gain(ks[2], (L, D_MODEL)),
        "w_in": nrm(ks[3], (L, D_MODEL, IN_COLS), D_MODEL),
        "g_gv": gain(ks[4], (L, GMLP_WIDTH)),
        "w_spatial": nrm(ks[5], (L, GMLP_GROUPS, GMLP_BLOCK, GMLP_BLOCK), GMLP_BLOCK),
        "b_spatial": 1.0 + 0.1 * jax.random.normal(ks[6], (L, GMLP_GROUPS, GMLP_BLOCK), f32),
        "w_gproj": nrm(ks[7], (L, GMLP_WIDTH, D_MODEL), GMLP_WIDTH),
        "g_cq": gain(ks[8], (L, Q_LORA)),
        "w_uq": nrm(ks[9], (L, Q_LORA, MLA_HEADS * (QK_NOPE_DIM + QK_ROPE_DIM)), Q_LORA),
        "g_ckv": gain(ks[10], (L, KV_LORA)),
        "w_ukv": nrm(ks[11], (L, KV_LORA, MLA_HEADS * (QK_NOPE_DIM + V_HEAD_DIM)), KV_LORA),
        "w_mla_o": nrm(ks[12], (L, MLA_HEADS * V_HEAD_DIM, D_MODEL), MLA_HEADS * V_HEAD_DIM),
        "w_out": nrm(ks[13], (L, D_MODEL, D_MODEL), D_MODEL),
        "g_moe": gain(ks[14], (L, D_MODEL)),
        "w_router_g": nrm(ks[15], (L, D_MODEL, N_GROUPS), D_MODEL),
        "b_router_g": 0.01 * jax.random.normal(ks[16], (L, N_GROUPS), f32),
        "w_router_e": nrm(ks[17], (L, D_MODEL, N_EXPERTS), D_MODEL),
        "b_router_e": 0.01 * jax.random.normal(ks[18], (L, N_GROUPS, EXPERTS_PER_GROUP), f32),
        "w_e_gate": nrm(ks[19], (L, N_EXPERTS, D_MODEL, D_EXPERT), D_MODEL),
        "w_e_up": nrm(ks[20], (L, N_EXPERTS, D_MODEL, D_EXPERT), D_MODEL),
        "w_e_down": nrm(ks[21], (L, N_EXPERTS, D_EXPERT, D_MODEL), D_EXPERT),
        "g_ple": gain(ks[22], (L, D_MODEL)),
        "w_ple_gate": nrm(ks[23], (L, D_MODEL, D_MODEL), D_MODEL),
        "w_ple_proj": nrm(ks[24], (L, PLE_DIM, D_MODEL), PLE_DIM),
        "g_final": gain(ks[25], (D_MODEL,)),
    }


def reference(x, p, g_mix, w_in, g_gv, w_spatial, b_spatial, w_gproj, g_cq, w_uq, g_ckv, w_ukv,
              w_mla_o, w_out, g_moe, w_router_g, b_router_g, w_router_e, b_router_e,
              w_e_gate, w_e_up, w_e_down, g_ple, w_ple_gate, w_ple_proj, g_final):
    B, S, D = x.shape
    cuts = [GMLP_WIDTH, 2 * GMLP_WIDTH, 2 * GMLP_WIDTH + Q_LORA, 2 * GMLP_WIDTH + Q_LORA + KV_LORA,
            2 * GMLP_WIDTH + Q_LORA + KV_LORA + QK_ROPE_DIM,
            2 * GMLP_WIDTH + Q_LORA + KV_LORA + QK_ROPE_DIM + D_MODEL]
    h = x
    for i in range(DEPTH):
        a = rmsnorm(h, g_mix[i])
        z = a @ w_in[i]
        z_u, z_v, c_q, c_kv, k_rope, gate_a, gate_b = jnp.split(z, cuts, axis=-1)
        y_a = gmlp_branch(jax.nn.gelu(z_u), jax.nn.gelu(z_v), g_gv[i], w_spatial[i], b_spatial[i], w_gproj[i])
        y_b = mla_branch(c_q, c_kv, k_rope, g_cq[i], w_uq[i], g_ckv[i], w_ukv[i], w_mla_o[i])
        merged = jax.nn.sigmoid(gate_a) * y_a + jax.nn.sigmoid(gate_b) * y_b
        h = h + merged @ w_out[i]
        m = rmsnorm(h, g_moe[i]).reshape(B * S, D)
        ids, wts = hierarchical_route(m, w_router_g[i], b_router_g[i], w_router_e[i], b_router_e[i])
        h = h + moe_dispatch(m, ids, wts, w_e_gate[i], w_e_up[i], w_e_down[i]).reshape(B, S, D)
        n3 = rmsnorm(h, g_ple[i])
        h = h + jax.nn.sigmoid(n3 @ w_ple_gate[i]) * (p[i] @ w_ple_proj[i])
    return rmsnorm(h, g_final)
```

```cpp
#include <hip/hip_runtime.h>
#include <hip/hip_cooperative_groups.h>
#include <cstdio>
#include <cstdint>
namespace cg = cooperative_groups;

#ifndef MK_N_LAUNCHES
#define MK_N_LAUNCHES 0
#endif

#define LAS __attribute__((address_space(3)))
typedef unsigned short bf16_t;
typedef short bf16x8 __attribute__((ext_vector_type(8)));
typedef short s16x4 __attribute__((ext_vector_type(4)));
typedef float f32x4 __attribute__((ext_vector_type(4)));
typedef float f32x2 __attribute__((ext_vector_type(2)));
typedef float f32x16 __attribute__((ext_vector_type(16)));
typedef unsigned u32x4 __attribute__((ext_vector_type(4)));
typedef unsigned u32x2 __attribute__((ext_vector_type(2)));

constexpr int NB = 8, NS = 4096, DM = 1024, MROWS = NB * NS;
constexpr int GWID = 1536, QL = 384, KVL = 256, RD = 64, NH = 8, PLE = 256;
constexpr int ZN = 5888;
constexpr int SEG_V = 1536, SEG_GA = 3072, SEG_GB = 4096, SEG_CQ = 5120, SEG_CKV = 5504, SEG_KR = 5760, SEG_PAD = 5824;
constexpr int NEXP = 64, DEXP = 256;
constexpr int MAXSLOT = 2 * MROWS + NEXP * 256;
constexpr float EPS = 1e-6f;

constexpr size_t MiB = 1u << 20;
constexpr size_t WS_CTL = 0;
constexpr size_t WS_CHUNKCNT = 64 * 1024;
constexpr size_t WS_TOKINFO = 128 * 1024;
constexpr size_t WS_ROWTOK = 1 * MiB;
constexpr size_t WS_ROWW = 1 * MiB + 512 * 1024;
constexpr size_t WS_ROPEC = 2 * MiB, WS_ROPES = 3 * MiB;
constexpr size_t WS_WIN = 4 * MiB;
constexpr size_t WS_WGP = 16 * MiB;
constexpr size_t WS_WUQ = 19 * MiB;
constexpr size_t WS_WUKV = 20 * MiB + 512 * 1024;
constexpr size_t WS_WO = 21 * MiB + 512 * 1024;
constexpr size_t WS_WOUT = 23 * MiB + 512 * 1024;
constexpr size_t WS_WR = 25 * MiB + 512 * 1024;
constexpr size_t WS_WPG = 26 * MiB;
constexpr size_t WS_WPP = 28 * MiB;
constexpr size_t WS_WSP = 28 * MiB + 512 * 1024;
constexpr size_t WS_PB = 29 * MiB;
constexpr size_t WS_VPART = 45 * MiB;
constexpr size_t WS_CQPART = 57 * MiB;
constexpr size_t WS_CKVPART = 58 * MiB + 512 * 1024;
constexpr size_t WS_RSTD3 = 63 * MiB + 512 * 1024;
constexpr size_t WS_U = 64 * MiB, WS_V = 160 * MiB, WS_GA = 256 * MiB, WS_GB = 320 * MiB, WS_CQ = 384 * MiB, WS_CKV = 408 * MiB, WS_KPE = 424 * MiB;
constexpr size_t WS_QN = 64 * MiB, WS_KN = 128 * MiB, WS_VV = 192 * MiB, WS_QR = 428 * MiB;
constexpr size_t WS_MB = 64 * MiB, WS_WGU = 128 * MiB, WS_WD = 192 * MiB, WS_LOG = 224 * MiB;
constexpr size_t WS_HID = 256 * MiB, WS_YS = 320 * MiB, WS_H2B = 64 * MiB, WS_PP = 128 * MiB;
constexpr size_t WS_END = 512 * MiB;

__device__ __forceinline__ unsigned cvtpk(float lo, float hi) { unsigned r; asm volatile("v_cvt_pk_bf16_f32 %0, %1, %2" : "=v"(r) : "v"(lo), "v"(hi)); return r; }
__device__ __forceinline__ float bflo(unsigned w) { return __uint_as_float(w << 16); }
__device__ __forceinline__ float bfhi(unsigned w) { return __uint_as_float(w & 0xffff0000u); }
__device__ __forceinline__ float bf2f(bf16_t b) { return __uint_as_float(((unsigned)b) << 16); }
__device__ __forceinline__ u32x4 pack8u(f32x4 a, f32x4 b) { u32x4 w = {cvtpk(a[0], a[1]), cvtpk(a[2], a[3]), cvtpk(b[0], b[1]), cvtpk(b[2], b[3])}; return w; }
__device__ __forceinline__ bf16x8 pack8(f32x4 a, f32x4 b) { u32x4 w = pack8u(a, b); return *reinterpret_cast<bf16x8*>(&w); }
__device__ __forceinline__ void unpack8(u32x4 w, f32x4& a, f32x4& b) { a = (f32x4){bflo(w.x), bfhi(w.x), bflo(w.y), bfhi(w.y)}; b = (f32x4){bflo(w.z), bfhi(w.z), bflo(w.w), bfhi(w.w)}; }
__device__ __forceinline__ float fsigmoid(float x) { return __builtin_amdgcn_rcpf(1.f + __builtin_amdgcn_exp2f(-1.4426950408889634f * x)); }
__device__ __forceinline__ float gelu_tanh(float x) { const float u = x * (1.f + 0.044715f * x * x); return x * fsigmoid(1.5957691216057308f * u); }
__device__ __forceinline__ float wave_sum(float v) {
#pragma unroll
    for (int o = 1; o < 64; o <<= 1) v += __shfl_xor(v, o);
    return v;
}
__device__ __forceinline__ float quad_sum(float v) { v += __shfl_xor(v, 16); v += __shfl_xor(v, 32); return v; }

namespace pg8 {
constexpr int BM = 256, BK = 64, HALF = 128, HTB = HALF * BK * 2, STAGE_BYTES = 8 * HTB, NXCD = 8, WGM = 8;
__host__ __device__ __forceinline__ int lds_byte(int r, int c) { const int st = (r >> 4) * 2 + (c >> 5), rr = r & 15, cc = c & 31, ob = rr * 64 + cc * 2; return st * 1024 + (ob ^ (((ob >> 9) & 1) << 5)); }
__host__ __device__ __forceinline__ void stage_rc(int b, int& R, int& C) { const int st = b / 1024, sb = b % 1024, swz = sb ^ (((sb >> 9) & 1) << 5); R = (st >> 1) * 16 + swz / 64; C = (st & 1) * 32 + (swz % 64) / 2; }
__host__ __device__ __forceinline__ int perm32(int rho) { const int n = rho >> 4, i = rho & 15; return 8 * (i >> 2) + 4 * n + (i & 3); }

struct Unit { int pm, pn, ex; };

struct SchedDense {
    const bf16_t* A; const bf16_t* Bt; int K; int nM, nN, nwg, G, c;
    __device__ void init(const bf16_t* A_, const bf16_t* Bt_, int M, int N, int K_, int G_, int c_) { A = A_; Bt = Bt_; K = K_; nM = M / BM; nN = N / BM; nwg = nM * nN; G = G_; c = c_; }
    __device__ __forceinline__ bool next(int i, Unit& u) const {
        const long L = (long)i * G + c; if (L >= nwg) return false;
        int wgid = (int)L; { const int q = nwg / NXCD, r = nwg % NXCD, xcd = wgid % NXCD, off = wgid / NXCD; wgid = (xcd < r ? xcd * (q + 1) : r * (q + 1) + (xcd - r) * q) + off; }
        const int nig = WGM * nN, gid = wgid / nig, fm = gid * WGM, gsz = (nM - fm) < WGM ? (nM - fm) : WGM;
        u.pm = fm + ((wgid % nig) % gsz); u.pn = (wgid % nig) / gsz; u.ex = 0; return true;
    }
    __device__ __forceinline__ const char* a_ptr(const Unit& u) const { return (const char*)A + (size_t)u.pm * BM * K * 2; }
    __device__ __forceinline__ const char* b_ptr(const Unit& u) const { return (const char*)Bt + (size_t)u.pn * BM * K * 2; }
    __device__ __forceinline__ void a_off(const Unit&, const int (&R)[2], const int (&C)[2], unsigned (&vo)[2][2]) const {
#pragma unroll
        for (int h = 0; h < 2; ++h)
#pragma unroll
            for (int i = 0; i < 2; ++i) vo[h][i] = (unsigned)((h * HALF + R[i]) * K + C[i]) * 2u;
    }
};
struct SchedGU {
    const bf16_t* A; const int* rowtok; const bf16_t* Bt; const int* tile_e; int ntiles; int G, c;
    __device__ __forceinline__ bool next(int i, Unit& u) const {
        const int L = i * G + c; if (L >= ntiles * 2) return false;
        u.pm = L >> 1; u.pn = L & 1; u.ex = tile_e[u.pm]; return true;
    }
    __device__ __forceinline__ const char* a_ptr(const Unit&) const { return (const char*)A; }
    __device__ __forceinline__ const char* b_ptr(const Unit& u) const { return (const char*)Bt + ((size_t)u.ex * 512 + (size_t)u.pn * 256) * DM * 2; }
    __device__ __forceinline__ void a_off(const Unit& u, const int (&R)[2], const int (&C)[2], unsigned (&vo)[2][2]) const {
#pragma unroll
        for (int h = 0; h < 2; ++h)
#pragma unroll
            for (int i = 0; i < 2; ++i) { const int t = rowtok[u.pm * BM + h * HALF + R[i]]; const int tok = t < 0 ? 0 : (t >> 1); vo[h][i] = (unsigned)(tok * DM + C[i]) * 2u; }
    }
};
struct SchedDown {
    const bf16_t* A; const bf16_t* Bt; const int* tile_e; int ntiles; int G, c;
    __device__ __forceinline__ bool next(int i, Unit& u) const {
        const int L = i * G + c; if (L >= ntiles * 4) return false;
        u.pm = L >> 2; u.pn = L & 3; u.ex = tile_e[u.pm]; return true;
    }
    __device__ __forceinline__ const char* a_ptr(const Unit& u) const { return (const char*)A + (size_t)u.pm * BM * DEXP * 2; }
    __device__ __forceinline__ const char* b_ptr(const Unit& u) const { return (const char*)Bt + ((size_t)u.ex * DM + (size_t)u.pn * 256) * DEXP * 2; }
    __device__ __forceinline__ void a_off(const Unit&, const int (&R)[2], const int (&C)[2], unsigned (&vo)[2][2]) const {
#pragma unroll
        for (int h = 0; h < 2; ++h)
#pragma unroll
            for (int i = 0; i < 2; ++i) vo[h][i] = (unsigned)((h * HALF + R[i]) * DEXP + C[i]) * 2u;
    }
};

template <class Epi, class Sched>
__device__ __forceinline__ void gemm_phase(LAS unsigned char* lds, const int K_, const Sched& S, const Epi& E) {
    int tid = threadIdx.x; asm volatile("" : "+v"(tid));
    int K = K_; asm volatile("" : "+s"(K));
    const int wid = __builtin_amdgcn_readfirstlane(tid >> 6), lane = tid & 63, wr = wid >> 2, wc = wid & 3, fr = lane & 15, fq = lane >> 4;
    const int nt = K / BK;
    int RA[2], CA[2]; unsigned voffB[2];
#pragma unroll
    for (int i = 0; i < 2; ++i) { int R, C; stage_rc(tid * 16 + i * 8192, R, C); const int Rb = Epi::PERM ? ((R & ~31) + perm32(R & 31)) : R;
        RA[i] = R; CA[i] = C; voffB[i] = (unsigned)(Rb * K + C) * 2u; }
    const size_t kstep = (size_t)(BK * 2);
    const size_t hstep = (size_t)HALF * K * 2;
    const unsigned ldsw = (unsigned)wid * 1024u;
    const int aoff = lds_byte(wr * 64 + fr, fq * 8), boff = lds_byte(wc * 32 + fr, fq * 8);
#define PG8_SA(b, h) (((b) * 2 + (h)) * HTB)
#define PG8_SB(b, h) ((4 + (b) * 2 + (h)) * HTB)
#define PG8_STAGE(bufoff, gbase, voff) do { _Pragma("unroll") for (int _i = 0; _i < 2; ++_i) \
        __builtin_amdgcn_global_load_lds((const unsigned*)((const char*)(gbase) + (voff)[_i]), (LAS unsigned*)(lds + (bufoff) + ldsw + _i * 8192), 16, 0, 0); } while (0)
#define PG8_LDA(dst, b, h) do { _Pragma("unroll") for (int m = 0; m < 4; ++m) _Pragma("unroll") for (int k = 0; k < 2; ++k) dst[m][k] = *(const LAS bf16x8*)(lds + PG8_SA(b, h) + aoff + m * 2048 + k * 1024); } while (0)
#define PG8_LDB(dst, b, h) do { _Pragma("unroll") for (int n = 0; n < 2; ++n) _Pragma("unroll") for (int k = 0; k < 2; ++k) dst[n][k] = *(const LAS bf16x8*)(lds + PG8_SB(b, h) + boff + n * 2048 + k * 1024); } while (0)
#define PG8_MMA(ai, bj, At, Bt) do { __builtin_amdgcn_s_setprio(1); _Pragma("unroll") for (int m = 0; m < 4; ++m) _Pragma("unroll") for (int n = 0; n < 2; ++n) _Pragma("unroll") for (int k = 0; k < 2; ++k) \
        acc[ai][bj][m][n] = __builtin_amdgcn_mfma_f32_16x16x32_bf16(Bt[n][k], At[m][k], acc[ai][bj][m][n], 0, 0, 0); __builtin_amdgcn_s_setprio(0); } while (0)
#define PG8_WAIT_V(n) asm volatile("s_waitcnt vmcnt(" #n ")" ::: "memory")
#define PG8_WAIT_L(n) asm volatile("s_waitcnt lgkmcnt(" #n ")" ::: "memory")
#define PG8_BAR __builtin_amdgcn_s_barrier()
#define PG8_SCHED __builtin_amdgcn_sched_barrier(0)
    Unit cur, nxt; int ui = 0;
    if (!S.next(0, cur)) return;
    f32x4 acc[2][2][4][2];
#pragma unroll
    for (int a = 0; a < 2; ++a)
#pragma unroll
        for (int b = 0; b < 2; ++b)
#pragma unroll
            for (int m = 0; m < 4; ++m)
#pragma unroll
                for (int n = 0; n < 2; ++n) acc[a][b][m][n] = (f32x4){0.f, 0.f, 0.f, 0.f};
    bf16x8 At[4][2], B0[2][2], B1[2][2];
    unsigned voC[2][2], voN[2][2];
    const char* cA = S.a_ptr(cur); const char* cB = S.b_ptr(cur);
    S.a_off(cur, RA, CA, voC);
    PG8_STAGE(PG8_SB(0, 0), cB, voffB); PG8_STAGE(PG8_SA(0, 0), cA, voC[0]); PG8_STAGE(PG8_SB(0, 1), cB + hstep, voffB); PG8_STAGE(PG8_SA(0, 1), cA, voC[1]);
    if (wr == 1) PG8_BAR;
    PG8_WAIT_V(4); PG8_BAR;
    PG8_STAGE(PG8_SB(1, 0), cB + kstep, voffB); PG8_STAGE(PG8_SA(1, 0), cA + kstep, voC[0]); PG8_STAGE(PG8_SB(1, 1), cB + hstep + kstep, voffB);
    PG8_WAIT_V(6); PG8_BAR;
    for (;;) {
        const bool has_next = S.next(ui + 1, nxt);
        const char* nA = has_next ? S.a_ptr(nxt) : cA; const char* nB = has_next ? S.b_ptr(nxt) : cB;
        if (has_next) S.a_off(nxt, RA, CA, voN);
        else {
#pragma unroll
            for (int h = 0; h < 2; ++h)
#pragma unroll
                for (int i = 0; i < 2; ++i) voN[h][i] = voC[h][i]; }
#pragma nounroll
        for (int t = 0; t < nt; t += 2) {
            const bool last = (t == nt - 2);
            const char* a1 = cA + (size_t)(t + 1) * kstep;
            const char* a2 = last ? nA : cA + (size_t)(t + 2) * kstep; const char* b2 = last ? nB : cB + (size_t)(t + 2) * kstep;
            const char* a3 = a2 + kstep; const char* b3 = b2 + kstep;
            unsigned v2[2][2];
#pragma unroll
            for (int h = 0; h < 2; ++h)
#pragma unroll
                for (int i = 0; i < 2; ++i) v2[h][i] = last ? voN[h][i] : voC[h][i];
            PG8_LDB(B0, 0, 0); PG8_SCHED; PG8_LDA(At, 0, 0); PG8_STAGE(PG8_SA(1, 1), a1, voC[1]);
            PG8_WAIT_L(8); PG8_BAR; PG8_WAIT_L(0); PG8_MMA(0, 0, At, B0); PG8_BAR; PG8_SCHED;
            PG8_LDB(B1, 0, 1); PG8_STAGE(PG8_SB(0, 0), b2, voffB);
            PG8_BAR; PG8_WAIT_L(0); PG8_MMA(0, 1, At, B1); PG8_BAR;
            PG8_LDA(At, 0, 1); PG8_STAGE(PG8_SA(0, 0), a2, v2[0]);
            PG8_BAR; PG8_WAIT_L(0); PG8_MMA(1, 0, At, B0); PG8_BAR; PG8_SCHED;
            PG8_STAGE(PG8_SB(0, 1), b2 + hstep, voffB);
            PG8_WAIT_V(6); PG8_BAR; PG8_MMA(1, 1, At, B1); PG8_BAR;
            PG8_LDB(B0, 1, 0); PG8_SCHED; PG8_LDA(At, 1, 0); PG8_STAGE(PG8_SA(0, 1), a2, v2[1]);
            PG8_WAIT_L(8); PG8_BAR; PG8_WAIT_L(0); PG8_MMA(0, 0, At, B0); PG8_BAR; PG8_SCHED;
            PG8_LDB(B1, 1, 1); PG8_STAGE(PG8_SB(1, 0), b3, voffB);
            PG8_BAR; PG8_WAIT_L(0); PG8_MMA(0, 1, At, B1); PG8_BAR;
            PG8_LDA(At, 1, 1); PG8_STAGE(PG8_SA(1, 0), a3, v2[0]);
            PG8_BAR; PG8_WAIT_L(0); PG8_MMA(1, 0, At, B0); PG8_BAR; PG8_SCHED;
            PG8_STAGE(PG8_SB(1, 1), b3 + hstep, voffB);
            PG8_WAIT_V(6); PG8_BAR; PG8_MMA(1, 1, At, B1); PG8_BAR;
        }
        E(acc, cur, wr, wc, fr, fq);
        if (!has_next) break;
#pragma unroll
        for (int a = 0; a < 2; ++a)
#pragma unroll
            for (int b = 0; b < 2; ++b)
#pragma unroll
                for (int m = 0; m < 4; ++m)
#pragma unroll
                    for (int n = 0; n < 2; ++n) acc[a][b][m][n] = (f32x4){0.f, 0.f, 0.f, 0.f};
        cur = nxt; cA = nA; cB = nB; ++ui;
#pragma unroll
        for (int h = 0; h < 2; ++h)
#pragma unroll
            for (int i = 0; i < 2; ++i) voC[h][i] = voN[h][i];
    }
    PG8_WAIT_V(0);
    if (wr == 0) PG8_BAR;
    PG8_BAR;
#undef PG8_SA
#undef PG8_SB
#undef PG8_STAGE
#undef PG8_LDA
#undef PG8_LDB
#undef PG8_MMA
#undef PG8_WAIT_V
#undef PG8_WAIT_L
#undef PG8_BAR
#undef PG8_SCHED
}

typedef f32x4 Acc[2][2][4][2];
#define EPI_ROW(u, ai, wr, m, fr) ((u).pm * 256 + (ai) * 128 + (wr) * 64 + (m) * 16 + (fr))

struct EpiZ {
    static constexpr bool PERM = true;
    bf16_t *U, *V, *GA, *GB, *CQ, *CKV, *KPE; float *vpart, *cqpart, *ckvpart; const float *ropeC, *ropeS;
    __device__ __forceinline__ void operator()(const Acc& acc, const Unit& u, int wr, int wc, int fr, int fq) const {
#pragma unroll
        for (int bj = 0; bj < 2; ++bj) {
            const int cb = u.pn * 256 + bj * 128 + wc * 32;
            const int c0 = cb + 8 * fq;
            if (cb >= SEG_PAD) continue;
#pragma unroll
            for (int ai = 0; ai < 2; ++ai)
#pragma unroll
                for (int m = 0; m < 4; ++m) {
                    const int row = EPI_ROW(u, ai, wr, m, fr);
                    f32x4 v0 = acc[ai][bj][m][0], v1 = acc[ai][bj][m][1];
                    if (cb < SEG_GA) {
#pragma unroll
                        for (int j = 0; j < 4; ++j) { v0[j] = gelu_tanh(v0[j]); v1[j] = gelu_tanh(v1[j]); }
                        if (cb < SEG_V) { *(u32x4*)(U + (size_t)row * GWID + c0) = pack8u(v0, v1); }
                        else {
                            *(u32x4*)(V + (size_t)row * GWID + (c0 - SEG_V)) = pack8u(v0, v1);
                            float s = (v0[0] + v0[1]) + (v0[2] + v0[3]) + (v1[0] + v1[1]) + (v1[2] + v1[3]);
                            float q = (v0[0] * v0[0] + v0[1] * v0[1]) + (v0[2] * v0[2] + v0[3] * v0[3]) + (v1[0] * v1[0] + v1[1] * v1[1]) + (v1[2] * v1[2] + v1[3] * v1[3]);
                            s = quad_sum(s); q = quad_sum(q);
                            if (fq == 0) *(f32x2*)(vpart + ((size_t)row * 48 + ((cb - SEG_V) >> 5)) * 2) = (f32x2){s, q};
                        }
                    } else if (cb < SEG_CQ) {
#pragma unroll
                        for (int j = 0; j < 4; ++j) { v0[j] = fsigmoid(v0[j]); v1[j] = fsigmoid(v1[j]); }
                        if (cb < SEG_GB) *(u32x4*)(GA + (size_t)row * DM + (c0 - SEG_GA)) = pack8u(v0, v1);
                        else *(u32x4*)(GB + (size_t)row * DM + (c0 - SEG_GB)) = pack8u(v0, v1);
                    } else if (cb < SEG_KR) {
                        float q = (v0[0] * v0[0] + v0[1] * v0[1]) + (v0[2] * v0[2] + v0[3] * v0[3]) + (v1[0] * v1[0] + v1[1] * v1[1]) + (v1[2] * v1[2] + v1[3] * v1[3]);
                        q = quad_sum(q);
                        if (cb < SEG_CKV) { *(u32x4*)(CQ + (size_t)row * QL + (c0 - SEG_CQ)) = pack8u(v0, v1); if (fq == 0) cqpart[(size_t)row * 12 + ((cb - SEG_CQ) >> 5)] = q; }
                        else { *(u32x4*)(CKV + (size_t)row * KVL + (c0 - SEG_CKV)) = pack8u(v0, v1); if (fq == 0) ckvpart[(size_t)row * 8 + ((cb - SEG_CKV) >> 5)] = q; }
                    } else {
                        const int s = row & (NS - 1), j0 = (c0 - SEG_KR) >> 1;
                        const f32x4 cs = *(const f32x4*)(ropeC + s * 32 + j0), sn = *(const f32x4*)(ropeS + s * 32 + j0);
                        f32x4 o0, o1;
                        o0[0] = v0[0] * cs[0] - v0[1] * sn[0]; o0[1] = v0[0] * sn[0] + v0[1] * cs[0];
                        o0[2] = v0[2] * cs[1] - v0[3] * sn[1]; o0[3] = v0[2] * sn[1] + v0[3] * cs[1];
                        o1[0] = v1[0] * cs[2] - v1[1] * sn[2]; o1[1] = v1[0] * sn[2] + v1[1] * cs[2];
                        o1[2] = v1[2] * cs[3] - v1[3] * sn[3]; o1[3] = v1[2] * sn[3] + v1[3] * cs[3];
                        *(u32x4*)(KPE + (size_t)row * RD + (c0 - SEG_KR)) = pack8u(o0, o1);
                    }
                }
        }
    }
};
struct EpiMul {
    static constexpr bool PERM = true;
    bf16_t* G;
    __device__ __forceinline__ void operator()(const Acc& acc, const Unit& u, int wr, int wc, int fr, int fq) const {
#pragma unroll
        for (int ai = 0; ai < 2; ++ai)
#pragma unroll
            for (int m = 0; m < 4; ++m) {
                const int row = EPI_ROW(u, ai, wr, m, fr);
#pragma unroll
                for (int bj = 0; bj < 2; ++bj) {
                    u32x4* p = (u32x4*)(G + (size_t)row * DM + u.pn * 256 + bj * 128 + wc * 32 + 8 * fq);
                    f32x4 g0, g1; unpack8(*p, g0, g1);
                    *p = pack8u(g0 * acc[ai][bj][m][0], g1 * acc[ai][bj][m][1]);
                }
                asm volatile("" ::: "memory");
            }
    }
};
struct EpiMulAdd {
    static constexpr bool PERM = true;
    bf16_t* MA; const bf16_t* GB;
    __device__ __forceinline__ void operator()(const Acc& acc, const Unit& u, int wr, int wc, int fr, int fq) const {
#pragma unroll
        for (int ai = 0; ai < 2; ++ai)
#pragma unroll
            for (int m = 0; m < 4; ++m) {
                const int row = EPI_ROW(u, ai, wr, m, fr);
#pragma unroll
                for (int bj = 0; bj < 2; ++bj) {
                    const size_t off = (size_t)row * DM + u.pn * 256 + bj * 128 + wc * 32 + 8 * fq;
                    u32x4* p = (u32x4*)(MA + off);
                    f32x4 a0, a1, g0, g1; unpack8(*p, a0, a1); unpack8(*(const u32x4*)(GB + off), g0, g1);
                    *p = pack8u(a0 + g0 * acc[ai][bj][m][0], a1 + g1 * acc[ai][bj][m][1]);
                }
                asm volatile("" ::: "memory");
            }
    }
};
struct EpiRes {
    static constexpr bool PERM = false;
    const float* X; float* H;
    __device__ __forceinline__ void operator()(const Acc& acc, const Unit& u, int wr, int wc, int fr, int fq) const {
#pragma unroll
        for (int ai = 0; ai < 2; ++ai)
#pragma unroll
            for (int m = 0; m < 4; ++m) {
                const int row = EPI_ROW(u, ai, wr, m, fr);
#pragma unroll
                for (int bj = 0; bj < 2; ++bj)
#pragma unroll
                    for (int n = 0; n < 2; ++n) {
                        const size_t off = (size_t)row * DM + u.pn * 256 + bj * 128 + wc * 32 + 16 * n + 4 * fq;
                        *(f32x4*)(H + off) = *(const f32x4*)(X + off) + acc[ai][bj][m][n];
                    }
                asm volatile("" ::: "memory");
            }
    }
};
struct EpiQ {
    static constexpr bool PERM = true;
    bf16_t *QN, *QR; const float* cqpart; const float *ropeC, *ropeS;
    __device__ __forceinline__ void operator()(const Acc& acc, const Unit& u, int wr, int wc, int fr, int fq) const {
#pragma unroll
        for (int ai = 0; ai < 2; ++ai)
#pragma unroll
            for (int m = 0; m < 4; ++m) {
                const int row = EPI_ROW(u, ai, wr, m, fr);
                const f32x4* pp = (const f32x4*)(cqpart + (size_t)row * 12);
                const f32x4 p0 = pp[0], p1 = pp[1], p2 = pp[2];
                const float ss = ((p0[0] + p0[1]) + (p0[2] + p0[3])) + ((p1[0] + p1[1]) + (p1[2] + p1[3])) + ((p2[0] + p2[1]) + (p2[2] + p2[3]));
                const float rstd = __builtin_amdgcn_rsqf(ss * (1.f / QL) + EPS);
                const int b = row >> 12, s = row & (NS - 1);
#pragma unroll
                for (int bj = 0; bj < 2; ++bj) {
                    const int c0 = u.pn * 256 + bj * 128 + wc * 32 + 8 * fq;
                    f32x4 v0 = acc[ai][bj][m][0] * rstd, v1 = acc[ai][bj][m][1] * rstd;
                    if (u.pn < 4) {
                        const int h = c0 >> 7, d = c0 & 127;
                        *(u32x4*)(QN + (((size_t)(b * NH + h)) * NS + s) * 128 + d) = pack8u(v0, v1);
                    } else {
                        const int cc = c0 - 1024, h = cc >> 6, i0 = cc & 63, j0 = i0 >> 1;
                        const f32x4 cs = *(const f32x4*)(ropeC + s * 32 + j0), sn = *(const f32x4*)(ropeS + s * 32 + j0);
                        f32x4 o0, o1;
                        o0[0] = v0[0] * cs[0] - v0[1] * sn[0]; o0[1] = v0[0] * sn[0] + v0[1] * cs[0];
                        o0[2] = v0[2] * cs[1] - v0[3] * sn[1]; o0[3] = v0[2] * sn[1] + v0[3] * cs[1];
                        o1[0] = v1[0] * cs[2] - v1[1] * sn[2]; o1[1] = v1[0] * sn[2] + v1[1] * cs[2];
                        o1[2] = v1[2] * cs[3] - v1[3] * sn[3]; o1[3] = v1[2] * sn[3] + v1[3] * cs[3];
                        *(u32x4*)(QR + (((size_t)(b * NH + h)) * NS + s) * RD + i0) = pack8u(o0, o1);
                    }
                }
                asm volatile("" ::: "memory");
            }
    }
};
struct EpiKV {
    static constexpr bool PERM = true;
    bf16_t *KN, *VV; const float* ckvpart;
    __device__ __forceinline__ void operator()(const Acc& acc, const Unit& u, int wr, int wc, int fr, int fq) const {
#pragma unroll
        for (int ai = 0; ai < 2; ++ai)
#pragma unroll
            for (int m = 0; m < 4; ++m) {
                const int row = EPI_ROW(u, ai, wr, m, fr);
                const f32x4* pp = (const f32x4*)(ckvpart + (size_t)row * 8);
                const f32x4 p0 = pp[0], p1 = pp[1];
                const float ss = ((p0[0] + p0[1]) + (p0[2] + p0[3])) + ((p1[0] + p1[1]) + (p1[2] + p1[3]));
                const float rstd = __builtin_amdgcn_rsqf(ss * (1.f / KVL) + EPS);
                const int b = row >> 12, s = row & (NS - 1);
                const size_t o = (((size_t)(b * NH + u.pn)) * NS + s) * 128 + wc * 32 + 8 * fq;
                *(u32x4*)(KN + o) = pack8u(acc[ai][0][m][0] * rstd, acc[ai][0][m][1] * rstd);
                *(u32x4*)(VV + o) = pack8u(acc[ai][1][m][0] * rstd, acc[ai][1][m][1] * rstd);
                asm volatile("" ::: "memory");
            }
    }
};
struct EpiRouter {
    static constexpr bool PERM = false;
    float* LOG;
    __device__ __forceinline__ void operator()(const Acc& acc, const Unit& u, int wr, int wc, int fr, int fq) const {
        if (wc > 2) return;
#pragma unroll
        for (int ai = 0; ai < 2; ++ai)
#pragma unroll
            for (int m = 0; m < 4; ++m) {
                const int row = EPI_ROW(u, ai, wr, m, fr);
#pragma unroll
                for (int n = 0; n < 2; ++n) { const int c = wc * 32 + 16 * n + 4 * fq; if (c < 72) *(f32x4*)(LOG + (size_t)row * 72 + c) = acc[ai][0][m][n]; }
            }
    }
};
struct EpiGU {
    static constexpr bool PERM = true;
    bf16_t* HID;
    __device__ __forceinline__ void operator()(const Acc& acc, const Unit& u, int wr, int wc, int fr, int fq) const {
#pragma unroll
        for (int ai = 0; ai < 2; ++ai)
#pragma unroll
            for (int m = 0; m < 4; ++m) {
                const int slot = EPI_ROW(u, ai, wr, m, fr);
                f32x4 h0, h1;
#pragma unroll
                for (int j = 0; j < 4; ++j) { const float g0 = acc[ai][0][m][0][j], g1 = acc[ai][0][m][1][j];
                    h0[j] = g0 * fsigmoid(g0) * acc[ai][1][m][0][j]; h1[j] = g1 * fsigmoid(g1) * acc[ai][1][m][1][j]; }
                *(u32x4*)(HID + (size_t)slot * DEXP + u.pn * 128 + wc * 32 + 8 * fq) = pack8u(h0, h1);
            }
    }
};
struct EpiDown {
    static constexpr bool PERM = true;
    bf16_t* YS; const int* rowtok; const float* roww;
    __device__ __forceinline__ void operator()(const Acc& acc, const Unit& u, int wr, int wc, int fr, int fq) const {
#pragma unroll
        for (int ai = 0; ai < 2; ++ai)
#pragma unroll
            for (int m = 0; m < 4; ++m) {
                const int slot = EPI_ROW(u, ai, wr, m, fr);
                const int t = rowtok[slot];
                if (t >= 0) {
                    const float w = roww[slot];
                    bf16_t* dst = YS + ((size_t)(t & 1) * MROWS + (t >> 1)) * DM + u.pn * 256 + wc * 32 + 8 * fq;
#pragma unroll
                    for (int bj = 0; bj < 2; ++bj) *(u32x4*)(dst + bj * 128) = pack8u(acc[ai][bj][m][0] * w, acc[ai][bj][m][1] * w);
                }
                asm volatile("" ::: "memory");
            }
    }
};
struct EpiPP {
    static constexpr bool PERM = true;
    bf16_t* PP;
    __device__ __forceinline__ void operator()(const Acc& acc, const Unit& u, int wr, int wc, int fr, int fq) const {
#pragma unroll
        for (int ai = 0; ai < 2; ++ai)
#pragma unroll
            for (int m = 0; m < 4; ++m) {
                const int row = EPI_ROW(u, ai, wr, m, fr);
#pragma unroll
                for (int bj = 0; bj < 2; ++bj) *(u32x4*)(PP + (size_t)row * DM + u.pn * 256 + bj * 128 + wc * 32 + 8 * fq) = pack8u(acc[ai][bj][m][0], acc[ai][bj][m][1]);
            }
    }
};
struct EpiPLE {
    static constexpr bool PERM = false;
    float* H; const bf16_t* PP; const float* rstd3;
    __device__ __forceinline__ void operator()(const Acc& acc, const Unit& u, int wr, int wc, int fr, int fq) const {
#pragma unroll
        for (int ai = 0; ai < 2; ++ai)
#pragma unroll
            for (int m = 0; m < 4; ++m) {
                const int row = EPI_ROW(u, ai, wr, m, fr);
                const float rs = rstd3[row];
#pragma unroll
                for (int bj = 0; bj < 2; ++bj)
#pragma unroll
                    for (int n = 0; n < 2; ++n) {
                        const size_t off = (size_t)row * DM + u.pn * 256 + bj * 128 + wc * 32 + 16 * n + 4 * fq;
                        const u32x2 pw = *(const u32x2*)(PP + off);
                        const f32x4 pp = {bflo(pw.x), bfhi(pw.x), bflo(pw.y), bfhi(pw.y)};
                        f32x4 h = *(const f32x4*)(H + off); const f32x4 a = acc[ai][bj][m][n];
#pragma unroll
                        for (int j = 0; j < 4; ++j) h[j] += fsigmoid(a[j] * rs) * pp[j];
                        *(f32x4*)(H + off) = h;
                    }
                asm volatile("" ::: "memory");
            }
    }
};
}

namespace att {
constexpr int SHM_V = 16384, SHM_KN = 16384, SHM_KR = 8192;
constexpr int OFF_V = 0, OFF_KN = 32768, OFF_KR = 65536, OFF_WS = 81920;
constexpr float SCALE = 0.07216878364870322f;
constexpr float THR = 8.f;
#define KSWZ(row, colB) ((row) * 256 + ((colB) ^ (((row) & 7) << 4)))
#define KRSWZ(row, colB) ((row) * 128 + ((colB) ^ ((((row) >> 1) & 7) << 4)))
#define SBAR() __builtin_amdgcn_sched_barrier(0)
__device__ __forceinline__ int v_st(int k, int c) { const int kk = (k & ~0xC) | ((k & 4) << 1) | ((k & 8) >> 1); return ((kk >> 3) * 4 + (c >> 5)) * 512 + ((kk & 7) * 32 + (c & 31)) * 2; }
__device__ __forceinline__ int v_rd_base(int lane) { return ((lane & 3) << 3) | (((lane >> 2) & 3) << 6) | (((lane >> 4) & 1) << 5) | (((lane >> 5) & 1) << 8); }
constexpr int v_rd_off(int d0, int ks, int half) { return d0 * 512 + ks * 4096 + half * 2048; }
__device__ __forceinline__ int crow(int r, int hi) { return (r & 3) + 8 * (r >> 2) + 4 * hi; }

__device__ __forceinline__ void partialSM(f32x16& p0, f32x16& p1, float& m_reg, float& mn, float& alpha) {
    float pmax = p0[0];
#pragma unroll
    for (int r = 1; r < 16; ++r) pmax = fmaxf(pmax, p0[r]);
#pragma unroll
    for (int r = 0; r < 16; ++r) pmax = fmaxf(pmax, p1[r]);
    { auto rr = __builtin_amdgcn_permlane32_swap(__float_as_uint(pmax), __float_as_uint(pmax), false, false);
      pmax = fmaxf(__uint_as_float(rr[0]), __uint_as_float(rr[1])); }
    constexpr float C2 = 1.4426950408889634f * SCALE;
    if (__builtin_expect(__all((pmax - m_reg) * SCALE <= THR), 1)) { mn = m_reg; alpha = 1.f; }
    else { mn = fmaxf(m_reg, pmax); alpha = __builtin_amdgcn_exp2f((m_reg - mn) * C2); m_reg = mn; }
    const float mnL = -mn * C2;
#pragma unroll
    for (int r = 0; r < 16; ++r) p0[r] = fmaf(p0[r], C2, mnL);
#pragma unroll
    for (int r = 0; r < 16; ++r) p1[r] = fmaf(p1[r], C2, mnL);
#pragma unroll
    for (int r = 0; r < 16; ++r) p0[r] = __builtin_amdgcn_exp2f(p0[r]);
}
__device__ __forceinline__ void finishSM(f32x16& p0, f32x16& p1, float alpha, float& l_reg, bf16x8& pa0, bf16x8& pa1, bf16x8& pa2, bf16x8& pa3) {
#pragma unroll
    for (int r = 0; r < 16; ++r) p1[r] = __builtin_amdgcn_exp2f(p1[r]);
    float ps = 0;
#pragma unroll
    for (int r = 0; r < 16; ++r) ps += p0[r];
#pragma unroll
    for (int r = 0; r < 16; ++r) ps += p1[r];
    { auto rr = __builtin_amdgcn_permlane32_swap(__float_as_uint(ps), __float_as_uint(ps), false, false);
      ps = __uint_as_float(rr[0]) + __uint_as_float(rr[1]); }
    l_reg = l_reg * alpha + ps;
#define PK4(P, B_, OUT) do { unsigned a0 = cvtpk(P[B_+0], P[B_+1]), a1 = cvtpk(P[B_+2], P[B_+3]);                          \
        unsigned b0 = cvtpk(P[B_+4], P[B_+5]), b1 = cvtpk(P[B_+6], P[B_+7]);                                             \
        auto r0 = __builtin_amdgcn_permlane32_swap(a0, b0, false, false); auto r1 = __builtin_amdgcn_permlane32_swap(a1, b1, false, false); \
        u32x4 w = {r0[0], r1[0], r0[1], r1[1]}; OUT = *reinterpret_cast<bf16x8*>(&w); } while (0)
    PK4(p0, 0, pa0); PK4(p0, 8, pa1); PK4(p1, 0, pa2); PK4(p1, 8, pa3);
#undef PK4
}
template <int KB>
__device__ __forceinline__ void qkt(f32x16& p0, f32x16& p1, const char* lds, int r32, int hi, const bf16x8* qr) {
    p0 = f32x16{}; p1 = f32x16{};
    const char* kb[4];
#pragma unroll
    for (int dd = 0; dd < 4; ++dd) kb[dd] = lds + OFF_KN + KB * SHM_KN + KSWZ(r32, (dd * 16 + hi * 8) * 2);
#pragma unroll
    for (int d0 = 0; d0 < 8; ++d0) { const char* a = kb[d0 & 3] + (d0 >> 2) * 128;
        bf16x8 b0 = *reinterpret_cast<const bf16x8*>(a);
        bf16x8 b1 = *reinterpret_cast<const bf16x8*>(a + 32 * 256);
        p0 = __builtin_amdgcn_mfma_f32_32x32x16_bf16(b0, qr[d0], p0, 0, 0, 0);
        p1 = __builtin_amdgcn_mfma_f32_32x32x16_bf16(b1, qr[d0], p1, 0, 0, 0); }
#pragma unroll
    for (int dd = 0; dd < 4; ++dd) { const char* a = lds + OFF_KR + KB * SHM_KR + KRSWZ(r32, (dd * 16 + hi * 8) * 2);
        bf16x8 b0 = *reinterpret_cast<const bf16x8*>(a);
        bf16x8 b1 = *reinterpret_cast<const bf16x8*>(a + 32 * 128);
        p0 = __builtin_amdgcn_mfma_f32_32x32x16_bf16(b0, qr[8 + dd], p0, 0, 0, 0);
        p1 = __builtin_amdgcn_mfma_f32_32x32x16_bf16(b1, qr[8 + dd], p1, 0, 0, 0); }
}
#define TRRD(dst, off) asm volatile("ds_read_b64_tr_b16 %0, %1 offset:%2" : "=&v"(dst) : "v"(vb0), "i"(off) : "memory")
template <int VB, int D0, int OI>
__device__ __forceinline__ void pv_d0(f32x16* o, int vb0, bf16x8 pa0, bf16x8 pa1, bf16x8 pa2, bf16x8 pa3) {
    s16x4 l0, l1, l2, l3, h0, h1, h2, h3; constexpr int b_ = VB * SHM_V + v_rd_off(D0, 0, 0);
    TRRD(l0, b_); TRRD(h0, b_ + 2048); TRRD(l1, b_ + 4096); TRRD(h1, b_ + 6144); TRRD(l2, b_ + 8192); TRRD(h2, b_ + 10240); TRRD(l3, b_ + 12288); TRRD(h3, b_ + 14336);
    asm volatile("s_waitcnt lgkmcnt(0)" ::: "memory"); SBAR();
    o[OI] = __builtin_amdgcn_mfma_f32_32x32x16_bf16(pa0, (bf16x8){l0[0], l0[1], l0[2], l0[3], h0[0], h0[1], h0[2], h0[3]}, o[OI], 0, 0, 0);
    o[OI] = __builtin_amdgcn_mfma_f32_32x32x16_bf16(pa1, (bf16x8){l1[0], l1[1], l1[2], l1[3], h1[0], h1[1], h1[2], h1[3]}, o[OI], 0, 0, 0);
    o[OI] = __builtin_amdgcn_mfma_f32_32x32x16_bf16(pa2, (bf16x8){l2[0], l2[1], l2[2], l2[3], h2[0], h2[1], h2[2], h2[3]}, o[OI], 0, 0, 0);
    o[OI] = __builtin_amdgcn_mfma_f32_32x32x16_bf16(pa3, (bf16x8){l3[0], l3[1], l3[2], l3[3], h3[0], h3[1], h3[2], h3[3]}, o[OI], 0, 0, 0);
}
template <int VB>
__device__ __forceinline__ void pv_tile(f32x16* o, int vb0, bf16x8 pa0, bf16x8 pa1, bf16x8 pa2, bf16x8 pa3) {
    pv_d0<VB, 0, 0>(o, vb0, pa0, pa1, pa2, pa3); pv_d0<VB, 1, 1>(o, vb0, pa0, pa1, pa2, pa3);
    pv_d0<VB, 2, 2>(o, vb0, pa0, pa1, pa2, pa3); pv_d0<VB, 3, 3>(o, vb0, pa0, pa1, pa2, pa3);
}
template <int VB, int CH>
__device__ __forceinline__ void pv_half(f32x16* o, int vb0, bf16x8 pa0, bf16x8 pa1, bf16x8 pa2, bf16x8 pa3) {
    pv_d0<VB, 2 * CH, 0>(o, vb0, pa0, pa1, pa2, pa3); pv_d0<VB, 2 * CH + 1, 1>(o, vb0, pa0, pa1, pa2, pa3);
}

__device__ __forceinline__ void attn_block(char* lds, const bf16_t* QN, const bf16_t* QR, const bf16_t* KN, const bf16_t* KPE, const bf16_t* VV, bf16_t* O, int bh, int qb) {
    int tid = threadIdx.x; asm volatile("" : "+v"(tid));
    const int wid = __builtin_amdgcn_readfirstlane(tid >> 6), lane = tid & 63, r32 = lane & 31, hi = lane >> 5;
    const int b = bh >> 3, h = bh & 7, P0 = qb * 256, NT = 4 * qb + 4;
    const int cw = (P0 + 32 * wid) >> 6;
    bf16x8 qr[12];
    { const bf16_t* qn = QN + ((size_t)bh * NS + P0 + wid * 32 + r32) * 128; const bf16_t* qp = QR + ((size_t)bh * NS + P0 + wid * 32 + r32) * RD;
#pragma unroll
      for (int d0 = 0; d0 < 8; ++d0) qr[d0] = *(const bf16x8*)(qn + d0 * 16 + hi * 8);
#pragma unroll
      for (int dd = 0; dd < 4; ++dd) qr[8 + dd] = *(const bf16x8*)(qp + dd * 16 + hi * 8); }
    const bf16_t* Kh = KN + (size_t)bh * NS * 128; const bf16_t* Vh = VV + (size_t)bh * NS * 128; const bf16_t* Kp = KPE + (size_t)b * NS * RD;
    const int sr = tid >> 4, sc = (tid & 15) * 8, rr = tid >> 3, rc = (tid & 7) * 8;
    const int kws = KSWZ(sr, sc * 2), vst0 = v_st(sr, sc), vst1 = v_st(32 + sr, sc), krw = KRSWZ(rr, rc * 2);
    const int vb0 = (int)(uintptr_t)(lds + OFF_V) + v_rd_base(lane);
    float* wsf = (float*)(lds + OFF_WS) + wid * 64; float* li_l = wsf; float* al_l = wsf + 32;
    bf16x8 sk0, sk1, sv0, sv1, skr;
#define SLOAD(k0) do { sk0 = *(const bf16x8*)(Kh + (size_t)((k0) + sr) * 128 + sc); sk1 = *(const bf16x8*)(Kh + (size_t)((k0) + 32 + sr) * 128 + sc); \
        sv0 = *(const bf16x8*)(Vh + (size_t)((k0) + sr) * 128 + sc); sv1 = *(const bf16x8*)(Vh + (size_t)((k0) + 32 + sr) * 128 + sc); \
        skr = *(const bf16x8*)(Kp + (size_t)((k0) + rr) * RD + rc); } while (0)
#define SWRITE(bf) do { *(bf16x8*)(lds + OFF_KN + (bf) * SHM_KN + kws) = sk0; *(bf16x8*)(lds + OFF_KN + (bf) * SHM_KN + kws + 32 * 256) = sk1; \
        *(bf16x8*)(lds + OFF_V + (bf) * SHM_V + vst0) = sv0; *(bf16x8*)(lds + OFF_V + (bf) * SHM_V + vst1) = sv1; \
        *(bf16x8*)(lds + OFF_KR + (bf) * SHM_KR + krw) = skr; } while (0)
    float m_reg = -1e30f, l_reg = 0.f; f32x16 o[4] = {};
    __syncthreads();
    SLOAD(0); SWRITE(0);
    __syncthreads();
#define COMPUTE(KB) do { f32x16 p0, p1; float mn, alpha; bf16x8 pa0, pa1, pa2, pa3; \
        qkt<KB>(p0, p1, lds, r32, hi, qr); partialSM(p0, p1, m_reg, mn, alpha); \
        if (__any(alpha < 1.f)) { if (hi == 0) al_l[r32] = alpha; asm volatile("s_waitcnt lgkmcnt(0)" ::: "memory"); \
            _Pragma("unroll") for (int r = 0; r < 16; ++r) { const float a_ = al_l[crow(r, hi)]; _Pragma("unroll") for (int d_ = 0; d_ < 4; ++d_) o[d_][r] *= a_; } } \
        finishSM(p0, p1, alpha, l_reg, pa0, pa1, pa2, pa3); SBAR(); \
        pv_tile<KB>(o, vb0, pa0, pa1, pa2, pa3); } while (0)
    for (int t = 0; t < NT; t += 2) {
        SLOAD((t + 1) * 64);
        if (t <= cw) COMPUTE(0);
        SWRITE(1);
        __syncthreads();
        if (t + 2 < NT) SLOAD((t + 2) * 64);
        if (t + 1 <= cw) COMPUTE(1);
        if (t + 2 < NT) SWRITE(0);
        __syncthreads();
    }
#undef COMPUTE
#undef SLOAD
#undef SWRITE
    if (hi == 0) li_l[r32] = l_reg;
    asm volatile("s_waitcnt lgkmcnt(0)" ::: "memory");
    float rli[16];
#pragma unroll
    for (int r = 0; r < 16; ++r) rli[r] = __builtin_amdgcn_rcpf(li_l[crow(r, hi)]);
    bf16_t* Ow = O + ((size_t)b * NS + P0 + wid * 32) * DM + h * 128;
#pragma unroll
    for (int r = 0; r < 16; ++r) { const int orow = crow(r, hi);
#pragma unroll
        for (int d0 = 0; d0 < 4; ++d0) { const float v = o[d0][r] * rli[r]; const float vn = __shfl_xor(v, 1);
            if ((r32 & 1) == 0) *(unsigned*)(Ow + (size_t)orow * DM + d0 * 32 + r32) = cvtpk(v, vn); } }
}
__device__ __forceinline__ void attn_phase(char* lds, const bf16_t* QN, const bf16_t* QR, const bf16_t* KN, const bf16_t* KPE, const bf16_t* VV, bf16_t* O, int G, int blk) {
    for (int L = blk; L < 512; L += G) {
        const int xcd = L & 7, k = L >> 3, bh = xcd * 8 + (k >> 3), y = k & 7;
        attn_block(lds, QN, QR, KN, KPE, VV, O, bh, 15 - y);
        attn_block(lds, QN, QR, KN, KPE, VV, O, bh, y);
    }
}

__device__ __forceinline__ void spatial_phase(char* lds, const bf16_t* U, const bf16_t* V, const float* vpart, const float* g_gv, const bf16_t* Wsp, const float* bsp, bf16_t* Y, int G, int blk0) {
    int tid = threadIdx.x; asm volatile("" : "+v"(tid));
    const int wid = __builtin_amdgcn_readfirstlane(tid >> 6), lane = tid & 63, r32 = lane & 31, hi = lane >> 5;
    float* mu_l = (float*)(lds + 40960); float* rs_l = mu_l + 128;
    const int vb0 = (int)(uintptr_t)(lds + OFF_V) + v_rd_base(lane);
    const int sr = tid >> 4, sc = (tid & 15) * 8;
    const int ts = (wid & 3) * 32, ch = wid >> 2;
    for (int blk = blk0; blk < MROWS / 128; blk += G) {
        __syncthreads();
        if (tid < 128) { const f32x2* pp = (const f32x2*)(vpart + (size_t)(blk * 128 + tid) * 96); float s = 0.f, q = 0.f;
            for (int i = 0; i < 48; ++i) { const f32x2 v = pp[i]; s += v.x; q += v.y; }
            const float mean = s * (1.f / GWID); float var = q * (1.f / GWID) - mean * mean; var = var < 0.f ? 0.f : var;
            mu_l[tid] = mean; rs_l[tid] = __builtin_amdgcn_rsqf(var + EPS); }
        __syncthreads();
        for (int g = 0; g < 12; ++g) {
            { f32x4 gg0 = *(const f32x4*)(g_gv + g * 128 + sc), gg1 = *(const f32x4*)(g_gv + g * 128 + sc + 4);
#pragma unroll
              for (int q = 0; q < 4; ++q) { const int s = sr + 32 * q; const u32x4 w = *(const u32x4*)(V + (size_t)(blk * 128 + s) * GWID + g * 128 + sc);
                f32x4 a, b2; unpack8(w, a, b2); const float mu = mu_l[s], rs = rs_l[s];
                a = (a - mu) * rs * gg0; b2 = (b2 - mu) * rs * gg1;
                *(bf16x8*)(lds + OFF_V + (q >> 1) * SHM_V + v_st(s & 63, sc)) = pack8(a, b2); } }
            __syncthreads();
            f32x16 o[2] = {};
            const bf16_t* wrow = Wsp + ((size_t)(g * 128 + ts + r32)) * 128 + hi * 8;
            { bf16x8 pa0 = *(const bf16x8*)(wrow), pa1 = *(const bf16x8*)(wrow + 16), pa2 = *(const bf16x8*)(wrow + 32), pa3 = *(const bf16x8*)(wrow + 48);
              if (ch == 0) pv_half<0, 0>(o, vb0, pa0, pa1, pa2, pa3); else pv_half<0, 1>(o, vb0, pa0, pa1, pa2, pa3); }
            if (ts >= 64) { bf16x8 pa0 = *(const bf16x8*)(wrow + 64), pa1 = *(const bf16x8*)(wrow + 80), pa2 = *(const bf16x8*)(wrow + 96), pa3 = *(const bf16x8*)(wrow + 112);
              if (ch == 0) pv_half<1, 0>(o, vb0, pa0, pa1, pa2, pa3); else pv_half<1, 1>(o, vb0, pa0, pa1, pa2, pa3); }
#pragma unroll
            for (int r = 0; r < 16; ++r) { const int t = ts + crow(r, hi); const float bb = bsp[g * 128 + t];
#pragma unroll
                for (int dd = 0; dd < 2; ++dd) { const size_t idx = (size_t)(blk * 128 + t) * GWID + g * 128 + (2 * ch + dd) * 32 + r32;
                    const float yv = bf2f(U[idx]) * (o[dd][r] + bb); const float yn = __shfl_xor(yv, 1);
                    if ((r32 & 1) == 0) *(unsigned*)(Y + idx) = cvtpk(yv, yn); } }
            __syncthreads();
        }
    }
}
#undef TRRD
#undef KSWZ
#undef KRSWZ
#undef SBAR
}

constexpr int NWAVES = 8, NTHREADS = 512;
constexpr int LDS_BYTES = 147456;
constexpr int NPHASE = 17;

struct Args {
    const float* in[26]; float* out; unsigned char* ws; int ph_lo, ph_hi;
};

enum { MAP_ID = 0, MAP_WIN = 1, MAP_WUQ = 2, MAP_GATE = 3, MAP_UP = 4 };
__device__ __forceinline__ int rowmap(int kind, int n) {
    if (kind == MAP_WIN) {
        if (n < 3072) return n;
        if (n < 3456) return SEG_CQ + (n - 3072);
        if (n < 3712) return SEG_CKV + (n - 3456);
        if (n < 3776) { const int j = n - 3712; return SEG_KR + (j < 32 ? 2 * j : 2 * (j - 32) + 1); }
        if (n < 4800) return SEG_GA + (n - 3776);
        return SEG_GB + (n - 4800);
    }
    if (kind == MAP_WUQ) { const int h = n / 192, r = n % 192; if (r < 128) return h * 128 + r; const int j = r - 128; return 1024 + h * 64 + (j < 32 ? 2 * j : 2 * (j - 32) + 1); }
    if (kind == MAP_GATE) return (n >> 7) * 256 + (n & 127);
    if (kind == MAP_UP) return (n >> 7) * 256 + 128 + (n & 127);
    return n;
}
__device__ __forceinline__ void transpose_item(const float* W, int K, int N, const float* kscale, bf16_t* WT, int kind, LAS float* scr, int item, int lane) {
    const int nblk = N / 32, kb = item / nblk, nb = item % nblk, k0 = 64 * kb, n0 = 32 * nb;
#pragma unroll 8
    for (int i = 0; i < 32; ++i) { const int kk = 2 * i + (lane >> 5); float v = W[(size_t)(k0 + kk) * N + n0 + (lane & 31)]; if (kscale) v *= kscale[k0 + kk]; scr[kk * 33 + (lane & 31)] = v; }
    asm volatile("s_waitcnt lgkmcnt(0)" ::: "memory");
    const int c = lane & 7;
#pragma unroll
    for (int j = 0; j < 4; ++j) { const int n = (lane >> 3) + 8 * j; const LAS float* s = scr + (8 * c) * 33 + n;
        u32x4 o; o.x = cvtpk(s[0 * 33], s[1 * 33]); o.y = cvtpk(s[2 * 33], s[3 * 33]); o.z = cvtpk(s[4 * 33], s[5 * 33]); o.w = cvtpk(s[6 * 33], s[7 * 33]);
        *(u32x4*)(WT + (size_t)rowmap(kind, n0 + n) * K + k0 + 8 * c) = o; }
    asm volatile("s_waitcnt lgkmcnt(0)" ::: "memory");
}
__device__ __forceinline__ void transpose_job(const float* W, int K, int N, const float* kscale, bf16_t* WT, int kind, LAS float* scr, int gw, int NGW, int lane) {
    const int nitems = (K / 64) * (N / 32);
    for (int it = gw; it < nitems; it += NGW) transpose_item(W, K, N, kscale, WT, kind, scr, it, lane);
}
__device__ __forceinline__ void rms_row_to_bf16(const float* xrow, const float* gain, bf16_t* orow, int lane) {
    const f32x4* xr = (const f32x4*)xrow + lane; f32x4 v[4]; float s = 0.f;
#pragma unroll
    for (int j = 0; j < 4; ++j) { v[j] = xr[64 * j]; s += (v[j][0] * v[j][0] + v[j][1] * v[j][1]) + (v[j][2] * v[j][2] + v[j][3] * v[j][3]); }
    const float rstd = 1.f / sqrtf(wave_sum(s) * (1.f / DM) + EPS);
    u32x2* o8 = (u32x2*)orow + lane;
#pragma unroll
    for (int j = 0; j < 4; ++j) { const f32x4 g = ((const f32x4*)gain)[lane + 64 * j]; const f32x4 w = v[j] * rstd * g; o8[64 * j] = (u32x2){cvtpk(w[0], w[1]), cvtpk(w[2], w[3])}; }
}

__global__ void __launch_bounds__(NTHREADS, 2) fwd_kernel(Args args) {
    extern __shared__ __attribute__((aligned(16))) unsigned char lds[];
    LAS unsigned char* ldsl = (LAS unsigned char*)lds;
    const int tid = threadIdx.x, lane = tid & 63, wave = __builtin_amdgcn_readfirstlane(tid >> 6);
    const int G = gridDim.x, blk = blockIdx.x;
    const int gw = blk * NWAVES + wave, NGW = G * NWAVES;
    unsigned char* ws = args.ws;
    const float* x = args.in[0]; const float* p_in = args.in[1]; const float* g_mix = args.in[2]; const float* w_in = args.in[3]; const float* g_gv = args.in[4];
    const float* w_spatial = args.in[5]; const float* b_spatial = args.in[6]; const float* w_gproj = args.in[7]; const float* g_cq = args.in[8]; const float* w_uq = args.in[9];
    const float* g_ckv = args.in[10]; const float* w_ukv = args.in[11]; const float* w_mla_o = args.in[12]; const float* w_out = args.in[13]; const float* g_moe = args.in[14];
    const float* w_router_g = args.in[15]; const float* b_router_g = args.in[16]; const float* w_router_e = args.in[17]; const float* b_router_e = args.in[18];
    const float* w_e_gate = args.in[19]; const float* w_e_up = args.in[20]; const float* w_e_down = args.in[21]; const float* g_ple = args.in[22];
    const float* w_ple_gate = args.in[23]; const float* w_ple_proj = args.in[24]; const float* g_final = args.in[25];
    float* out = args.out;
    int* ctl = (int*)(ws + WS_CTL); int* chunkcnt = (int*)(ws + WS_CHUNKCNT); u32x4* tokinfo = (u32x4*)(ws + WS_TOKINFO);
    int* rowtok = (int*)(ws + WS_ROWTOK); float* roww = (float*)(ws + WS_ROWW);
    float* ropeC = (float*)(ws + WS_ROPEC); float* ropeS = (float*)(ws + WS_ROPES);
    bf16_t* Win_t = (bf16_t*)(ws + WS_WIN); bf16_t* Wgp_t = (bf16_t*)(ws + WS_WGP); bf16_t* Wuq_t = (bf16_t*)(ws + WS_WUQ); bf16_t* Wukv_t = (bf16_t*)(ws + WS_WUKV);
    bf16_t* Wo_t = (bf16_t*)(ws + WS_WO); bf16_t* Wout_t = (bf16_t*)(ws + WS_WOUT); bf16_t* Wr_t = (bf16_t*)(ws + WS_WR); bf16_t* Wpg_t = (bf16_t*)(ws + WS_WPG);
    bf16_t* Wpp_t = (bf16_t*)(ws + WS_WPP); bf16_t* Wsp = (bf16_t*)(ws + WS_WSP); bf16_t* Pb = (bf16_t*)(ws + WS_PB);
    float* vpart = (float*)(ws + WS_VPART); float* cqpart = (float*)(ws + WS_CQPART); float* ckvpart = (float*)(ws + WS_CKVPART); float* rstd3 = (float*)(ws + WS_RSTD3);
    bf16_t* Ub = (bf16_t*)(ws + WS_U); bf16_t* Vb = (bf16_t*)(ws + WS_V); bf16_t* GA = (bf16_t*)(ws + WS_GA); bf16_t* GB = (bf16_t*)(ws + WS_GB);
    bf16_t* CQ = (bf16_t*)(ws + WS_CQ); bf16_t* CKV = (bf16_t*)(ws + WS_CKV); bf16_t* KPE = (bf16_t*)(ws + WS_KPE);
    bf16_t* QN = (bf16_t*)(ws + WS_QN); bf16_t* KN = (bf16_t*)(ws + WS_KN); bf16_t* VV = (bf16_t*)(ws + WS_VV); bf16_t* QR = (bf16_t*)(ws + WS_QR);
    bf16_t* Mb = (bf16_t*)(ws + WS_MB); bf16_t* Wgu_t = (bf16_t*)(ws + WS_WGU); bf16_t* Wd_t = (bf16_t*)(ws + WS_WD); float* LOG = (float*)(ws + WS_LOG);
    bf16_t* HID = (bf16_t*)(ws + WS_HID); bf16_t* YS = (bf16_t*)(ws + WS_YS); bf16_t* H2b = (bf16_t*)(ws + WS_H2B); bf16_t* PP = (bf16_t*)(ws + WS_PP);
    bf16_t* XA = (bf16_t*)out; bf16_t* Yb = (bf16_t*)out; bf16_t* Ob = (bf16_t*)out; float* H = out;

    const int lo = args.ph_lo, hi = args.ph_hi;
#ifndef PHMASK
#define PHMASK 0xFFFFFFFFu
#endif
#define IN(k) (((PHMASK >> (k)) & 1u) && lo <= (k) && (k) < hi)
#define SEAM(k) do { if (IN(k) && IN((k) + 1)) { __threadfence(); cg::this_grid().sync(); } } while (0)

    if (IN(0)) {
        LAS float* scr = (LAS float*)(ldsl + wave * 16384);
        transpose_job(w_in, DM, 5824, nullptr, Win_t, MAP_WIN, scr, gw, NGW, lane);
        transpose_job(w_gproj, GWID, DM, nullptr, Wgp_t, MAP_ID, scr, gw, NGW, lane);
        transpose_job(w_uq, QL, 1536, g_cq, Wuq_t, MAP_WUQ, scr, gw, NGW, lane);
        transpose_job(w_ukv, KVL, 2048, g_ckv, Wukv_t, MAP_ID, scr, gw, NGW, lane);
        transpose_job(w_mla_o, DM, DM, nullptr, Wo_t, MAP_ID, scr, gw, NGW, lane);
        transpose_job(w_out, DM, DM, nullptr, Wout_t, MAP_ID, scr, gw, NGW, lane);
        transpose_job(w_ple_gate, DM, DM, g_ple, Wpg_t, MAP_ID, scr, gw, NGW, lane);
        transpose_job(w_ple_proj, PLE, DM, nullptr, Wpp_t, MAP_ID, scr, gw, NGW, lane);
        const int gt = blk * NTHREADS + tid, NGT = G * NTHREADS;
        for (int i = gt; i < 64 * DM; i += NGT) Win_t[(size_t)SEG_PAD * DM + i] = 0;
        for (int i = gt; i < 256 * DM; i += NGT) { const int n = i >> 10, k = i & 1023; float v = 0.f;
            if (n < 8) v = w_router_g[k * 8 + n]; else if (n < 72) v = w_router_e[k * 64 + (n - 8)];
            Wr_t[i] = (bf16_t)(cvtpk(v, 0.f) & 0xffffu); }
        for (int i = gt; i < 12 * 128 * 128; i += NGT) { const int t = (i >> 7) & 127, s = i & 127; const float v = ((s >> 6) <= (t >> 6)) ? w_spatial[i] : 0.f; Wsp[i] = (bf16_t)(cvtpk(v, 0.f) & 0xffffu); }
        for (int i = gt; i < NS * 32; i += NGT) { const int s = i >> 5, j = i & 31; const double inv = exp(-(double)j * (1.0 / 32.0) * 9.210340371976184); const double a = (double)s * inv;
            ropeC[i] = (float)cos(a); ropeS[i] = (float)sin(a); }
        for (int i = gt; i < MROWS * PLE / 4; i += NGT) { const f32x4 v = ((const f32x4*)p_in)[i]; ((u32x2*)Pb)[i] = (u32x2){cvtpk(v[0], v[1]), cvtpk(v[2], v[3])}; }
        for (int m = gw; m < MROWS; m += NGW) rms_row_to_bf16(x + (size_t)m * DM, g_mix, XA + (size_t)m * DM, lane);
    }
    SEAM(0);
    if (IN(1)) {
        pg8::SchedDense S; S.init(XA, Win_t, MROWS, ZN, DM, G, blk);
        pg8::EpiZ E{Ub, Vb, GA, GB, CQ, CKV, KPE, vpart, cqpart, ckvpart, ropeC, ropeS};
        pg8::gemm_phase(ldsl, DM, S, E);
    }
    SEAM(1);
    if (IN(2)) { att::spatial_phase((char*)lds, Ub, Vb, vpart, g_gv, Wsp, b_spatial, Yb, G, blk); }
    SEAM(2);
    if (IN(3)) {
#ifndef SUBMASK
#define SUBMASK 7
#endif
        if (SUBMASK & 1) { pg8::SchedDense S; S.init(Yb, Wgp_t, MROWS, DM, GWID, G, blk); pg8::EpiMul E{GA}; pg8::gemm_phase(ldsl, GWID, S, E); }
        __syncthreads();
        if (SUBMASK & 2) { pg8::SchedDense S; S.init(CQ, Wuq_t, MROWS, 1536, QL, G, blk); pg8::EpiQ E{QN, QR, cqpart, ropeC, ropeS}; pg8::gemm_phase(ldsl, QL, S, E); }
        __syncthreads();
        if (SUBMASK & 4) { pg8::SchedDense S; S.init(CKV, Wukv_t, MROWS, 2048, KVL, G, blk); pg8::EpiKV E{KN, VV, ckvpart}; pg8::gemm_phase(ldsl, KVL, S, E); }
    }
    SEAM(3);
    if (IN(4)) { att::attn_phase((char*)lds, QN, QR, KN, KPE, VV, Ob, G, blk); }
    SEAM(4);
    if (IN(5)) {
        { pg8::SchedDense S; S.init(Ob, Wo_t, MROWS, DM, DM, G, blk); pg8::EpiMulAdd E{GA, GB}; pg8::gemm_phase(ldsl, DM, S, E); }
        __syncthreads();
        LAS float* scr = (LAS float*)(ldsl + wave * 16384);
        for (int it = gw; it < NEXP * 128; it += NGW) { const int e = it >> 7, sub = it & 127;
            transpose_item(w_e_gate + (size_t)e * DM * DEXP, DM, DEXP, nullptr, Wgu_t + (size_t)e * 512 * DM, MAP_GATE, scr, sub, lane);
            transpose_item(w_e_up + (size_t)e * DM * DEXP, DM, DEXP, nullptr, Wgu_t + (size_t)e * 512 * DM, MAP_UP, scr, sub, lane);
            transpose_item(w_e_down + (size_t)e * DEXP * DM, DEXP, DM, nullptr, Wd_t + (size_t)e * DM * DEXP, MAP_ID, scr, sub, lane); }
    }
    SEAM(5);
    if (IN(6)) { pg8::SchedDense S; S.init(GA, Wout_t, MROWS, DM, DM, G, blk); pg8::EpiRes E{x, H}; pg8::gemm_phase(ldsl, DM, S, E); }
    SEAM(6);
    if (IN(7)) { for (int m = gw; m < MROWS; m += NGW) rms_row_to_bf16(H + (size_t)m * DM, g_moe, Mb + (size_t)m * DM, lane); }
    SEAM(7);
    if (IN(8)) { pg8::SchedDense S; S.init(Mb, Wr_t, MROWS, 256, DM, G, blk); pg8::EpiRouter E{LOG}; pg8::gemm_phase(ldsl, DM, S, E); }
    SEAM(8);
    if (IN(9)) {
        LAS int* hist = (LAS int*)ldsl;
        for (int chunk = blk; chunk < MROWS / 128; chunk += G) {
            __syncthreads();
            if (tid < 64) hist[tid] = 0;
            __syncthreads();
            if (tid < 128) {
                const int tok = chunk * 128 + tid; const float* lg = LOG + (size_t)tok * 72;
                float gl[8]; float gm = -1e30f;
#pragma unroll
                for (int i = 0; i < 8; ++i) { gl[i] = lg[i]; gm = fmaxf(gm, gl[i]); }
                float gs = 0.f;
#pragma unroll
                for (int i = 0; i < 8; ++i) { gl[i] = expf(gl[i] - gm); gs += gl[i]; }
                int gi = 0; float gbest = -1e30f, gw_ = 0.f;
#pragma unroll
                for (int i = 0; i < 8; ++i) { const float pr = gl[i] / gs; const float sc_ = pr + b_router_g[i]; if (sc_ > gbest) { gbest = sc_; gi = i; gw_ = pr; } }
                float el[8]; float em = -1e30f;
#pragma unroll
                for (int i = 0; i < 8; ++i) { el[i] = lg[8 + gi * 8 + i]; em = fmaxf(em, el[i]); }
                float es = 0.f;
#pragma unroll
                for (int i = 0; i < 8; ++i) { el[i] = expf(el[i] - em); es += el[i]; }
                int i0 = 0, i1 = 0; float s0 = -1e30f, s1 = -1e30f, p0 = 0.f, p1 = 0.f;
#pragma unroll
                for (int i = 0; i < 8; ++i) { const float pr = el[i] / es; const float sc_ = pr + b_router_e[gi * 8 + i];
                    if (sc_ > s0) { s1 = s0; i1 = i0; p1 = p0; s0 = sc_; i0 = i; p0 = pr; } else if (sc_ > s1) { s1 = sc_; i1 = i; p1 = pr; } }
                const float den = p0 + p1; const float w0 = gw_ * (p0 / den), w1 = gw_ * (p1 / den);
                const int e0 = gi * 8 + i0, e1 = gi * 8 + i1;
                const int r0 = __hip_atomic_fetch_add(&hist[e0], 1, __ATOMIC_RELAXED, __HIP_MEMORY_SCOPE_WORKGROUP);
                const int r1 = __hip_atomic_fetch_add(&hist[e1], 1, __ATOMIC_RELAXED, __HIP_MEMORY_SCOPE_WORKGROUP);
                tokinfo[tok] = (u32x4){(unsigned)(e0 | (r0 << 8)), (unsigned)(e1 | (r1 << 8)), __float_as_uint(w0), __float_as_uint(w1)};
            }
            __syncthreads();
            if (tid < 64) chunkcnt[chunk * 64 + tid] = hist[tid];
        }
    }
    SEAM(9);
    if (IN(10)) {
        LAS int* tot = (LAS int*)ldsl; LAS int* base = tot + 64; LAS int* cbase = tot + 128;
        if (tid < 64) { int s = 0; for (int c = 0; c < MROWS / 128; ++c) s += chunkcnt[c * 64 + tid]; tot[tid] = s; }
        __syncthreads();
        if (tid == 0) { int acc = 0; for (int e = 0; e < 64; ++e) { base[e] = acc; acc += (tot[e] + 255) & ~255; }
            if (blk == 0) { ctl[0] = acc >> 8; int rt = 0; for (int e = 0; e < 64; ++e) { const int n = (tot[e] + 255) >> 8; for (int i = 0; i < n; ++i) ctl[16 + rt++] = e; } } }
        __syncthreads();
        for (int e = blk; e < 64; e += G) { const int b0 = base[e] + tot[e], b1 = base[e] + ((tot[e] + 255) & ~255); for (int s = b0 + tid; s < b1; s += NTHREADS) { rowtok[s] = -1; roww[s] = 0.f; } }
        for (int chunk = blk; chunk < MROWS / 128; chunk += G) {
            __syncthreads();
            if (tid < 64) { int s = 0; for (int c = 0; c < chunk; ++c) s += chunkcnt[c * 64 + tid]; cbase[tid] = s; }
            __syncthreads();
            if (tid < 128) { const int tok = chunk * 128 + tid; const u32x4 ti = tokinfo[tok];
                const int e0 = ti.x & 255, r0 = ti.x >> 8, e1 = ti.y & 255, r1 = ti.y >> 8;
                const int s0 = base[e0] + cbase[e0] + r0, s1 = base[e1] + cbase[e1] + r1;
                rowtok[s0] = tok * 2; roww[s0] = __uint_as_float(ti.z); rowtok[s1] = tok * 2 + 1; roww[s1] = __uint_as_float(ti.w); }
        }
    }
    SEAM(10);
    if (IN(11)) { pg8::SchedGU S{Mb, rowtok, Wgu_t, ctl + 16, ctl[0], G, blk}; pg8::EpiGU E{HID}; pg8::gemm_phase(ldsl, DM, S, E); }
    SEAM(11);
    if (IN(12)) { pg8::SchedDown S{HID, Wd_t, ctl + 16, ctl[0], G, blk}; pg8::EpiDown E{YS, rowtok, roww}; pg8::gemm_phase(ldsl, DEXP, S, E); }
    SEAM(12);
    if (IN(13)) {
        for (int m = gw; m < MROWS; m += NGW) {
            f32x4* hr = (f32x4*)(H + (size_t)m * DM) + lane; const u32x2* y0 = (const u32x2*)(YS + (size_t)m * DM) + lane; const u32x2* y1 = (const u32x2*)(YS + ((size_t)MROWS + m) * DM) + lane;
            u32x2* hb = (u32x2*)(H2b + (size_t)m * DM) + lane; float s = 0.f;
#pragma unroll
            for (int j = 0; j < 4; ++j) { f32x4 v = hr[64 * j]; const u32x2 a = y0[64 * j], b = y1[64 * j];
                v[0] += bflo(a.x) + bflo(b.x); v[1] += bfhi(a.x) + bfhi(b.x); v[2] += bflo(a.y) + bflo(b.y); v[3] += bfhi(a.y) + bfhi(b.y);
                hr[64 * j] = v; hb[64 * j] = (u32x2){cvtpk(v[0], v[1]), cvtpk(v[2], v[3])};
                s += (v[0] * v[0] + v[1] * v[1]) + (v[2] * v[2] + v[3] * v[3]); }
            s = wave_sum(s);
            if (lane == 0) rstd3[m] = 1.f / sqrtf(s * (1.f / DM) + EPS);
        }
    }
    SEAM(13);
    if (IN(14)) {
        { pg8::SchedDense S; S.init(Pb, Wpp_t, MROWS, DM, PLE, G, blk); pg8::EpiPP E{PP}; pg8::gemm_phase(ldsl, PLE, S, E); }
        __syncthreads();
        { pg8::SchedDense S; S.init(H2b, Wpg_t, MROWS, DM, DM, G, blk); pg8::EpiPLE E{H, PP, rstd3}; pg8::gemm_phase(ldsl, DM, S, E); }
    }
    SEAM(14);
    if (IN(15)) {
        for (int m = gw; m < MROWS; m += NGW) {
            f32x4* hr = (f32x4*)(H + (size_t)m * DM) + lane; f32x4 v[4]; float s = 0.f;
#pragma unroll
            for (int j = 0; j < 4; ++j) { v[j] = hr[64 * j]; s += (v[j][0] * v[j][0] + v[j][1] * v[j][1]) + (v[j][2] * v[j][2] + v[j][3] * v[j][3]); }
            const float rstd = 1.f / sqrtf(wave_sum(s) * (1.f / DM) + EPS);
#pragma unroll
            for (int j = 0; j < 4; ++j) hr[64 * j] = v[j] * rstd * ((const f32x4*)g_final)[lane + 64 * j];
        }
    }
#undef IN
#undef SEAM
}

extern "C" void kernel_launch(void* const* d_in, const int* in_sizes, int n_in, void* d_out, int out_size, void* d_ws, size_t ws_size, hipStream_t stream) {
    static int grid = 0;
    if (grid == 0) {
        if (n_in != 26 || out_size != MROWS * DM || ws_size < WS_END) { fprintf(stderr, "kernel_launch: unexpected shapes (n_in %d out %d ws %zu)\n", n_in, out_size, ws_size); grid = -1; return; }
        int dev = 0, cus = 0, per_cu = 0;
        (void)hipGetDevice(&dev); (void)hipDeviceGetAttribute(&cus, hipDeviceAttributeMultiprocessorCount, dev);
        if (hipFuncSetAttribute((const void*)fwd_kernel, hipFuncAttributeMaxDynamicSharedMemorySize, LDS_BYTES) != hipSuccess) { fprintf(stderr, "kernel_launch: hipFuncSetAttribute failed\n"); grid = -1; return; }
        if (hipOccupancyMaxActiveBlocksPerMultiprocessor(&per_cu, (const void*)fwd_kernel, NTHREADS, LDS_BYTES) != hipSuccess || per_cu < 1) { fprintf(stderr, "kernel_launch: occupancy query says %d\n", per_cu); per_cu = 1; }
        (void)hipGetLastError();
        grid = cus > 0 ? cus : 256;
    }
    if (grid < 0) return;
    Args a{};
    for (int i = 0; i < 26; ++i) a.in[i] = (const float*)d_in[i];
    a.out = (float*)d_out; a.ws = (unsigned char*)d_ws;
#if MK_N_LAUNCHES == 1
    a.ph_lo = 0; a.ph_hi = NPHASE;
    void* params[] = {&a};
    hipError_t e = hipLaunchCooperativeKernel((const void*)fwd_kernel, dim3(grid), dim3(NTHREADS), params, LDS_BYTES, stream);
    if (e != hipSuccess) fprintf(stderr, "kernel_launch: cooperative launch failed: %s\n", hipGetErrorString(e));
#else
    for (int ph = 0; ph < 16; ++ph) { a.ph_lo = ph; a.ph_hi = ph + 1; hipLaunchKernelGGL(fwd_kernel, dim3(grid), dim3(NTHREADS), LDS_BYTES, stream, a); }
#endif
}
```

```cpp
#include <hip/hip_runtime.h>
#include <hip/hip_cooperative_groups.h>
#include <cstdio>
#include <cstdint>
namespace cg = cooperative_groups;

#ifndef MK_N_LAUNCHES
#define MK_N_LAUNCHES 1
#endif

#define LAS __attribute__((address_space(3)))
typedef unsigned short bf16_t;
typedef short bf16x8 __attribute__((ext_vector_type(8)));
typedef short s16x4 __attribute__((ext_vector_type(4)));
typedef float f32x4 __attribute__((ext_vector_type(4)));
typedef float f32x2 __attribute__((ext_vector_type(2)));
typedef float f32x16 __attribute__((ext_vector_type(16)));
typedef unsigned u32x4 __attribute__((ext_vector_type(4)));
typedef unsigned u32x2 __attribute__((ext_vector_type(2)));

constexpr int NB = 8, NS = 4096, DM = 1024, MROWS = NB * NS;
constexpr int GWID = 1536, QL = 384, KVL = 256, RD = 64, NH = 8, PLE = 256;
constexpr int ZN = 5888;
constexpr int SEG_V = 1536, SEG_GA = 3072, SEG_GB = 4096, SEG_CQ = 5120, SEG_CKV = 5504, SEG_KR = 5760, SEG_PAD = 5824;
constexpr int NEXP = 64, DEXP = 256;
constexpr int MAXSLOT = 2 * MROWS + NEXP * 256;
constexpr float EPS = 1e-6f;

constexpr size_t MiB = 1u << 20;
constexpr size_t WS_CTL = 0;
constexpr size_t WS_CHUNKCNT = 64 * 1024;
constexpr size_t WS_TOKINFO = 128 * 1024;
constexpr size_t WS_ROWTOK = 1 * MiB;
constexpr size_t WS_ROWW = 1 * MiB + 512 * 1024;
constexpr size_t WS_ROPEC = 2 * MiB, WS_ROPES = 3 * MiB;
constexpr size_t WS_WIN = 4 * MiB;
constexpr size_t WS_WGP = 16 * MiB;
constexpr size_t WS_WUQ = 19 * MiB;
constexpr size_t WS_WUKV = 20 * MiB + 512 * 1024;
constexpr size_t WS_WO = 21 * MiB + 512 * 1024;
constexpr size_t WS_WOUT = 23 * MiB + 512 * 1024;
constexpr size_t WS_WR = 25 * MiB + 512 * 1024;
constexpr size_t WS_WPG = 26 * MiB;
constexpr size_t WS_WPP = 28 * MiB;
constexpr size_t WS_WSP = 28 * MiB + 512 * 1024;
constexpr size_t WS_PB = 29 * MiB;
constexpr size_t WS_VPART = 45 * MiB;
constexpr size_t WS_CQPART = 57 * MiB;
constexpr size_t WS_CKVPART = 58 * MiB + 512 * 1024;
constexpr size_t WS_RSTD3 = 63 * MiB + 512 * 1024;
constexpr size_t WS_U = 64 * MiB, WS_V = 160 * MiB, WS_GA = 256 * MiB, WS_GB = 320 * MiB, WS_CQ = 384 * MiB, WS_CKV = 408 * MiB, WS_KPE = 424 * MiB;
constexpr size_t WS_QN = 64 * MiB, WS_KN = 128 * MiB, WS_VV = 192 * MiB, WS_QR = 428 * MiB;
constexpr size_t WS_MB = 64 * MiB, WS_WGU = 128 * MiB, WS_WD = 192 * MiB, WS_LOG = 224 * MiB;
constexpr size_t WS_HID = 256 * MiB, WS_YS = 320 * MiB, WS_H2B = 64 * MiB, WS_PP = 128 * MiB;
constexpr size_t WS_END = 512 * MiB;

__device__ __forceinline__ unsigned cvtpk(float lo, float hi) { unsigned r; asm volatile("v_cvt_pk_bf16_f32 %0, %1, %2" : "=v"(r) : "v"(lo), "v"(hi)); return r; }
__device__ __forceinline__ float bflo(unsigned w) { return __uint_as_float(w << 16); }
__device__ __forceinline__ float bfhi(unsigned w) { return __uint_as_float(w & 0xffff0000u); }
__device__ __forceinline__ float bf2f(bf16_t b) { return __uint_as_float(((unsigned)b) << 16); }
__device__ __forceinline__ u32x4 pack8u(f32x4 a, f32x4 b) { u32x4 w = {cvtpk(a[0], a[1]), cvtpk(a[2], a[3]), cvtpk(b[0], b[1]), cvtpk(b[2], b[3])}; return w; }
__device__ __forceinline__ bf16x8 pack8(f32x4 a, f32x4 b) { u32x4 w = pack8u(a, b); return *reinterpret_cast<bf16x8*>(&w); }
__device__ __forceinline__ void unpack8(u32x4 w, f32x4& a, f32x4& b) { a = (f32x4){bflo(w.x), bfhi(w.x), bflo(w.y), bfhi(w.y)}; b = (f32x4){bflo(w.z), bfhi(w.z), bflo(w.w), bfhi(w.w)}; }
__device__ __forceinline__ float fsigmoid(float x) { return __builtin_amdgcn_rcpf(1.f + __builtin_amdgcn_exp2f(-1.4426950408889634f * x)); }
__device__ __forceinline__ float gelu_tanh(float x) { const float u = x * (1.f + 0.044715f * x * x); return x * fsigmoid(1.5957691216057308f * u); }
__device__ __forceinline__ float wave_sum(float v) {
#pragma unroll
    for (int o = 1; o < 64; o <<= 1) v += __shfl_xor(v, o);
    return v;
}
__device__ __forceinline__ float quad_sum(float v) { v += __shfl_xor(v, 16); v += __shfl_xor(v, 32); return v; }

namespace pg8 {
constexpr int BM = 256, BK = 64, HALF = 128, HTB = HALF * BK * 2, STAGE_BYTES = 8 * HTB, NXCD = 8, WGM = 8;
__host__ __device__ __forceinline__ int lds_byte(int r, int c) { const int st = (r >> 4) * 2 + (c >> 5), rr = r & 15, cc = c & 31, ob = rr * 64 + cc * 2; return st * 1024 + (ob ^ (((ob >> 9) & 1) << 5)); }
__host__ __device__ __forceinline__ void stage_rc(int b, int& R, int& C) { const int st = b / 1024, sb = b % 1024, swz = sb ^ (((sb >> 9) & 1) << 5); R = (st >> 1) * 16 + swz / 64; C = (st & 1) * 32 + (swz % 64) / 2; }
__host__ __device__ __forceinline__ int perm32(int rho) { const int n = rho >> 4, i = rho & 15; return 8 * (i >> 2) + 4 * n + (i & 3); }

struct Unit { int pm, pn, ex; };

struct SchedDense {
    const bf16_t* A; const bf16_t* Bt; int K; int nM, nN, nwg, G, c;
    __device__ void init(const bf16_t* A_, const bf16_t* Bt_, int M, int N, int K_, int G_, int c_) { A = A_; Bt = Bt_; K = K_; nM = M / BM; nN = N / BM; nwg = nM * nN; G = G_; c = c_; }
    __device__ __forceinline__ bool next(int i, Unit& u) const {
        const long L = (long)i * G + c; if (L >= nwg) return false;
        int wgid = (int)L; { const int q = nwg / NXCD, r = nwg % NXCD, xcd = wgid % NXCD, off = wgid / NXCD; wgid = (xcd < r ? xcd * (q + 1) : r * (q + 1) + (xcd - r) * q) + off; }
        const int nig = WGM * nN, gid = wgid / nig, fm = gid * WGM, gsz = (nM - fm) < WGM ? (nM - fm) : WGM;
        u.pm = fm + ((wgid % nig) % gsz); u.pn = (wgid % nig) / gsz; u.ex = 0; return true;
    }
    __device__ __forceinline__ const char* a_ptr(const Unit& u) const { return (const char*)A + (size_t)u.pm * BM * K * 2; }
    __device__ __forceinline__ const char* b_ptr(const Unit& u) const { return (const char*)Bt + (size_t)u.pn * BM * K * 2; }
    __device__ __forceinline__ void a_off(const Unit&, const int (&R)[2], const int (&C)[2], unsigned (&vo)[2][2]) const {
#pragma unroll
        for (int h = 0; h < 2; ++h)
#pragma unroll
            for (int i = 0; i < 2; ++i) vo[h][i] = (unsigned)((h * HALF + R[i]) * K + C[i]) * 2u;
    }
};
struct SchedGU {
    const bf16_t* A; const int* rowtok; const bf16_t* Bt; const int* tile_e; int ntiles; int G, c;
    __device__ __forceinline__ bool next(int i, Unit& u) const {
        const int L = i * G + c; if (L >= ntiles * 2) return false;
        u.pm = L >> 1; u.pn = L & 1; u.ex = tile_e[u.pm]; return true;
    }
    __device__ __forceinline__ const char* a_ptr(const Unit&) const { return (const char*)A; }
    __device__ __forceinline__ const char* b_ptr(const Unit& u) const { return (const char*)Bt + ((size_t)u.ex * 512 + (size_t)u.pn * 256) * DM * 2; }
    __device__ __forceinline__ void a_off(const Unit& u, const int (&R)[2], const int (&C)[2], unsigned (&vo)[2][2]) const {
#pragma unroll
        for (int h = 0; h < 2; ++h)
#pragma unroll
            for (int i = 0; i < 2; ++i) { const int t = rowtok[u.pm * BM + h * HALF + R[i]]; const int tok = t < 0 ? 0 : (t >> 1); vo[h][i] = (unsigned)(tok * DM + C[i]) * 2u; }
    }
};
struct SchedDown {
    const bf16_t* A; const bf16_t* Bt; const int* tile_e; int ntiles; int G, c;
    __device__ __forceinline__ bool next(int i, Unit& u) const {
        const int L = i * G + c; if (L >= ntiles * 4) return false;
        u.pm = L >> 2; u.pn = L & 3; u.ex = tile_e[u.pm]; return true;
    }
    __device__ __forceinline__ const char* a_ptr(const Unit& u) const { return (const char*)A + (size_t)u.pm * BM * DEXP * 2; }
    __device__ __forceinline__ const char* b_ptr(const Unit& u) const { return (const char*)Bt + ((size_t)u.ex * DM + (size_t)u.pn * 256) * DEXP * 2; }
    __device__ __forceinline__ void a_off(const Unit&, const int (&R)[2], const int (&C)[2], unsigned (&vo)[2][2]) const {
#pragma unroll
        for (int h = 0; h < 2; ++h)
#pragma unroll
            for (int i = 0; i < 2; ++i) vo[h][i] = (unsigned)((h * HALF + R[i]) * DEXP + C[i]) * 2u;
    }
};

template <class Epi, class Sched>
__device__ __forceinline__ void gemm_phase(LAS unsigned char* lds, const int K_, const Sched& S, const Epi& E) {
    int tid = threadIdx.x; asm volatile("" : "+v"(tid));
    int K = K_; asm volatile("" : "+s"(K));
    const int wid = __builtin_amdgcn_readfirstlane(tid >> 6), lane = tid & 63, wr = wid >> 2, wc = wid & 3, fr = lane & 15, fq = lane >> 4;
    const int nt = K / BK;
    int RA[2], CA[2]; unsigned voffB[2];
#pragma unroll
    for (int i = 0; i < 2; ++i) { int R, C; stage_rc(tid * 16 + i * 8192, R, C); const int Rb = Epi::PERM ? ((R & ~31) + perm32(R & 31)) : R;
        RA[i] = R; CA[i] = C; voffB[i] = (unsigned)(Rb * K + C) * 2u; }
    const size_t kstep = (size_t)(BK * 2);
    const size_t hstep = (size_t)HALF * K * 2;
    const unsigned ldsw = (unsigned)wid * 1024u;
    const int aoff = lds_byte(wr * 64 + fr, fq * 8), boff = lds_byte(wc * 32 + fr, fq * 8);
#define PG8_SA(b, h) (((b) * 2 + (h)) * HTB)
#define PG8_SB(b, h) ((4 + (b) * 2 + (h)) * HTB)
#define PG8_STAGE(bufoff, gbase, voff) do { _Pragma("unroll") for (int _i = 0; _i < 2; ++_i) \
        __builtin_amdgcn_global_load_lds((const unsigned*)((const char*)(gbase) + (voff)[_i]), (LAS unsigned*)(lds + (bufoff) + ldsw + _i * 8192), 16, 0, 0); } while (0)
#define PG8_LDA(dst, b, h) do { _Pragma("unroll") for (int m = 0; m < 4; ++m) _Pragma("unroll") for (int k = 0; k < 2; ++k) dst[m][k] = *(const LAS bf16x8*)(lds + PG8_SA(b, h) + aoff + m * 2048 + k * 1024); } while (0)
#define PG8_LDB(dst, b, h) do { _Pragma("unroll") for (int n = 0; n < 2; ++n) _Pragma("unroll") for (int k = 0; k < 2; ++k) dst[n][k] = *(const LAS bf16x8*)(lds + PG8_SB(b, h) + boff + n * 2048 + k * 1024); } while (0)
#define PG8_MMA(ai, bj, At, Bt) do { __builtin_amdgcn_s_setprio(1); _Pragma("unroll") for (int m = 0; m < 4; ++m) _Pragma("unroll") for (int n = 0; n < 2; ++n) _Pragma("unroll") for (int k = 0; k < 2; ++k) \
        acc[ai][bj][m][n] = __builtin_amdgcn_mfma_f32_16x16x32_bf16(Bt[n][k], At[m][k], acc[ai][bj][m][n], 0, 0, 0); __builtin_amdgcn_s_setprio(0); } while (0)
#define PG8_WAIT_V(n) asm volatile("s_waitcnt vmcnt(" #n ")" ::: "memory")
#define PG8_WAIT_L(n) asm volatile("s_waitcnt lgkmcnt(" #n ")" ::: "memory")
#define PG8_BAR __builtin_amdgcn_s_barrier()
#define PG8_SCHED __builtin_amdgcn_sched_barrier(0)
    Unit cur, nxt; int ui = 0;
    if (!S.next(0, cur)) return;
    f32x4 acc[2][2][4][2];
#pragma unroll
    for (int a = 0; a < 2; ++a)
#pragma unroll
        for (int b = 0; b < 2; ++b)
#pragma unroll
            for (int m = 0; m < 4; ++m)
#pragma unroll
                for (int n = 0; n < 2; ++n) acc[a][b][m][n] = (f32x4){0.f, 0.f, 0.f, 0.f};
    bf16x8 At[4][2], B0[2][2], B1[2][2];
    unsigned voC[2][2], voN[2][2];
    const char* cA = S.a_ptr(cur); const char* cB = S.b_ptr(cur);
    S.a_off(cur, RA, CA, voC);
    PG8_STAGE(PG8_SB(0, 0), cB, voffB); PG8_STAGE(PG8_SA(0, 0), cA, voC[0]); PG8_STAGE(PG8_SB(0, 1), cB + hstep, voffB); PG8_STAGE(PG8_SA(0, 1), cA, voC[1]);
    if (wr == 1) PG8_BAR;
    PG8_WAIT_V(4); PG8_BAR;
    PG8_STAGE(PG8_SB(1, 0), cB + kstep, voffB); PG8_STAGE(PG8_SA(1, 0), cA + kstep, voC[0]); PG8_STAGE(PG8_SB(1, 1), cB + hstep + kstep, voffB);
    PG8_WAIT_V(6); PG8_BAR;
    for (;;) {
        const bool has_next = S.next(ui + 1, nxt);
        const char* nA = has_next ? S.a_ptr(nxt) : cA; const char* nB = has_next ? S.b_ptr(nxt) : cB;
        if (has_next) S.a_off(nxt, RA, CA, voN);
        else {
#pragma unroll
            for (int h = 0; h < 2; ++h)
#pragma unroll
                for (int i = 0; i < 2; ++i) voN[h][i] = voC[h][i]; }
#pragma nounroll
        for (int t = 0; t < nt; t += 2) {
            const bool last = (t == nt - 2);
            const char* a1 = cA + (size_t)(t + 1) * kstep;
            const char* a2 = last ? nA : cA + (size_t)(t + 2) * kstep; const char* b2 = last ? nB : cB + (size_t)(t + 2) * kstep;
            const char* a3 = a2 + kstep; const char* b3 = b2 + kstep;
            unsigned v2[2][2];
#pragma unroll
            for (int h = 0; h < 2; ++h)
#pragma unroll
                for (int i = 0; i < 2; ++i) v2[h][i] = last ? voN[h][i] : voC[h][i];
            PG8_LDB(B0, 0, 0); PG8_SCHED; PG8_LDA(At, 0, 0); PG8_STAGE(PG8_SA(1, 1), a1, voC[1]);
            PG8_WAIT_L(8); PG8_BAR; PG8_WAIT_L(0); PG8_MMA(0, 0, At, B0); PG8_BAR; PG8_SCHED;
            PG8_LDB(B1, 0, 1); PG8_STAGE(PG8_SB(0, 0), b2, voffB);
            PG8_BAR; PG8_WAIT_L(0); PG8_MMA(0, 1, At, B1); PG8_BAR;
            PG8_LDA(At, 0, 1); PG8_STAGE(PG8_SA(0, 0), a2, v2[0]);
            PG8_BAR; PG8_WAIT_L(0); PG8_MMA(1, 0, At, B0); PG8_BAR; PG8_SCHED;
            PG8_STAGE(PG8_SB(0, 1), b2 + hstep, voffB);
            PG8_WAIT_V(6); PG8_BAR; PG8_MMA(1, 1, At, B1); PG8_BAR;
            PG8_LDB(B0, 1, 0); PG8_SCHED; PG8_LDA(At, 1, 0); PG8_STAGE(PG8_SA(0, 1), a2, v2[1]);
            PG8_WAIT_L(8); PG8_BAR; PG8_WAIT_L(0); PG8_MMA(0, 0, At, B0); PG8_BAR; PG8_SCHED;
            PG8_LDB(B1, 1, 1); PG8_STAGE(PG8_SB(1, 0), b3, voffB);
            PG8_BAR; PG8_WAIT_L(0); PG8_MMA(0, 1, At, B1); PG8_BAR;
            PG8_LDA(At, 1, 1); PG8_STAGE(PG8_SA(1, 0), a3, v2[0]);
            PG8_BAR; PG8_WAIT_L(0); PG8_MMA(1, 0, At, B0); PG8_BAR; PG8_SCHED;
            PG8_STAGE(PG8_SB(1, 1), b3 + hstep, voffB);
            PG8_WAIT_V(6); PG8_BAR; PG8_MMA(1, 1, At, B1); PG8_BAR;
        }
        E(acc, cur, wr, wc, fr, fq);
        if (!has_next) break;
#pragma unroll
        for (int a = 0; a < 2; ++a)
#pragma unroll
            for (int b = 0; b < 2; ++b)
#pragma unroll
                for (int m = 0; m < 4; ++m)
#pragma unroll
                    for (int n = 0; n < 2; ++n) acc[a][b][m][n] = (f32x4){0.f, 0.f, 0.f, 0.f};
        cur = nxt; cA = nA; cB = nB; ++ui;
#pragma unroll
        for (int h = 0; h < 2; ++h)
#pragma unroll
            for (int i = 0; i < 2; ++i) voC[h][i] = voN[h][i];
    }
    PG8_WAIT_V(0);
    if (wr == 0) PG8_BAR;
    PG8_BAR;
#undef PG8_SA
#undef PG8_SB
#undef PG8_STAGE
#undef PG8_LDA
#undef PG8_LDB
#undef PG8_MMA
#undef PG8_WAIT_V
#undef PG8_WAIT_L
#undef PG8_BAR
#undef PG8_SCHED
}

typedef f32x4 Acc[2][2][4][2];
#define EPI_ROW(u, ai, wr, m, fr) ((u).pm * 256 + (ai) * 128 + (wr) * 64 + (m) * 16 + (fr))

struct EpiZ {
    static constexpr bool PERM = true;
    bf16_t *U, *V, *GA, *GB, *CQ, *CKV, *KPE; float *vpart, *cqpart, *ckvpart; const float *ropeC, *ropeS;
    __device__ __forceinline__ void operator()(const Acc& acc, const Unit& u, int wr, int wc, int fr, int fq) const {
#pragma unroll
        for (int bj = 0; bj < 2; ++bj) {
            const int cb = u.pn * 256 + bj * 128 + wc * 32;
            const int c0 = cb + 8 * fq;
            if (cb >= SEG_PAD) continue;
#pragma unroll
            for (int ai = 0; ai < 2; ++ai)
#pragma unroll
                for (int m = 0; m < 4; ++m) {
                    const int row = EPI_ROW(u, ai, wr, m, fr);
                    f32x4 v0 = acc[ai][bj][m][0], v1 = acc[ai][bj][m][1];
                    if (cb < SEG_GA) {
#pragma unroll
                        for (int j = 0; j < 4; ++j) { v0[j] = gelu_tanh(v0[j]); v1[j] = gelu_tanh(v1[j]); }
                        if (cb < SEG_V) { *(u32x4*)(U + (size_t)row * GWID + c0) = pack8u(v0, v1); }
                        else {
                            *(u32x4*)(V + (size_t)row * GWID + (c0 - SEG_V)) = pack8u(v0, v1);
                            float s = (v0[0] + v0[1]) + (v0[2] + v0[3]) + (v1[0] + v1[1]) + (v1[2] + v1[3]);
                            float q = (v0[0] * v0[0] + v0[1] * v0[1]) + (v0[2] * v0[2] + v0[3] * v0[3]) + (v1[0] * v1[0] + v1[1] * v1[1]) + (v1[2] * v1[2] + v1[3] * v1[3]);
                            s = quad_sum(s); q = quad_sum(q);
                            if (fq == 0) *(f32x2*)(vpart + ((size_t)row * 48 + ((cb - SEG_V) >> 5)) * 2) = (f32x2){s, q};
                        }
                    } else if (cb < SEG_CQ) {
#pragma unroll
                        for (int j = 0; j < 4; ++j) { v0[j] = fsigmoid(v0[j]); v1[j] = fsigmoid(v1[j]); }
                        if (cb < SEG_GB) *(u32x4*)(GA + (size_t)row * DM + (c0 - SEG_GA)) = pack8u(v0, v1);
                        else *(u32x4*)(GB + (size_t)row * DM + (c0 - SEG_GB)) = pack8u(v0, v1);
                    } else if (cb < SEG_KR) {
                        float q = (v0[0] * v0[0] + v0[1] * v0[1]) + (v0[2] * v0[2] + v0[3] * v0[3]) + (v1[0] * v1[0] + v1[1] * v1[1]) + (v1[2] * v1[2] + v1[3] * v1[3]);
                        q = quad_sum(q);
                        if (cb < SEG_CKV) { *(u32x4*)(CQ + (size_t)row * QL + (c0 - SEG_CQ)) = pack8u(v0, v1); if (fq == 0) cqpart[(size_t)row * 12 + ((cb - SEG_CQ) >> 5)] = q; }
                        else { *(u32x4*)(CKV + (size_t)row * KVL + (c0 - SEG_CKV)) = pack8u(v0, v1); if (fq == 0) ckvpart[(size_t)row * 8 + ((cb - SEG_CKV) >> 5)] = q; }
                    } else {
                        const int s = row & (NS - 1), j0 = (c0 - SEG_KR) >> 1;
                        const f32x4 cs = *(const f32x4*)(ropeC + s * 32 + j0), sn = *(const f32x4*)(ropeS + s * 32 + j0);
                        f32x4 o0, o1;
                        o0[0] = v0[0] * cs[0] - v0[1] * sn[0]; o0[1] = v0[0] * sn[0] + v0[1] * cs[0];
                        o0[2] = v0[2] * cs[1] - v0[3] * sn[1]; o0[3] = v0[2] * sn[1] + v0[3] * cs[1];
                        o1[0] = v1[0] * cs[2] - v1[1] * sn[2]; o1[1] = v1[0] * sn[2] + v1[1] * cs[2];
                        o1[2] = v1[2] * cs[3] - v1[3] * sn[3]; o1[3] = v1[2] * sn[3] + v1[3] * cs[3];
                        *(u32x4*)(KPE + (size_t)row * RD + (c0 - SEG_KR)) = pack8u(o0, o1);
                    }
                }
        }
    }
};
struct EpiMul {
    static constexpr bool PERM = true;
    bf16_t* G;
    __device__ __forceinline__ void operator()(const Acc& acc, const Unit& u, int wr, int wc, int fr, int fq) const {
#pragma unroll
        for (int ai = 0; ai < 2; ++ai)
#pragma unroll
            for (int m = 0; m < 4; ++m) {
                const int row = EPI_ROW(u, ai, wr, m, fr);
#pragma unroll
                for (int bj = 0; bj < 2; ++bj) {
                    u32x4* p = (u32x4*)(G + (size_t)row * DM + u.pn * 256 + bj * 128 + wc * 32 + 8 * fq);
                    f32x4 g0, g1; unpack8(*p, g0, g1);
                    *p = pack8u(g0 * acc[ai][bj][m][0], g1 * acc[ai][bj][m][1]);
                }
                asm volatile("" ::: "memory");
            }
    }
};
struct EpiMulAdd {
    static constexpr bool PERM = true;
    bf16_t* MA; const bf16_t* GB;
    __device__ __forceinline__ void operator()(const Acc& acc, const Unit& u, int wr, int wc, int fr, int fq) const {
#pragma unroll
        for (int ai = 0; ai < 2; ++ai)
#pragma unroll
            for (int m = 0; m < 4; ++m) {
                const int row = EPI_ROW(u, ai, wr, m, fr);
#pragma unroll
                for (int bj = 0; bj < 2; ++bj) {
                    const size_t off = (size_t)row * DM + u.pn * 256 + bj * 128 + wc * 32 + 8 * fq;
                    u32x4* p = (u32x4*)(MA + off);
                    f32x4 a0, a1, g0, g1; unpack8(*p, a0, a1); unpack8(*(const u32x4*)(GB + off), g0, g1);
                    *p = pack8u(a0 + g0 * acc[ai][bj][m][0], a1 + g1 * acc[ai][bj][m][1]);
                }
                asm volatile("" ::: "memory");
            }
    }
};
struct EpiRes {
    static constexpr bool PERM = false;
    const float* X; float* H;
    __device__ __forceinline__ void operator()(const Acc& acc, const Unit& u, int wr, int wc, int fr, int fq) const {
#pragma unroll
        for (int ai = 0; ai < 2; ++ai)
#pragma unroll
            for (int m = 0; m < 4; ++m) {
                const int row = EPI_ROW(u, ai, wr, m, fr);
#pragma unroll
                for (int bj = 0; bj < 2; ++bj)
#pragma unroll
                    for (int n = 0; n < 2; ++n) {
                        const size_t off = (size_t)row * DM + u.pn * 256 + bj * 128 + wc * 32 + 16 * n + 4 * fq;
                        *(f32x4*)(H + off) = *(const f32x4*)(X + off) + acc[ai][bj][m][n];
                    }
                asm volatile("" ::: "memory");
            }
    }
};
struct EpiQ {
    static constexpr bool PERM = true;
    bf16_t *QN, *QR; const float* cqpart; const float *ropeC, *ropeS;
    __device__ __forceinline__ void operator()(const Acc& acc, const Unit& u, int wr, int wc, int fr, int fq) const {
#pragma unroll
        for (int ai = 0; ai < 2; ++ai)
#pragma unroll
            for (int m = 0; m < 4; ++m) {
                const int row = EPI_ROW(u, ai, wr, m, fr);
                const f32x4* pp = (const f32x4*)(cqpart + (size_t)row * 12);
                const f32x4 p0 = pp[0], p1 = pp[1], p2 = pp[2];
                const float ss = ((p0[0] + p0[1]) + (p0[2] + p0[3])) + ((p1[0] + p1[1]) + (p1[2] + p1[3])) + ((p2[0] + p2[1]) + (p2[2] + p2[3]));
                const float rstd = __builtin_amdgcn_rsqf(ss * (1.f / QL) + EPS);
                const int b = row >> 12, s = row & (NS - 1);
#pragma unroll
                for (int bj = 0; bj < 2; ++bj) {
                    const int c0 = u.pn * 256 + bj * 128 + wc * 32 + 8 * fq;
                    f32x4 v0 = acc[ai][bj][m][0] * rstd, v1 = acc[ai][bj][m][1] * rstd;
                    if (u.pn < 4) {
                        const int h = c0 >> 7, d = c0 & 127;
                        *(u32x4*)(QN + (((size_t)(b * NH + h)) * NS + s) * 128 + d) = pack8u(v0, v1);
                    } else {
                        const int cc = c0 - 1024, h = cc >> 6, i0 = cc & 63, j0 = i0 >> 1;
                        const f32x4 cs = *(const f32x4*)(ropeC + s * 32 + j0), sn = *(const f32x4*)(ropeS + s * 32 + j0);
                        f32x4 o0, o1;
                        o0[0] = v0[0] * cs[0] - v0[1] * sn[0]; o0[1] = v0[0] * sn[0] + v0[1] * cs[0];
                        o0[2] = v0[2] * cs[1] - v0[3] * sn[1]; o0[3] = v0[2] * sn[1] + v0[3] * cs[1];
                        o1[0] = v1[0] * cs[2] - v1[1] * sn[2]; o1[1] = v1[0] * sn[2] + v1[1] * cs[2];
                        o1[2] = v1[2] * cs[3] - v1[3] * sn[3]; o1[3] = v1[2] * sn[3] + v1[3] * cs[3];
                        *(u32x4*)(QR + (((size_t)(b * NH + h)) * NS + s) * RD + i0) = pack8u(o0, o1);
                    }
                }
                asm volatile("" ::: "memory");
            }
    }
};
struct EpiKV {
    static constexpr bool PERM = true;
    bf16_t *KN, *VV; const float* ckvpart;
    __device__ __forceinline__ void operator()(const Acc& acc, const Unit& u, int wr, int wc, int fr, int fq) const {
#pragma unroll
        for (int ai = 0; ai < 2; ++ai)
#pragma unroll
            for (int m = 0; m < 4; ++m) {
                const int row = EPI_ROW(u, ai, wr, m, fr);
                const f32x4* pp = (const f32x4*)(ckvpart + (size_t)row * 8);
                const f32x4 p0 = pp[0], p1 = pp[1];
                const float ss = ((p0[0] + p0[1]) + (p0[2] + p0[3])) + ((p1[0] + p1[1]) + (p1[2] + p1[3]));
                const float rstd = __builtin_amdgcn_rsqf(ss * (1.f / KVL) + EPS);
                const int b = row >> 12, s = row & (NS - 1);
                const size_t o = (((size_t)(b * NH + u.pn)) * NS + s) * 128 + wc * 32 + 8 * fq;
                *(u32x4*)(KN + o) = pack8u(acc[ai][0][m][0] * rstd, acc[ai][0][m][1] * rstd);
                *(u32x4*)(VV + o) = pack8u(acc[ai][1][m][0] * rstd, acc[ai][1][m][1] * rstd);
                asm volatile("" ::: "memory");
            }
    }
};
struct EpiRouter {
    static constexpr bool PERM = false;
    float* LOG;
    __device__ __forceinline__ void operator()(const Acc& acc, const Unit& u, int wr, int wc, int fr, int fq) const {
        if (wc > 2) return;
#pragma unroll
        for (int ai = 0; ai < 2; ++ai)
#pragma unroll
            for (int m = 0; m < 4; ++m) {
                const int row = EPI_ROW(u, ai, wr, m, fr);
#pragma unroll
                for (int n = 0; n < 2; ++n) { const int c = wc * 32 + 16 * n + 4 * fq; if (c < 72) *(f32x4*)(LOG + (size_t)row * 72 + c) = acc[ai][0][m][n]; }
            }
    }
};
struct EpiGU {
    static constexpr bool PERM = true;
    bf16_t* HID;
    __device__ __forceinline__ void operator()(const Acc& acc, const Unit& u, int wr, int wc, int fr, int fq) const {
#pragma unroll
        for (int ai = 0; ai < 2; ++ai)
#pragma unroll
            for (int m = 0; m < 4; ++m) {
                const int slot = EPI_ROW(u, ai, wr, m, fr);
                f32x4 h0, h1;
#pragma unroll
                for (int j = 0; j < 4; ++j) { const float g0 = acc[ai][0][m][0][j], g1 = acc[ai][0][m][1][j];
                    h0[j] = g0 * fsigmoid(g0) * acc[ai][1][m][0][j]; h1[j] = g1 * fsigmoid(g1) * acc[ai][1][m][1][j]; }
                *(u32x4*)(HID + (size_t)slot * DEXP + u.pn * 128 + wc * 32 + 8 * fq) = pack8u(h0, h1);
            }
    }
};
struct EpiDown {
    static constexpr bool PERM = true;
    bf16_t* YS; const int* rowtok; const float* roww;
    __device__ __forceinline__ void operator()(const Acc& acc, const Unit& u, int wr, int wc, int fr, int fq) const {
#pragma unroll
        for (int ai = 0; ai < 2; ++ai)
#pragma unroll
            for (int m = 0; m < 4; ++m) {
                const int slot = EPI_ROW(u, ai, wr, m, fr);
                const int t = rowtok[slot];
                if (t >= 0) {
                    const float w = roww[slot];
                    bf16_t* dst = YS + ((size_t)(t & 1) * MROWS + (t >> 1)) * DM + u.pn * 256 + wc * 32 + 8 * fq;
#pragma unroll
                    for (int bj = 0; bj < 2; ++bj) *(u32x4*)(dst + bj * 128) = pack8u(acc[ai][bj][m][0] * w, acc[ai][bj][m][1] * w);
                }
                asm volatile("" ::: "memory");
            }
    }
};
struct EpiPP {
    static constexpr bool PERM = true;
    bf16_t* PP;
    __device__ __forceinline__ void operator()(const Acc& acc, const Unit& u, int wr, int wc, int fr, int fq) const {
#pragma unroll
        for (int ai = 0; ai < 2; ++ai)
#pragma unroll
            for (int m = 0; m < 4; ++m) {
                const int row = EPI_ROW(u, ai, wr, m, fr);
#pragma unroll
                for (int bj = 0; bj < 2; ++bj) *(u32x4*)(PP + (size_t)row * DM + u.pn * 256 + bj * 128 + wc * 32 + 8 * fq) = pack8u(acc[ai][bj][m][0], acc[ai][bj][m][1]);
            }
    }
};
struct EpiPLE {
    static constexpr bool PERM = false;
    float* H; const bf16_t* PP; const float* rstd3;
    __device__ __forceinline__ void operator()(const Acc& acc, const Unit& u, int wr, int wc, int fr, int fq) const {
#pragma unroll
        for (int ai = 0; ai < 2; ++ai)
#pragma unroll
            for (int m = 0; m < 4; ++m) {
                const int row = EPI_ROW(u, ai, wr, m, fr);
                const float rs = rstd3[row];
#pragma unroll
                for (int bj = 0; bj < 2; ++bj)
#pragma unroll
                    for (int n = 0; n < 2; ++n) {
                        const size_t off = (size_t)row * DM + u.pn * 256 + bj * 128 + wc * 32 + 16 * n + 4 * fq;
                        const u32x2 pw = *(const u32x2*)(PP + off);
                        const f32x4 pp = {bflo(pw.x), bfhi(pw.x), bflo(pw.y), bfhi(pw.y)};
                        f32x4 h = *(const f32x4*)(H + off); const f32x4 a = acc[ai][bj][m][n];
#pragma unroll
                        for (int j = 0; j < 4; ++j) h[j] += fsigmoid(a[j] * rs) * pp[j];
                        *(f32x4*)(H + off) = h;
                    }
                asm volatile("" ::: "memory");
            }
    }
};
}

namespace att {
constexpr int SHM_V = 16384, SHM_KN = 16384, SHM_KR = 8192;
constexpr int OFF_V = 0, OFF_KN = 32768, OFF_KR = 65536, OFF_WS = 81920;
constexpr float SCALE = 0.07216878364870322f;
constexpr float THR = 8.f;
#define KSWZ(row, colB) ((row) * 256 + ((colB) ^ (((row) & 7) << 4)))
#define KRSWZ(row, colB) ((row) * 128 + ((colB) ^ ((((row) >> 1) & 7) << 4)))
#define SBAR() __builtin_amdgcn_sched_barrier(0)
__device__ __forceinline__ int v_st(int k, int c) { const int kk = (k & ~0xC) | ((k & 4) << 1) | ((k & 8) >> 1); return ((kk >> 3) * 4 + (c >> 5)) * 512 + ((kk & 7) * 32 + (c & 31)) * 2; }
__device__ __forceinline__ int v_rd_base(int lane) { return ((lane & 3) << 3) | (((lane >> 2) & 3) << 6) | (((lane >> 4) & 1) << 5) | (((lane >> 5) & 1) << 8); }
constexpr int v_rd_off(int d0, int ks, int half) { return d0 * 512 + ks * 4096 + half * 2048; }
__device__ __forceinline__ int crow(int r, int hi) { return (r & 3) + 8 * (r >> 2) + 4 * hi; }

__device__ __forceinline__ void partialSM(f32x16& p0, f32x16& p1, float& m_reg, float& mn, float& alpha) {
    float pmax = p0[0];
#pragma unroll
    for (int r = 1; r < 16; ++r) pmax = fmaxf(pmax, p0[r]);
#pragma unroll
    for (int r = 0; r < 16; ++r) pmax = fmaxf(pmax, p1[r]);
    { auto rr = __builtin_amdgcn_permlane32_swap(__float_as_uint(pmax), __float_as_uint(pmax), false, false);
      pmax = fmaxf(__uint_as_float(rr[0]), __uint_as_float(rr[1])); }
    constexpr float C2 = 1.4426950408889634f * SCALE;
    if (__builtin_expect(__all((pmax - m_reg) * SCALE <= THR), 1)) { mn = m_reg; alpha = 1.f; }
    else { mn = fmaxf(m_reg, pmax); alpha = __builtin_amdgcn_exp2f((m_reg - mn) * C2); m_reg = mn; }
    const float mnL = -mn * C2;
#pragma unroll
    for (int r = 0; r < 16; ++r) p0[r] = fmaf(p0[r], C2, mnL);
#pragma unroll
    for (int r = 0; r < 16; ++r) p1[r] = fmaf(p1[r], C2, mnL);
#pragma unroll
    for (int r = 0; r < 16; ++r) p0[r] = __builtin_amdgcn_exp2f(p0[r]);
}
__device__ __forceinline__ void finishSM(f32x16& p0, f32x16& p1, float alpha, float& l_reg, bf16x8& pa0, bf16x8& pa1, bf16x8& pa2, bf16x8& pa3) {
#pragma unroll
    for (int r = 0; r < 16; ++r) p1[r] = __builtin_amdgcn_exp2f(p1[r]);
    float ps = 0;
#pragma unroll
    for (int r = 0; r < 16; ++r) ps += p0[r];
#pragma unroll
    for (int r = 0; r < 16; ++r) ps += p1[r];
    { auto rr = __builtin_amdgcn_permlane32_swap(__float_as_uint(ps), __float_as_uint(ps), false, false);
      ps = __uint_as_float(rr[0]) + __uint_as_float(rr[1]); }
    l_reg = l_reg * alpha + ps;
#define PK4(P, B_, OUT) do { unsigned a0 = cvtpk(P[B_+0], P[B_+1]), a1 = cvtpk(P[B_+2], P[B_+3]);                          \
        unsigned b0 = cvtpk(P[B_+4], P[B_+5]), b1 = cvtpk(P[B_+6], P[B_+7]);                                             \
        auto r0 = __builtin_amdgcn_permlane32_swap(a0, b0, false, false); auto r1 = __builtin_amdgcn_permlane32_swap(a1, b1, false, false); \
        u32x4 w = {r0[0], r1[0], r0[1], r1[1]}; OUT = *reinterpret_cast<bf16x8*>(&w); } while (0)
    PK4(p0, 0, pa0); PK4(p0, 8, pa1); PK4(p1, 0, pa2); PK4(p1, 8, pa3);
#undef PK4
}
template <int KB>
__device__ __forceinline__ void qkt(f32x16& p0, f32x16& p1, const char* lds, int r32, int hi, const bf16x8* qr) {
    p0 = f32x16{}; p1 = f32x16{};
    const char* kb[4];
#pragma unroll
    for (int dd = 0; dd < 4; ++dd) kb[dd] = lds + OFF_KN + KB * SHM_KN + KSWZ(r32, (dd * 16 + hi * 8) * 2);
#pragma unroll
    for (int d0 = 0; d0 < 8; ++d0) { const char* a = kb[d0 & 3] + (d0 >> 2) * 128;
        bf16x8 b0 = *reinterpret_cast<const bf16x8*>(a);
        bf16x8 b1 = *reinterpret_cast<const bf16x8*>(a + 32 * 256);
        p0 = __builtin_amdgcn_mfma_f32_32x32x16_bf16(b0, qr[d0], p0, 0, 0, 0);
        p1 = __builtin_amdgcn_mfma_f32_32x32x16_bf16(b1, qr[d0], p1, 0, 0, 0); }
#pragma unroll
    for (int dd = 0; dd < 4; ++dd) { const char* a = lds + OFF_KR + KB * SHM_KR + KRSWZ(r32, (dd * 16 + hi * 8) * 2);
        bf16x8 b0 = *reinterpret_cast<const bf16x8*>(a);
        bf16x8 b1 = *reinterpret_cast<const bf16x8*>(a + 32 * 128);
        p0 = __builtin_amdgcn_mfma_f32_32x32x16_bf16(b0, qr[8 + dd], p0, 0, 0, 0);
        p1 = __builtin_amdgcn_mfma_f32_32x32x16_bf16(b1, qr[8 + dd], p1, 0, 0, 0); }
}
#define TRRD(dst, off) asm volatile("ds_read_b64_tr_b16 %0, %1 offset:%2" : "=&v"(dst) : "v"(vb0), "i"(off) : "memory")
template <int VB, int D0, int OI>
__device__ __forceinline__ void pv_d0(f32x16* o, int vb0, bf16x8 pa0, bf16x8 pa1, bf16x8 pa2, bf16x8 pa3) {
    s16x4 l0, l1, l2, l3, h0, h1, h2, h3; constexpr int b_ = VB * SHM_V + v_rd_off(D0, 0, 0);
    TRRD(l0, b_); TRRD(h0, b_ + 2048); TRRD(l1, b_ + 4096); TRRD(h1, b_ + 6144); TRRD(l2, b_ + 8192); TRRD(h2, b_ + 10240); TRRD(l3, b_ + 12288); TRRD(h3, b_ + 14336);
    asm volatile("s_waitcnt lgkmcnt(0)" ::: "memory"); SBAR();
    o[OI] = __builtin_amdgcn_mfma_f32_32x32x16_bf16(pa0, (bf16x8){l0[0], l0[1], l0[2], l0[3], h0[0], h0[1], h0[2], h0[3]}, o[OI], 0, 0, 0);
    o[OI] = __builtin_amdgcn_mfma_f32_32x32x16_bf16(pa1, (bf16x8){l1[0], l1[1], l1[2], l1[3], h1[0], h1[1], h1[2], h1[3]}, o[OI], 0, 0, 0);
    o[OI] = __builtin_amdgcn_mfma_f32_32x32x16_bf16(pa2, (bf16x8){l2[0], l2[1], l2[2], l2[3], h2[0], h2[1], h2[2], h2[3]}, o[OI], 0, 0, 0);
    o[OI] = __builtin_amdgcn_mfma_f32_32x32x16_bf16(pa3, (bf16x8){l3[0], l3[1], l3[2], l3[3], h3[0], h3[1], h3[2], h3[3]}, o[OI], 0, 0, 0);
}
template <int VB>
__device__ __forceinline__ void pv_tile(f32x16* o, int vb0, bf16x8 pa0, bf16x8 pa1, bf16x8 pa2, bf16x8 pa3) {
    pv_d0<VB, 0, 0>(o, vb0, pa0, pa1, pa2, pa3); pv_d0<VB, 1, 1>(o, vb0, pa0, pa1, pa2, pa3);
    pv_d0<VB, 2, 2>(o, vb0, pa0, pa1, pa2, pa3); pv_d0<VB, 3, 3>(o, vb0, pa0, pa1, pa2, pa3);
}
template <int VB, int CH>
__device__ __forceinline__ void pv_half(f32x16* o, int vb0, bf16x8 pa0, bf16x8 pa1, bf16x8 pa2, bf16x8 pa3) {
    pv_d0<VB, 2 * CH, 0>(o, vb0, pa0, pa1, pa2, pa3); pv_d0<VB, 2 * CH + 1, 1>(o, vb0, pa0, pa1, pa2, pa3);
}

__device__ __forceinline__ void attn_block(char* lds, const bf16_t* QN, const bf16_t* QR, const bf16_t* KN, const bf16_t* KPE, const bf16_t* VV, bf16_t* O, int bh, int qb) {
    int tid = threadIdx.x; asm volatile("" : "+v"(tid));
    const int wid = __builtin_amdgcn_readfirstlane(tid >> 6), lane = tid & 63, r32 = lane & 31, hi = lane >> 5;
    const int b = bh >> 3, h = bh & 7, P0 = qb * 256, NT = 4 * qb + 4;
    const int cw = (P0 + 32 * wid) >> 6;
    bf16x8 qr[12];
    { const bf16_t* qn = QN + ((size_t)bh * NS + P0 + wid * 32 + r32) * 128; const bf16_t* qp = QR + ((size_t)bh * NS + P0 + wid * 32 + r32) * RD;
#pragma unroll
      for (int d0 = 0; d0 < 8; ++d0) qr[d0] = *(const bf16x8*)(qn + d0 * 16 + hi * 8);
#pragma unroll
      for (int dd = 0; dd < 4; ++dd) qr[8 + dd] = *(const bf16x8*)(qp + dd * 16 + hi * 8); }
    const bf16_t* Kh = KN + (size_t)bh * NS * 128; const bf16_t* Vh = VV + (size_t)bh * NS * 128; const bf16_t* Kp = KPE + (size_t)b * NS * RD;
    const int sr = tid >> 4, sc = (tid & 15) * 8, rr = tid >> 3, rc = (tid & 7) * 8;
    const int kws = KSWZ(sr, sc * 2), vst0 = v_st(sr, sc), vst1 = v_st(32 + sr, sc), krw = KRSWZ(rr, rc * 2);
    const int vb0 = (int)(uintptr_t)(lds + OFF_V) + v_rd_base(lane);
    float* wsf = (float*)(lds + OFF_WS) + wid * 64; float* li_l = wsf; float* al_l = wsf + 32;
    bf16x8 sk0, sk1, sv0, sv1, skr;
#define SLOAD(k0) do { sk0 = *(const bf16x8*)(Kh + (size_t)((k0) + sr) * 128 + sc); sk1 = *(const bf16x8*)(Kh + (size_t)((k0) + 32 + sr) * 128 + sc); \
        sv0 = *(const bf16x8*)(Vh + (size_t)((k0) + sr) * 128 + sc); sv1 = *(const bf16x8*)(Vh + (size_t)((k0) + 32 + sr) * 128 + sc); \
        skr = *(const bf16x8*)(Kp + (size_t)((k0) + rr) * RD + rc); } while (0)
#define SWRITE(bf) do { *(bf16x8*)(lds + OFF_KN + (bf) * SHM_KN + kws) = sk0; *(bf16x8*)(lds + OFF_KN + (bf) * SHM_KN + kws + 32 * 256) = sk1; \
        *(bf16x8*)(lds + OFF_V + (bf) * SHM_V + vst0) = sv0; *(bf16x8*)(lds + OFF_V + (bf) * SHM_V + vst1) = sv1; \
        *(bf16x8*)(lds + OFF_KR + (bf) * SHM_KR + krw) = skr; } while (0)
    float m_reg = -1e30f, l_reg = 0.f; f32x16 o[4] = {};
    __syncthreads();
    SLOAD(0); SWRITE(0);
    __syncthreads();
#define COMPUTE(KB) do { f32x16 p0, p1; float mn, alpha; bf16x8 pa0, pa1, pa2, pa3; \
        qkt<KB>(p0, p1, lds, r32, hi, qr); partialSM(p0, p1, m_reg, mn, alpha); \
        if (__any(alpha < 1.f)) { if (hi == 0) al_l[r32] = alpha; asm volatile("s_waitcnt lgkmcnt(0)" ::: "memory"); \
            _Pragma("unroll") for (int r = 0; r < 16; ++r) { const float a_ = al_l[crow(r, hi)]; _Pragma("unroll") for (int d_ = 0; d_ < 4; ++d_) o[d_][r] *= a_; } } \
        finishSM(p0, p1, alpha, l_reg, pa0, pa1, pa2, pa3); SBAR(); \
        pv_tile<KB>(o, vb0, pa0, pa1, pa2, pa3); } while (0)
    for (int t = 0; t < NT; t += 2) {
        SLOAD((t + 1) * 64);
        if (t <= cw) COMPUTE(0);
        SWRITE(1);
        __syncthreads();
        if (t + 2 < NT) SLOAD((t + 2) * 64);
        if (t + 1 <= cw) COMPUTE(1);
        if (t + 2 < NT) SWRITE(0);
        __syncthreads();
    }
#undef COMPUTE
#undef SLOAD
#undef SWRITE
    if (hi == 0) li_l[r32] = l_reg;
    asm volatile("s_waitcnt lgkmcnt(0)" ::: "memory");
    float rli[16];
#pragma unroll
    for (int r = 0; r < 16; ++r) rli[r] = __builtin_amdgcn_rcpf(li_l[crow(r, hi)]);
    bf16_t* Ow = O + ((size_t)b * NS + P0 + wid * 32) * DM + h * 128;
#pragma unroll
    for (int r = 0; r < 16; ++r) { const int orow = crow(r, hi);
#pragma unroll
        for (int d0 = 0; d0 < 4; ++d0) { const float v = o[d0][r] * rli[r]; const float vn = __shfl_xor(v, 1);
            if ((r32 & 1) == 0) *(unsigned*)(Ow + (size_t)orow * DM + d0 * 32 + r32) = cvtpk(v, vn); } }
}
__device__ __forceinline__ void attn_phase(char* lds, const bf16_t* QN, const bf16_t* QR, const bf16_t* KN, const bf16_t* KPE, const bf16_t* VV, bf16_t* O, int G, int blk) {
    for (int L = blk; L < 512; L += G) {
        const int xcd = L & 7, k = L >> 3, bh = xcd * 8 + (k >> 3), y = k & 7;
        attn_block(lds, QN, QR, KN, KPE, VV, O, bh, 15 - y);
        attn_block(lds, QN, QR, KN, KPE, VV, O, bh, y);
    }
}

__device__ __forceinline__ void spatial_phase(char* lds, const bf16_t* U, const bf16_t* V, const float* vpart, const float* g_gv, const bf16_t* Wsp, const float* bsp, bf16_t* Y, int G, int blk0) {
    int tid = threadIdx.x; asm volatile("" : "+v"(tid));
    const int wid = __builtin_amdgcn_readfirstlane(tid >> 6), lane = tid & 63, r32 = lane & 31, hi = lane >> 5;
    float* mu_l = (float*)(lds + 40960); float* rs_l = mu_l + 128;
    const int vb0 = (int)(uintptr_t)(lds + OFF_V) + v_rd_base(lane);
    const int sr = tid >> 4, sc = (tid & 15) * 8;
    const int ts = (wid & 3) * 32, ch = wid >> 2;
    for (int blk = blk0; blk < MROWS / 128; blk += G) {
        __syncthreads();
        if (tid < 128) { const f32x2* pp = (const f32x2*)(vpart + (size_t)(blk * 128 + tid) * 96); float s = 0.f, q = 0.f;
            for (int i = 0; i < 48; ++i) { const f32x2 v = pp[i]; s += v.x; q += v.y; }
            const float mean = s * (1.f / GWID); float var = q * (1.f / GWID) - mean * mean; var = var < 0.f ? 0.f : var;
            mu_l[tid] = mean; rs_l[tid] = __builtin_amdgcn_rsqf(var + EPS); }
        __syncthreads();
        for (int g = 0; g < 12; ++g) {
            { f32x4 gg0 = *(const f32x4*)(g_gv + g * 128 + sc), gg1 = *(const f32x4*)(g_gv + g * 128 + sc + 4);
#pragma unroll
              for (int q = 0; q < 4; ++q) { const int s = sr + 32 * q; const u32x4 w = *(const u32x4*)(V + (size_t)(blk * 128 + s) * GWID + g * 128 + sc);
                f32x4 a, b2; unpack8(w, a, b2); const float mu = mu_l[s], rs = rs_l[s];
                a = (a - mu) * rs * gg0; b2 = (b2 - mu) * rs * gg1;
                *(bf16x8*)(lds + OFF_V + (q >> 1) * SHM_V + v_st(s & 63, sc)) = pack8(a, b2); } }
            __syncthreads();
            f32x16 o[2] = {};
            const bf16_t* wrow = Wsp + ((size_t)(g * 128 + ts + r32)) * 128 + hi * 8;
            { bf16x8 pa0 = *(const bf16x8*)(wrow), pa1 = *(const bf16x8*)(wrow + 16), pa2 = *(const bf16x8*)(wrow + 32), pa3 = *(const bf16x8*)(wrow + 48);
              if (ch == 0) pv_half<0, 0>(o, vb0, pa0, pa1, pa2, pa3); else pv_half<0, 1>(o, vb0, pa0, pa1, pa2, pa3); }
            if (ts >= 64) { bf16x8 pa0 = *(const bf16x8*)(wrow + 64), pa1 = *(const bf16x8*)(wrow + 80), pa2 = *(const bf16x8*)(wrow + 96), pa3 = *(const bf16x8*)(wrow + 112);
              if (ch == 0) pv_half<1, 0>(o, vb0, pa0, pa1, pa2, pa3); else pv_half<1, 1>(o, vb0, pa0, pa1, pa2, pa3); }
#pragma unroll
            for (int r = 0; r < 16; ++r) { const int t = ts + crow(r, hi); const float bb = bsp[g * 128 + t];
#pragma unroll
                for (int dd = 0; dd < 2; ++dd) { const size_t idx = (size_t)(blk * 128 + t) * GWID + g * 128 + (2 * ch + dd) * 32 + r32;
                    const float yv = bf2f(U[idx]) * (o[dd][r] + bb); const float yn = __shfl_xor(yv, 1);
                    if ((r32 & 1) == 0) *(unsigned*)(Y + idx) = cvtpk(yv, yn); } }
            __syncthreads();
        }
    }
}
#undef TRRD
#undef KSWZ
#undef KRSWZ
#undef SBAR
}

constexpr int NWAVES = 8, NTHREADS = 512;
constexpr int LDS_BYTES = 147456;
constexpr int NPHASE = 17;

struct Args {
    const float* in[26]; float* out; unsigned char* ws; int ph_lo, ph_hi;
};

enum { MAP_ID = 0, MAP_WIN = 1, MAP_WUQ = 2, MAP_GATE = 3, MAP_UP = 4 };
__device__ __forceinline__ int rowmap(int kind, int n) {
    if (kind == MAP_WIN) {
        if (n < 3072) return n;
        if (n < 3456) return SEG_CQ + (n - 3072);
        if (n < 3712) return SEG_CKV + (n - 3456);
        if (n < 3776) { const int j = n - 3712; return SEG_KR + (j < 32 ? 2 * j : 2 * (j - 32) + 1); }
        if (n < 4800) return SEG_GA + (n - 3776);
        return SEG_GB + (n - 4800);
    }
    if (kind == MAP_WUQ) { const int h = n / 192, r = n % 192; if (r < 128) return h * 128 + r; const int j = r - 128; return 1024 + h * 64 + (j < 32 ? 2 * j : 2 * (j - 32) + 1); }
    if (kind == MAP_GATE) return (n >> 7) * 256 + (n & 127);
    if (kind == MAP_UP) return (n >> 7) * 256 + 128 + (n & 127);
    return n;
}
__device__ __forceinline__ void transpose_item(const float* W, int K, int N, const float* kscale, bf16_t* WT, int kind, LAS float* scr, int item, int lane) {
    const int nblk = N / 32, kb = item / nblk, nb = item % nblk, k0 = 64 * kb, n0 = 32 * nb;
#pragma unroll 8
    for (int i = 0; i < 32; ++i) { const int kk = 2 * i + (lane >> 5); float v = W[(size_t)(k0 + kk) * N + n0 + (lane & 31)]; if (kscale) v *= kscale[k0 + kk]; scr[kk * 33 + (lane & 31)] = v; }
    asm volatile("s_waitcnt lgkmcnt(0)" ::: "memory");
    const int c = lane & 7;
#pragma unroll
    for (int j = 0; j < 4; ++j) { const int n = (lane >> 3) + 8 * j; const LAS float* s = scr + (8 * c) * 33 + n;
        u32x4 o; o.x = cvtpk(s[0 * 33], s[1 * 33]); o.y = cvtpk(s[2 * 33], s[3 * 33]); o.z = cvtpk(s[4 * 33], s[5 * 33]); o.w = cvtpk(s[6 * 33], s[7 * 33]);
        *(u32x4*)(WT + (size_t)rowmap(kind, n0 + n) * K + k0 + 8 * c) = o; }
    asm volatile("s_waitcnt lgkmcnt(0)" ::: "memory");
}
__device__ __forceinline__ void transpose_job(const float* W, int K, int N, const float* kscale, bf16_t* WT, int kind, LAS float* scr, int gw, int NGW, int lane) {
    const int nitems = (K / 64) * (N / 32);
    for (int it = gw; it < nitems; it += NGW) transpose_item(W, K, N, kscale, WT, kind, scr, it, lane);
}
__device__ __forceinline__ void rms_row_to_bf16(const float* xrow, const float* gain, bf16_t* orow, int lane) {
    const f32x4* xr = (const f32x4*)xrow + lane; f32x4 v[4]; float s = 0.f;
#pragma unroll
    for (int j = 0; j < 4; ++j) { v[j] = xr[64 * j]; s += (v[j][0] * v[j][0] + v[j][1] * v[j][1]) + (v[j][2] * v[j][2] + v[j][3] * v[j][3]); }
    const float rstd = 1.f / sqrtf(wave_sum(s) * (1.f / DM) + EPS);
    u32x2* o8 = (u32x2*)orow + lane;
#pragma unroll
    for (int j = 0; j < 4; ++j) { const f32x4 g = ((const f32x4*)gain)[lane + 64 * j]; const f32x4 w = v[j] * rstd * g; o8[64 * j] = (u32x2){cvtpk(w[0], w[1]), cvtpk(w[2], w[3])}; }
}

__global__ void __launch_bounds__(NTHREADS, 2) fwd_kernel(Args args) {
    extern __shared__ __attribute__((aligned(16))) unsigned char lds[];
    LAS unsigned char* ldsl = (LAS unsigned char*)lds;
    const int tid = threadIdx.x, lane = tid & 63, wave = __builtin_amdgcn_readfirstlane(tid >> 6);
    const int G = gridDim.x, blk = blockIdx.x;
    const int gw = blk * NWAVES + wave, NGW = G * NWAVES;
    unsigned char* ws = args.ws;
    const float* x = args.in[0]; const float* p_in = args.in[1]; const float* g_mix = args.in[2]; const float* w_in = args.in[3]; const float* g_gv = args.in[4];
    const float* w_spatial = args.in[5]; const float* b_spatial = args.in[6]; const float* w_gproj = args.in[7]; const float* g_cq = args.in[8]; const float* w_uq = args.in[9];
    const float* g_ckv = args.in[10]; const float* w_ukv = args.in[11]; const float* w_mla_o = args.in[12]; const float* w_out = args.in[13]; const float* g_moe = args.in[14];
    const float* w_router_g = args.in[15]; const float* b_router_g = args.in[16]; const float* w_router_e = args.in[17]; const float* b_router_e = args.in[18];
    const float* w_e_gate = args.in[19]; const float* w_e_up = args.in[20]; const float* w_e_down = args.in[21]; const float* g_ple = args.in[22];
    const float* w_ple_gate = args.in[23]; const float* w_ple_proj = args.in[24]; const float* g_final = args.in[25];
    float* out = args.out;
    int* ctl = (int*)(ws + WS_CTL); int* chunkcnt = (int*)(ws + WS_CHUNKCNT); u32x4* tokinfo = (u32x4*)(ws + WS_TOKINFO);
    int* rowtok = (int*)(ws + WS_ROWTOK); float* roww = (float*)(ws + WS_ROWW);
    float* ropeC = (float*)(ws + WS_ROPEC); float* ropeS = (float*)(ws + WS_ROPES);
    bf16_t* Win_t = (bf16_t*)(ws + WS_WIN); bf16_t* Wgp_t = (bf16_t*)(ws + WS_WGP); bf16_t* Wuq_t = (bf16_t*)(ws + WS_WUQ); bf16_t* Wukv_t = (bf16_t*)(ws + WS_WUKV);
    bf16_t* Wo_t = (bf16_t*)(ws + WS_WO); bf16_t* Wout_t = (bf16_t*)(ws + WS_WOUT); bf16_t* Wr_t = (bf16_t*)(ws + WS_WR); bf16_t* Wpg_t = (bf16_t*)(ws + WS_WPG);
    bf16_t* Wpp_t = (bf16_t*)(ws + WS_WPP); bf16_t* Wsp = (bf16_t*)(ws + WS_WSP); bf16_t* Pb = (bf16_t*)(ws + WS_PB);
    float* vpart = (float*)(ws + WS_VPART); float* cqpart = (float*)(ws + WS_CQPART); float* ckvpart = (float*)(ws + WS_CKVPART); float* rstd3 = (float*)(ws + WS_RSTD3);
    bf16_t* Ub = (bf16_t*)(ws + WS_U); bf16_t* Vb = (bf16_t*)(ws + WS_V); bf16_t* GA = (bf16_t*)(ws + WS_GA); bf16_t* GB = (bf16_t*)(ws + WS_GB);
    bf16_t* CQ = (bf16_t*)(ws + WS_CQ); bf16_t* CKV = (bf16_t*)(ws + WS_CKV); bf16_t* KPE = (bf16_t*)(ws + WS_KPE);
    bf16_t* QN = (bf16_t*)(ws + WS_QN); bf16_t* KN = (bf16_t*)(ws + WS_KN); bf16_t* VV = (bf16_t*)(ws + WS_VV); bf16_t* QR = (bf16_t*)(ws + WS_QR);
    bf16_t* Mb = (bf16_t*)(ws + WS_MB); bf16_t* Wgu_t = (bf16_t*)(ws + WS_WGU); bf16_t* Wd_t = (bf16_t*)(ws + WS_WD); float* LOG = (float*)(ws + WS_LOG);
    bf16_t* HID = (bf16_t*)(ws + WS_HID); bf16_t* YS = (bf16_t*)(ws + WS_YS); bf16_t* H2b = (bf16_t*)(ws + WS_H2B); bf16_t* PP = (bf16_t*)(ws + WS_PP);
    bf16_t* XA = (bf16_t*)out; bf16_t* Yb = (bf16_t*)out; bf16_t* Ob = (bf16_t*)out; float* H = out;

    const int lo = args.ph_lo, hi = args.ph_hi;
#ifndef PHMASK
#define PHMASK 0xFFFFFFFFu
#endif
#define IN(k) (((PHMASK >> (k)) & 1u) && lo <= (k) && (k) < hi)
#define SEAM(k) do { if (IN(k) && IN((k) + 1)) { __threadfence(); cg::this_grid().sync(); } } while (0)

    if (IN(0)) {
        LAS float* scr = (LAS float*)(ldsl + wave * 16384);
        transpose_job(w_in, DM, 5824, nullptr, Win_t, MAP_WIN, scr, gw, NGW, lane);
        transpose_job(w_gproj, GWID, DM, nullptr, Wgp_t, MAP_ID, scr, gw, NGW, lane);
        transpose_job(w_uq, QL, 1536, g_cq, Wuq_t, MAP_WUQ, scr, gw, NGW, lane);
        transpose_job(w_ukv, KVL, 2048, g_ckv, Wukv_t, MAP_ID, scr, gw, NGW, lane);
        transpose_job(w_mla_o, DM, DM, nullptr, Wo_t, MAP_ID, scr, gw, NGW, lane);
        transpose_job(w_out, DM, DM, nullptr, Wout_t, MAP_ID, scr, gw, NGW, lane);
        transpose_job(w_ple_gate, DM, DM, g_ple, Wpg_t, MAP_ID, scr, gw, NGW, lane);
        transpose_job(w_ple_proj, PLE, DM, nullptr, Wpp_t, MAP_ID, scr, gw, NGW, lane);
        const int gt = blk * NTHREADS + tid, NGT = G * NTHREADS;
        for (int i = gt; i < 64 * DM; i += NGT) Win_t[(size_t)SEG_PAD * DM + i] = 0;
        for (int i = gt; i < 256 * DM; i += NGT) { const int n = i >> 10, k = i & 1023; float v = 0.f;
            if (n < 8) v = w_router_g[k * 8 + n]; else if (n < 72) v = w_router_e[k * 64 + (n - 8)];
            Wr_t[i] = (bf16_t)(cvtpk(v, 0.f) & 0xffffu); }
        for (int i = gt; i < 12 * 128 * 128; i += NGT) { const int t = (i >> 7) & 127, s = i & 127; const float v = ((s >> 6) <= (t >> 6)) ? w_spatial[i] : 0.f; Wsp[i] = (bf16_t)(cvtpk(v, 0.f) & 0xffffu); }
        for (int i = gt; i < NS * 32; i += NGT) { const int s = i >> 5, j = i & 31; const double inv = exp(-(double)j * (1.0 / 32.0) * 9.210340371976184); const double a = (double)s * inv;
            ropeC[i] = (float)cos(a); ropeS[i] = (float)sin(a); }
        for (int i = gt; i < MROWS * PLE / 4; i += NGT) { const f32x4 v = ((const f32x4*)p_in)[i]; ((u32x2*)Pb)[i] = (u32x2){cvtpk(v[0], v[1]), cvtpk(v[2], v[3])}; }
        for (int m = gw; m < MROWS; m += NGW) rms_row_to_bf16(x + (size_t)m * DM, g_mix, XA + (size_t)m * DM, lane);
    }
    SEAM(0);
    if (IN(1)) {
        pg8::SchedDense S; S.init(XA, Win_t, MROWS, ZN, DM, G, blk);
        pg8::EpiZ E{Ub, Vb, GA, GB, CQ, CKV, KPE, vpart, cqpart, ckvpart, ropeC, ropeS};
        pg8::gemm_phase(ldsl, DM, S, E);
    }
    SEAM(1);
    if (IN(2)) { att::spatial_phase((char*)lds, Ub, Vb, vpart, g_gv, Wsp, b_spatial, Yb, G, blk); }
    SEAM(2);
    if (IN(3)) {
#ifndef SUBMASK
#define SUBMASK 7
#endif
        if (SUBMASK & 1) { pg8::SchedDense S; S.init(Yb, Wgp_t, MROWS, DM, GWID, G, blk); pg8::EpiMul E{GA}; pg8::gemm_phase(ldsl, GWID, S, E); }
        __syncthreads();
        if (SUBMASK & 2) { pg8::SchedDense S; S.init(CQ, Wuq_t, MROWS, 1536, QL, G, blk); pg8::EpiQ E{QN, QR, cqpart, ropeC, ropeS}; pg8::gemm_phase(ldsl, QL, S, E); }
        __syncthreads();
        if (SUBMASK & 4) { pg8::SchedDense S; S.init(CKV, Wukv_t, MROWS, 2048, KVL, G, blk); pg8::EpiKV E{KN, VV, ckvpart}; pg8::gemm_phase(ldsl, KVL, S, E); }
    }
    SEAM(3);
    if (IN(4)) { att::attn_phase((char*)lds, QN, QR, KN, KPE, VV, Ob, G, blk); }
    SEAM(4);
    if (IN(5)) {
        { pg8::SchedDense S; S.init(Ob, Wo_t, MROWS, DM, DM, G, blk); pg8::EpiMulAdd E{GA, GB}; pg8::gemm_phase(ldsl, DM, S, E); }
        __syncthreads();
        LAS float* scr = (LAS float*)(ldsl + wave * 16384);
        for (int it = gw; it < NEXP * 128; it += NGW) { const int e = it >> 7, sub = it & 127;
            transpose_item(w_e_gate + (size_t)e * DM * DEXP, DM, DEXP, nullptr, Wgu_t + (size_t)e * 512 * DM, MAP_GATE, scr, sub, lane);
            transpose_item(w_e_up + (size_t)e * DM * DEXP, DM, DEXP, nullptr, Wgu_t + (size_t)e * 512 * DM, MAP_UP, scr, sub, lane);
            transpose_item(w_e_down + (size_t)e * DEXP * DM, DEXP, DM, nullptr, Wd_t + (size_t)e * DM * DEXP, MAP_ID, scr, sub, lane); }
    }
    SEAM(5);
    if (IN(6)) { pg8::SchedDense S; S.init(GA, Wout_t, MROWS, DM, DM, G, blk); pg8::EpiRes E{x, H}; pg8::gemm_phase(ldsl, DM, S, E); }
    SEAM(6);
    if (IN(7)) { for (int m = gw; m < MROWS; m += NGW) rms_row_to_bf16(H + (size_t)m * DM, g_moe, Mb + (size_t)m * DM, lane); }
    SEAM(7);
    if (IN(8)) { pg8::SchedDense S; S.init(Mb, Wr_t, MROWS, 256, DM, G, blk); pg8::EpiRouter E{LOG}; pg8::gemm_phase(ldsl, DM, S, E); }
    SEAM(8);
    if (IN(9)) {
        LAS int* hist = (LAS int*)ldsl;
        for (int chunk = blk; chunk < MROWS / 128; chunk += G) {
            __syncthreads();
            if (tid < 64) hist[tid] = 0;
            __syncthreads();
            if (tid < 128) {
                const int tok = chunk * 128 + tid; const float* lg = LOG + (size_t)tok * 72;
                float gl[8]; float gm = -1e30f;
#pragma unroll
                for (int i = 0; i < 8; ++i) { gl[i] = lg[i]; gm = fmaxf(gm, gl[i]); }
                float gs = 0.f;
#pragma unroll
                for (int i = 0; i < 8; ++i) { gl[i] = expf(gl[i] - gm); gs += gl[i]; }
                int gi = 0; float gbest = -1e30f, gw_ = 0.f;
#pragma unroll
                for (int i = 0; i < 8; ++i) { const float pr = gl[i] / gs; const float sc_ = pr + b_router_g[i]; if (sc_ > gbest) { gbest = sc_; gi = i; gw_ = pr; } }
                float el[8]; float em = -1e30f;
#pragma unroll
                for (int i = 0; i < 8; ++i) { el[i] = lg[8 + gi * 8 + i]; em = fmaxf(em, el[i]); }
                float es = 0.f;
#pragma unroll
                for (int i = 0; i < 8; ++i) { el[i] = expf(el[i] - em); es += el[i]; }
                int i0 = 0, i1 = 0; float s0 = -1e30f, s1 = -1e30f, p0 = 0.f, p1 = 0.f;
#pragma unroll
                for (int i = 0; i < 8; ++i) { const float pr = el[i] / es; const float sc_ = pr + b_router_e[gi * 8 + i];
                    if (sc_ > s0) { s1 = s0; i1 = i0; p1 = p0; s0 = sc_; i0 = i; p0 = pr; } else if (sc_ > s1) { s1 = sc_; i1 = i; p1 = pr; } }
                const float den = p0 + p1; const float w0 = gw_ * (p0 / den), w1 = gw_ * (p1 / den);
                const int e0 = gi * 8 + i0, e1 = gi * 8 + i1;
                const int r0 = __hip_atomic_fetch_add(&hist[e0], 1, __ATOMIC_RELAXED, __HIP_MEMORY_SCOPE_WORKGROUP);
                const int r1 = __hip_atomic_fetch_add(&hist[e1], 1, __ATOMIC_RELAXED, __HIP_MEMORY_SCOPE_WORKGROUP);
                tokinfo[tok] = (u32x4){(unsigned)(e0 | (r0 << 8)), (unsigned)(e1 | (r1 << 8)), __float_as_uint(w0), __float_as_uint(w1)};
            }
            __syncthreads();
            if (tid < 64) chunkcnt[chunk * 64 + tid] = hist[tid];
        }
    }
    SEAM(9);
    if (IN(10)) {
        LAS int* tot = (LAS int*)ldsl; LAS int* base = tot + 64; LAS int* cbase = tot + 128;
        if (tid < 64) { int s = 0; for (int c = 0; c < MROWS / 128; ++c) s += chunkcnt[c * 64 + tid]; tot[tid] = s; }
        __syncthreads();
        if (tid == 0) { int acc = 0; for (int e = 0; e < 64; ++e) { base[e] = acc; acc += (tot[e] + 255) & ~255; }
            if (blk == 0) { ctl[0] = acc >> 8; int rt = 0; for (int e = 0; e < 64; ++e) { const int n = (tot[e] + 255) >> 8; for (int i = 0; i < n; ++i) ctl[16 + rt++] = e; } } }
        __syncthreads();
        for (int e = blk; e < 64; e += G) { const int b0 = base[e] + tot[e], b1 = base[e] + ((tot[e] + 255) & ~255); for (int s = b0 + tid; s < b1; s += NTHREADS) { rowtok[s] = -1; roww[s] = 0.f; } }
        for (int chunk = blk; chunk < MROWS / 128; chunk += G) {
            __syncthreads();
            if (tid < 64) { int s = 0; for (int c = 0; c < chunk; ++c) s += chunkcnt[c * 64 + tid]; cbase[tid] = s; }
            __syncthreads();
            if (tid < 128) { const int tok = chunk * 128 + tid; const u32x4 ti = tokinfo[tok];
                const int e0 = ti.x & 255, r0 = ti.x >> 8, e1 = ti.y & 255, r1 = ti.y >> 8;
                const int s0 = base[e0] + cbase[e0] + r0, s1 = base[e1] + cbase[e1] + r1;
                rowtok[s0] = tok * 2; roww[s0] = __uint_as_float(ti.z); rowtok[s1] = tok * 2 + 1; roww[s1] = __uint_as_float(ti.w); }
        }
    }
    SEAM(10);
    if (IN(11)) { pg8::SchedGU S{Mb, rowtok, Wgu_t, ctl + 16, ctl[0], G, blk}; pg8::EpiGU E{HID}; pg8::gemm_phase(ldsl, DM, S, E); }
    SEAM(11);
    if (IN(12)) { pg8::SchedDown S{HID, Wd_t, ctl + 16, ctl[0], G, blk}; pg8::EpiDown E{YS, rowtok, roww}; pg8::gemm_phase(ldsl, DEXP, S, E); }
    SEAM(12);
    if (IN(13)) {
        for (int m = gw; m < MROWS; m += NGW) {
            f32x4* hr = (f32x4*)(H + (size_t)m * DM) + lane; const u32x2* y0 = (const u32x2*)(YS + (size_t)m * DM) + lane; const u32x2* y1 = (const u32x2*)(YS + ((size_t)MROWS + m) * DM) + lane;
            u32x2* hb = (u32x2*)(H2b + (size_t)m * DM) + lane; float s = 0.f;
#pragma unroll
            for (int j = 0; j < 4; ++j) { f32x4 v = hr[64 * j]; const u32x2 a = y0[64 * j], b = y1[64 * j];
                v[0] += bflo(a.x) + bflo(b.x); v[1] += bfhi(a.x) + bfhi(b.x); v[2] += bflo(a.y) + bflo(b.y); v[3] += bfhi(a.y) + bfhi(b.y);
                hr[64 * j] = v; hb[64 * j] = (u32x2){cvtpk(v[0], v[1]), cvtpk(v[2], v[3])};
                s += (v[0] * v[0] + v[1] * v[1]) + (v[2] * v[2] + v[3] * v[3]); }
            s = wave_sum(s);
            if (lane == 0) rstd3[m] = 1.f / sqrtf(s * (1.f / DM) + EPS);
        }
    }
    SEAM(13);
    if (IN(14)) {
        { pg8::SchedDense S; S.init(Pb, Wpp_t, MROWS, DM, PLE, G, blk); pg8::EpiPP E{PP}; pg8::gemm_phase(ldsl, PLE, S, E); }
        __syncthreads();
        { pg8::SchedDense S; S.init(H2b, Wpg_t, MROWS, DM, DM, G, blk); pg8::EpiPLE E{H, PP, rstd3}; pg8::gemm_phase(ldsl, DM, S, E); }
    }
    SEAM(14);
    if (IN(15)) {
        for (int m = gw; m < MROWS; m += NGW) {
            f32x4* hr = (f32x4*)(H + (size_t)m * DM) + lane; f32x4 v[4]; float s = 0.f;
#pragma unroll
            for (int j = 0; j < 4; ++j) { v[j] = hr[64 * j]; s += (v[j][0] * v[j][0] + v[j][1] * v[j][1]) + (v[j][2] * v[j][2] + v[j][3] * v[j][3]); }
            const float rstd = 1.f / sqrtf(wave_sum(s) * (1.f / DM) + EPS);
#pragma unroll
            for (int j = 0; j < 4; ++j) hr[64 * j] = v[j] * rstd * ((const f32x4*)g_final)[lane + 64 * j];
        }
    }
#undef IN
#undef SEAM
}

extern "C" void kernel_launch(void* const* d_in, const int* in_sizes, int n_in, void* d_out, int out_size, void* d_ws, size_t ws_size, hipStream_t stream) {
    static int grid = 0;
    if (grid == 0) {
        if (n_in != 26 || out_size != MROWS * DM || ws_size < WS_END) { fprintf(stderr, "kernel_launch: unexpected shapes (n_in %d out %d ws %zu)\n", n_in, out_size, ws_size); grid = -1; return; }
        int dev = 0, cus = 0, per_cu = 0;
        (void)hipGetDevice(&dev); (void)hipDeviceGetAttribute(&cus, hipDeviceAttributeMultiprocessorCount, dev);
        if (hipFuncSetAttribute((const void*)fwd_kernel, hipFuncAttributeMaxDynamicSharedMemorySize, LDS_BYTES) != hipSuccess) { fprintf(stderr, "kernel_launch: hipFuncSetAttribute failed\n"); grid = -1; return; }
        if (hipOccupancyMaxActiveBlocksPerMultiprocessor(&per_cu, (const void*)fwd_kernel, NTHREADS, LDS_BYTES) != hipSuccess || per_cu < 1) { fprintf(stderr, "kernel_launch: occupancy query says %d\n", per_cu); per_cu = 1; }
        (void)hipGetLastError();
        grid = cus > 0 ? cus : 256;
    }
    if (grid < 0) return;
    Args a{};
    for (int i = 0; i < 26; ++i) a.in[i] = (const float*)d_in[i];
    a.out = (float*)d_out; a.ws = (unsigned char*)d_ws;
#if MK_N_LAUNCHES == 1
    a.ph_lo = 0; a.ph_hi = NPHASE;
    void* params[] = {&a};
    hipError_t e = hipLaunchCooperativeKernel((const void*)fwd_kernel, dim3(grid), dim3(NTHREADS), params, LDS_BYTES, stream);
    if (e != hipSuccess) fprintf(stderr, "kernel_launch: cooperative launch failed: %s\n", hipGetErrorString(e));
#else
    for (int ph = 0; ph < 16; ++ph) { a.ph_lo = ph; a.ph_hi = ph + 1; hipLaunchKernelGGL(fwd_kernel, dim3(grid), dim3(NTHREADS), LDS_BYTES, stream, a); }
#endif
}
```

```cpp
#include <hip/hip_runtime.h>
#include <hip/hip_cooperative_groups.h>
#include <cstdio>
#include <cstdint>
namespace cg = cooperative_groups;

#ifndef MK_N_LAUNCHES
#define MK_N_LAUNCHES 1
#endif

#define LAS __attribute__((address_space(3)))
typedef unsigned short bf16_t;
typedef short bf16x8 __attribute__((ext_vector_type(8)));
typedef short s16x4 __attribute__((ext_vector_type(4)));
typedef float f32x4 __attribute__((ext_vector_type(4)));
typedef float f32x2 __attribute__((ext_vector_type(2)));
typedef float f32x16 __attribute__((ext_vector_type(16)));
typedef unsigned u32x4 __attribute__((ext_vector_type(4)));
typedef unsigned u32x2 __attribute__((ext_vector_type(2)));

constexpr int NB = 8, NS = 4096, DM = 1024, MROWS = NB * NS;
constexpr int GWID = 1536, QL = 384, KVL = 256, RD = 64, NH = 8, PLE = 256;
constexpr int ZN = 5888;
constexpr int SEG_V = 1536, SEG_GA = 3072, SEG_GB = 4096, SEG_CQ = 5120, SEG_CKV = 5504, SEG_KR = 5760, SEG_PAD = 5824;
constexpr int NEXP = 64, DEXP = 256;
constexpr int MAXSLOT = 2 * MROWS + NEXP * 256;
constexpr float EPS = 1e-6f;

constexpr size_t MiB = 1u << 20;
constexpr size_t WS_CTL = 0;
constexpr size_t WS_BAR = 8192, BAR_ZERO_BYTES = 16384;
constexpr size_t WS_CHUNKCNT = 64 * 1024;
constexpr size_t WS_TOKINFO = 128 * 1024;
constexpr size_t WS_ROWTOK = 1 * MiB;
constexpr size_t WS_ROWW = 1 * MiB + 512 * 1024;
constexpr size_t WS_ROPEC = 2 * MiB, WS_ROPES = 3 * MiB;
constexpr size_t WS_WIN = 4 * MiB;
constexpr size_t WS_WGP = 16 * MiB;
constexpr size_t WS_WUQ = 19 * MiB;
constexpr size_t WS_WUKV = 20 * MiB + 512 * 1024;
constexpr size_t WS_WO = 21 * MiB + 512 * 1024;
constexpr size_t WS_WOUT = 23 * MiB + 512 * 1024;
constexpr size_t WS_WR = 25 * MiB + 512 * 1024;
constexpr size_t WS_WPG = 26 * MiB;
constexpr size_t WS_WPP = 28 * MiB;
constexpr size_t WS_WSP = 28 * MiB + 512 * 1024;
constexpr size_t WS_PB = 29 * MiB;
constexpr size_t WS_VPART = 45 * MiB;
constexpr size_t WS_CQPART = 57 * MiB;
constexpr size_t WS_CKVPART = 58 * MiB + 512 * 1024;
constexpr size_t WS_RSTD3 = 63 * MiB + 512 * 1024;
constexpr size_t WS_U = 64 * MiB, WS_V = 160 * MiB, WS_GA = 256 * MiB, WS_GB = 320 * MiB, WS_CQ = 384 * MiB, WS_CKV = 408 * MiB, WS_KPE = 424 * MiB;
constexpr size_t WS_QN = 64 * MiB, WS_KN = 128 * MiB, WS_VV = 192 * MiB, WS_QR = 428 * MiB;
constexpr size_t WS_MB = 64 * MiB, WS_WGU = 128 * MiB, WS_WD = 192 * MiB, WS_LOG = 224 * MiB;
constexpr size_t WS_HID = 256 * MiB, WS_YS = 320 * MiB, WS_H2B = 64 * MiB, WS_PP = 128 * MiB;
constexpr size_t WS_END = 512 * MiB;

__device__ __forceinline__ unsigned cvtpk(float lo, float hi) { unsigned r; asm volatile("v_cvt_pk_bf16_f32 %0, %1, %2" : "=v"(r) : "v"(lo), "v"(hi)); return r; }
__device__ __forceinline__ float bflo(unsigned w) { return __uint_as_float(w << 16); }
__device__ __forceinline__ float bfhi(unsigned w) { return __uint_as_float(w & 0xffff0000u); }
__device__ __forceinline__ float bf2f(bf16_t b) { return __uint_as_float(((unsigned)b) << 16); }
__device__ __forceinline__ u32x4 pack8u(f32x4 a, f32x4 b) { u32x4 w = {cvtpk(a[0], a[1]), cvtpk(a[2], a[3]), cvtpk(b[0], b[1]), cvtpk(b[2], b[3])}; return w; }
__device__ __forceinline__ bf16x8 pack8(f32x4 a, f32x4 b) { u32x4 w = pack8u(a, b); return *reinterpret_cast<bf16x8*>(&w); }
__device__ __forceinline__ void unpack8(u32x4 w, f32x4& a, f32x4& b) { a = (f32x4){bflo(w.x), bfhi(w.x), bflo(w.y), bfhi(w.y)}; b = (f32x4){bflo(w.z), bfhi(w.z), bflo(w.w), bfhi(w.w)}; }
__device__ __forceinline__ float fsigmoid(float x) { return __builtin_amdgcn_rcpf(1.f + __builtin_amdgcn_exp2f(-1.4426950408889634f * x)); }
__device__ __forceinline__ float gelu_tanh(float x) { const float u = x * (1.f + 0.044715f * x * x); return x * fsigmoid(1.5957691216057308f * u); }
__device__ __forceinline__ float wave_sum(float v) {
#pragma unroll
    for (int o = 1; o < 64; o <<= 1) v += __shfl_xor(v, o);
    return v;
}
__device__ __forceinline__ float quad_sum(float v) { v += __shfl_xor(v, 16); v += __shfl_xor(v, 32); return v; }

namespace pg8 {
constexpr int BM = 256, BK = 64, HALF = 128, HTB = HALF * BK * 2, STAGE_BYTES = 8 * HTB, NXCD = 8, WGM = 8;
__host__ __device__ __forceinline__ int lds_byte(int r, int c) { const int st = (r >> 4) * 2 + (c >> 5), rr = r & 15, cc = c & 31, ob = rr * 64 + cc * 2; return st * 1024 + (ob ^ (((ob >> 9) & 1) << 5)); }
__host__ __device__ __forceinline__ void stage_rc(int b, int& R, int& C) { const int st = b / 1024, sb = b % 1024, swz = sb ^ (((sb >> 9) & 1) << 5); R = (st >> 1) * 16 + swz / 64; C = (st & 1) * 32 + (swz % 64) / 2; }
__host__ __device__ __forceinline__ int perm32(int rho) { const int n = rho >> 4, i = rho & 15; return 8 * (i >> 2) + 4 * n + (i & 3); }

struct Unit { int pm, pn, ex; };

struct SchedDense {
    const bf16_t* A; const bf16_t* Bt; int K; int nM, nN, nwg, G, c;
    __device__ void init(const bf16_t* A_, const bf16_t* Bt_, int M, int N, int K_, int G_, int c_) { A = A_; Bt = Bt_; K = K_; nM = M / BM; nN = N / BM; nwg = nM * nN; G = G_; c = c_; }
    __device__ __forceinline__ bool next(int i, Unit& u) const {
        const long L = (long)i * G + c; if (L >= nwg) return false;
        int wgid = (int)L; { const int q = nwg / NXCD, r = nwg % NXCD, xcd = wgid % NXCD, off = wgid / NXCD; wgid = (xcd < r ? xcd * (q + 1) : r * (q + 1) + (xcd - r) * q) + off; }
        const int nig = WGM * nN, gid = wgid / nig, fm = gid * WGM, gsz = (nM - fm) < WGM ? (nM - fm) : WGM;
        u.pm = fm + ((wgid % nig) % gsz); u.pn = (wgid % nig) / gsz; u.ex = 0; return true;
    }
    __device__ __forceinline__ const char* a_ptr(const Unit& u) const { return (const char*)A + (size_t)u.pm * BM * K * 2; }
    __device__ __forceinline__ const char* b_ptr(const Unit& u) const { return (const char*)Bt + (size_t)u.pn * BM * K * 2; }
    __device__ __forceinline__ void a_off(const Unit&, const int (&R)[2], const int (&C)[2], unsigned (&vo)[2][2]) const {
#pragma unroll
        for (int h = 0; h < 2; ++h)
#pragma unroll
            for (int i = 0; i < 2; ++i) vo[h][i] = (unsigned)((h * HALF + R[i]) * K + C[i]) * 2u;
    }
};
struct SchedGU {
    const bf16_t* A; const int* rowtok; const bf16_t* Bt; const int* tile_e; int ntiles; int G, c;
    __device__ __forceinline__ bool next(int i, Unit& u) const {
        const int L = i * G + c; if (L >= ntiles * 2) return false;
        u.pm = L >> 1; u.pn = L & 1; u.ex = tile_e[u.pm]; return true;
    }
    __device__ __forceinline__ const char* a_ptr(const Unit&) const { return (const char*)A; }
    __device__ __forceinline__ const char* b_ptr(const Unit& u) const { return (const char*)Bt + ((size_t)u.ex * 512 + (size_t)u.pn * 256) * DM * 2; }
    __device__ __forceinline__ void a_off(const Unit& u, const int (&R)[2], const int (&C)[2], unsigned (&vo)[2][2]) const {
#pragma unroll
        for (int h = 0; h < 2; ++h)
#pragma unroll
            for (int i = 0; i < 2; ++i) { const int t = rowtok[u.pm * BM + h * HALF + R[i]]; const int tok = t < 0 ? 0 : (t >> 1); vo[h][i] = (unsigned)(tok * DM + C[i]) * 2u; }
    }
};
struct SchedDown {
    const bf16_t* A; const bf16_t* Bt; const int* tile_e; int ntiles; int G, c;
    __device__ __forceinline__ bool next(int i, Unit& u) const {
        const int L = i * G + c; if (L >= ntiles * 4) return false;
        u.pm = L >> 2; u.pn = L & 3; u.ex = tile_e[u.pm]; return true;
    }
    __device__ __forceinline__ const char* a_ptr(const Unit& u) const { return (const char*)A + (size_t)u.pm * BM * DEXP * 2; }
    __device__ __forceinline__ const char* b_ptr(const Unit& u) const { return (const char*)Bt + ((size_t)u.ex * DM + (size_t)u.pn * 256) * DEXP * 2; }
    __device__ __forceinline__ void a_off(const Unit&, const int (&R)[2], const int (&C)[2], unsigned (&vo)[2][2]) const {
#pragma unroll
        for (int h = 0; h < 2; ++h)
#pragma unroll
            for (int i = 0; i < 2; ++i) vo[h][i] = (unsigned)((h * HALF + R[i]) * DEXP + C[i]) * 2u;
    }
};

template <class Epi, class Sched>
__device__ __forceinline__ void gemm_phase(LAS unsigned char* lds, const int K_, const Sched& S, const Epi& E) {
    int tid = threadIdx.x; asm volatile("" : "+v"(tid));
    int K = K_; asm volatile("" : "+s"(K));
    const int wid = __builtin_amdgcn_readfirstlane(tid >> 6), lane = tid & 63, wr = wid >> 2, wc = wid & 3, fr = lane & 15, fq = lane >> 4;
    const int nt = K / BK;
    int RA[2], CA[2]; unsigned voffB[2];
#pragma unroll
    for (int i = 0; i < 2; ++i) { int R, C; stage_rc(tid * 16 + i * 8192, R, C); const int Rb = Epi::PERM ? ((R & ~31) + perm32(R & 31)) : R;
        RA[i] = R; CA[i] = C; voffB[i] = (unsigned)(Rb * K + C) * 2u; }
    const size_t kstep = (size_t)(BK * 2);
    const size_t hstep = (size_t)HALF * K * 2;
    const unsigned ldsw = (unsigned)wid * 1024u;
    const int aoff = lds_byte(wr * 64 + fr, fq * 8), boff = lds_byte(wc * 32 + fr, fq * 8);
#define PG8_SA(b, h) (((b) * 2 + (h)) * HTB)
#define PG8_SB(b, h) ((4 + (b) * 2 + (h)) * HTB)
#define PG8_STAGE(bufoff, gbase, voff) do { _Pragma("unroll") for (int _i = 0; _i < 2; ++_i) \
        __builtin_amdgcn_global_load_lds((const unsigned*)((const char*)(gbase) + (voff)[_i]), (LAS unsigned*)(lds + (bufoff) + ldsw + _i * 8192), 16, 0, 0); } while (0)
#define PG8_LDA(dst, b, h) do { _Pragma("unroll") for (int m = 0; m < 4; ++m) _Pragma("unroll") for (int k = 0; k < 2; ++k) dst[m][k] = *(const LAS bf16x8*)(lds + PG8_SA(b, h) + aoff + m * 2048 + k * 1024); } while (0)
#define PG8_LDB(dst, b, h) do { _Pragma("unroll") for (int n = 0; n < 2; ++n) _Pragma("unroll") for (int k = 0; k < 2; ++k) dst[n][k] = *(const LAS bf16x8*)(lds + PG8_SB(b, h) + boff + n * 2048 + k * 1024); } while (0)
#define PG8_MMA(ai, bj, At, Bt) do { __builtin_amdgcn_s_setprio(1); _Pragma("unroll") for (int m = 0; m < 4; ++m) _Pragma("unroll") for (int n = 0; n < 2; ++n) _Pragma("unroll") for (int k = 0; k < 2; ++k) \
        acc[ai][bj][m][n] = __builtin_amdgcn_mfma_f32_16x16x32_bf16(Bt[n][k], At[m][k], acc[ai][bj][m][n], 0, 0, 0); __builtin_amdgcn_s_setprio(0); } while (0)
#define PG8_WAIT_V(n) asm volatile("s_waitcnt vmcnt(" #n ")" ::: "memory")
#define PG8_WAIT_L(n) asm volatile("s_waitcnt lgkmcnt(" #n ")" ::: "memory")
#define PG8_BAR __builtin_amdgcn_s_barrier()
#define PG8_SCHED __builtin_amdgcn_sched_barrier(0)
    Unit cur, nxt; int ui = 0;
    if (!S.next(0, cur)) return;
    f32x4 acc[2][2][4][2];
#pragma unroll
    for (int a = 0; a < 2; ++a)
#pragma unroll
        for (int b = 0; b < 2; ++b)
#pragma unroll
            for (int m = 0; m < 4; ++m)
#pragma unroll
                for (int n = 0; n < 2; ++n) acc[a][b][m][n] = (f32x4){0.f, 0.f, 0.f, 0.f};
    bf16x8 At[4][2], B0[2][2], B1[2][2];
    unsigned voC[2][2], voN[2][2];
    const char* cA = S.a_ptr(cur); const char* cB = S.b_ptr(cur);
    S.a_off(cur, RA, CA, voC);
    PG8_STAGE(PG8_SB(0, 0), cB, voffB); PG8_STAGE(PG8_SA(0, 0), cA, voC[0]); PG8_STAGE(PG8_SB(0, 1), cB + hstep, voffB); PG8_STAGE(PG8_SA(0, 1), cA, voC[1]);
    if (wr == 1) PG8_BAR;
    PG8_WAIT_V(4); PG8_BAR;
    PG8_STAGE(PG8_SB(1, 0), cB + kstep, voffB); PG8_STAGE(PG8_SA(1, 0), cA + kstep, voC[0]); PG8_STAGE(PG8_SB(1, 1), cB + hstep + kstep, voffB);
    PG8_WAIT_V(6); PG8_BAR;
    for (;;) {
        const bool has_next = S.next(ui + 1, nxt);
        const char* nA = has_next ? S.a_ptr(nxt) : cA; const char* nB = has_next ? S.b_ptr(nxt) : cB;
        if (has_next) S.a_off(nxt, RA, CA, voN);
        else {
#pragma unroll
            for (int h = 0; h < 2; ++h)
#pragma unroll
                for (int i = 0; i < 2; ++i) voN[h][i] = voC[h][i]; }
#pragma nounroll
        for (int t = 0; t < nt; t += 2) {
            const bool last = (t == nt - 2);
            const char* a1 = cA + (size_t)(t + 1) * kstep;
            const char* a2 = last ? nA : cA + (size_t)(t + 2) * kstep; const char* b2 = last ? nB : cB + (size_t)(t + 2) * kstep;
            const char* a3 = a2 + kstep; const char* b3 = b2 + kstep;
            unsigned v2[2][2];
#pragma unroll
            for (int h = 0; h < 2; ++h)
#pragma unroll
                for (int i = 0; i < 2; ++i) v2[h][i] = last ? voN[h][i] : voC[h][i];
            PG8_LDB(B0, 0, 0); PG8_SCHED; PG8_LDA(At, 0, 0); PG8_STAGE(PG8_SA(1, 1), a1, voC[1]);
            PG8_WAIT_L(8); PG8_BAR; PG8_WAIT_L(0); PG8_MMA(0, 0, At, B0); PG8_BAR; PG8_SCHED;
            PG8_LDB(B1, 0, 1); PG8_STAGE(PG8_SB(0, 0), b2, voffB);
            PG8_BAR; PG8_WAIT_L(0); PG8_MMA(0, 1, At, B1); PG8_BAR;
            PG8_LDA(At, 0, 1); PG8_STAGE(PG8_SA(0, 0), a2, v2[0]);
            PG8_BAR; PG8_WAIT_L(0); PG8_MMA(1, 0, At, B0); PG8_BAR; PG8_SCHED;
            PG8_STAGE(PG8_SB(0, 1), b2 + hstep, voffB);
            PG8_WAIT_V(6); PG8_BAR; PG8_MMA(1, 1, At, B1); PG8_BAR;
            PG8_LDB(B0, 1, 0); PG8_SCHED; PG8_LDA(At, 1, 0); PG8_STAGE(PG8_SA(0, 1), a2, v2[1]);
            PG8_WAIT_L(8); PG8_BAR; PG8_WAIT_L(0); PG8_MMA(0, 0, At, B0); PG8_BAR; PG8_SCHED;
            PG8_LDB(B1, 1, 1); PG8_STAGE(PG8_SB(1, 0), b3, voffB);
            PG8_BAR; PG8_WAIT_L(0); PG8_MMA(0, 1, At, B1); PG8_BAR;
            PG8_LDA(At, 1, 1); PG8_STAGE(PG8_SA(1, 0), a3, v2[0]);
            PG8_BAR; PG8_WAIT_L(0); PG8_MMA(1, 0, At, B0); PG8_BAR; PG8_SCHED;
            PG8_STAGE(PG8_SB(1, 1), b3 + hstep, voffB);
            PG8_WAIT_V(6); PG8_BAR; PG8_MMA(1, 1, At, B1); PG8_BAR;
        }
        E(acc, cur, wr, wc, fr, fq);
        if (!has_next) break;
#pragma unroll
        for (int a = 0; a < 2; ++a)
#pragma unroll
            for (int b = 0; b < 2; ++b)
#pragma unroll
                for (int m = 0; m < 4; ++m)
#pragma unroll
                    for (int n = 0; n < 2; ++n) acc[a][b][m][n] = (f32x4){0.f, 0.f, 0.f, 0.f};
        cur = nxt; cA = nA; cB = nB; ++ui;
#pragma unroll
        for (int h = 0; h < 2; ++h)
#pragma unroll
            for (int i = 0; i < 2; ++i) voC[h][i] = voN[h][i];
    }
    PG8_WAIT_V(0);
    if (wr == 0) PG8_BAR;
    PG8_BAR;
#undef PG8_SA
#undef PG8_SB
#undef PG8_STAGE
#undef PG8_LDA
#undef PG8_LDB
#undef PG8_MMA
#undef PG8_WAIT_V
#undef PG8_WAIT_L
#undef PG8_BAR
#undef PG8_SCHED
}

typedef f32x4 Acc[2][2][4][2];
#define EPI_ROW(u, ai, wr, m, fr) ((u).pm * 256 + (ai) * 128 + (wr) * 64 + (m) * 16 + (fr))

struct EpiZ {
    static constexpr bool PERM = true;
    bf16_t *U, *V, *GA, *GB, *CQ, *CKV, *KPE; float *vpart, *cqpart, *ckvpart; const float *ropeC, *ropeS;
    __device__ __forceinline__ void operator()(const Acc& acc, const Unit& u, int wr, int wc, int fr, int fq) const {
#pragma unroll
        for (int bj = 0; bj < 2; ++bj) {
            const int cb = u.pn * 256 + bj * 128 + wc * 32;
            const int c0 = cb + 8 * fq;
            if (cb >= SEG_PAD) continue;
#pragma unroll
            for (int ai = 0; ai < 2; ++ai)
#pragma unroll
                for (int m = 0; m < 4; ++m) {
                    const int row = EPI_ROW(u, ai, wr, m, fr);
                    f32x4 v0 = acc[ai][bj][m][0], v1 = acc[ai][bj][m][1];
                    if (cb < SEG_GA) {
#pragma unroll
                        for (int j = 0; j < 4; ++j) { v0[j] = gelu_tanh(v0[j]); v1[j] = gelu_tanh(v1[j]); }
                        if (cb < SEG_V) { *(u32x4*)(U + (size_t)row * GWID + c0) = pack8u(v0, v1); }
                        else {
                            *(u32x4*)(V + (size_t)row * GWID + (c0 - SEG_V)) = pack8u(v0, v1);
                            float s = (v0[0] + v0[1]) + (v0[2] + v0[3]) + (v1[0] + v1[1]) + (v1[2] + v1[3]);
                            float q = (v0[0] * v0[0] + v0[1] * v0[1]) + (v0[2] * v0[2] + v0[3] * v0[3]) + (v1[0] * v1[0] + v1[1] * v1[1]) + (v1[2] * v1[2] + v1[3] * v1[3]);
                            s = quad_sum(s); q = quad_sum(q);
                            if (fq == 0) *(f32x2*)(vpart + ((size_t)row * 48 + ((cb - SEG_V) >> 5)) * 2) = (f32x2){s, q};
                        }
                    } else if (cb < SEG_CQ) {
#pragma unroll
                        for (int j = 0; j < 4; ++j) { v0[j] = fsigmoid(v0[j]); v1[j] = fsigmoid(v1[j]); }
                        if (cb < SEG_GB) *(u32x4*)(GA + (size_t)row * DM + (c0 - SEG_GA)) = pack8u(v0, v1);
                        else *(u32x4*)(GB + (size_t)row * DM + (c0 - SEG_GB)) = pack8u(v0, v1);
                    } else if (cb < SEG_KR) {
                        float q = (v0[0] * v0[0] + v0[1] * v0[1]) + (v0[2] * v0[2] + v0[3] * v0[3]) + (v1[0] * v1[0] + v1[1] * v1[1]) + (v1[2] * v1[2] + v1[3] * v1[3]);
                        q = quad_sum(q);
                        if (cb < SEG_CKV) { *(u32x4*)(CQ + (size_t)row * QL + (c0 - SEG_CQ)) = pack8u(v0, v1); if (fq == 0) cqpart[(size_t)row * 12 + ((cb - SEG_CQ) >> 5)] = q; }
                        else { *(u32x4*)(CKV + (size_t)row * KVL + (c0 - SEG_CKV)) = pack8u(v0, v1); if (fq == 0) ckvpart[(size_t)row * 8 + ((cb - SEG_CKV) >> 5)] = q; }
                    } else {
                        const int s = row & (NS - 1), j0 = (c0 - SEG_KR) >> 1;
                        const f32x4 cs = *(const f32x4*)(ropeC + s * 32 + j0), sn = *(const f32x4*)(ropeS + s * 32 + j0);
                        f32x4 o0, o1;
                        o0[0] = v0[0] * cs[0] - v0[1] * sn[0]; o0[1] = v0[0] * sn[0] + v0[1] * cs[0];
                        o0[2] = v0[2] * cs[1] - v0[3] * sn[1]; o0[3] = v0[2] * sn[1] + v0[3] * cs[1];
                        o1[0] = v1[0] * cs[2] - v1[1] * sn[2]; o1[1] = v1[0] * sn[2] + v1[1] * cs[2];
                        o1[2] = v1[2] * cs[3] - v1[3] * sn[3]; o1[3] = v1[2] * sn[3] + v1[3] * cs[3];
                        *(u32x4*)(KPE + (size_t)row * RD + (c0 - SEG_KR)) = pack8u(o0, o1);
                    }
                }
        }
    }
};
struct EpiMul {
    static constexpr bool PERM = true;
    bf16_t* G;
    __device__ __forceinline__ void operator()(const Acc& acc, const Unit& u, int wr, int wc, int fr, int fq) const {
#pragma unroll
        for (int ai = 0; ai < 2; ++ai)
#pragma unroll
            for (int m = 0; m < 4; ++m) {
                const int row = EPI_ROW(u, ai, wr, m, fr);
#pragma unroll
                for (int bj = 0; bj < 2; ++bj) {
                    u32x4* p = (u32x4*)(G + (size_t)row * DM + u.pn * 256 + bj * 128 + wc * 32 + 8 * fq);
                    f32x4 g0, g1; unpack8(*p, g0, g1);
                    *p = pack8u(g0 * acc[ai][bj][m][0], g1 * acc[ai][bj][m][1]);
                }
                asm volatile("" ::: "memory");
            }
    }
};
struct EpiMulAdd {
    static constexpr bool PERM = true;
    bf16_t* MA; const bf16_t* GB;
    __device__ __forceinline__ void operator()(const Acc& acc, const Unit& u, int wr, int wc, int fr, int fq) const {
#pragma unroll
        for (int ai = 0; ai < 2; ++ai)
#pragma unroll
            for (int m = 0; m < 4; ++m) {
                const int row = EPI_ROW(u, ai, wr, m, fr);
#pragma unroll
                for (int bj = 0; bj < 2; ++bj) {
                    const size_t off = (size_t)row * DM + u.pn * 256 + bj * 128 + wc * 32 + 8 * fq;
                    u32x4* p = (u32x4*)(MA + off);
                    f32x4 a0, a1, g0, g1; unpack8(*p, a0, a1); unpack8(*(const u32x4*)(GB + off), g0, g1);
                    *p = pack8u(a0 + g0 * acc[ai][bj][m][0], a1 + g1 * acc[ai][bj][m][1]);
                }
                asm volatile("" ::: "memory");
            }
    }
};
struct EpiRes {
    static constexpr bool PERM = false;
    const float* X; float* H;
    __device__ __forceinline__ void operator()(const Acc& acc, const Unit& u, int wr, int wc, int fr, int fq) const {
#pragma unroll
        for (int ai = 0; ai < 2; ++ai)
#pragma unroll
            for (int m = 0; m < 4; ++m) {
                const int row = EPI_ROW(u, ai, wr, m, fr);
#pragma unroll
                for (int bj = 0; bj < 2; ++bj)
#pragma unroll
                    for (int n = 0; n < 2; ++n) {
                        const size_t off = (size_t)row * DM + u.pn * 256 + bj * 128 + wc * 32 + 16 * n + 4 * fq;
                        *(f32x4*)(H + off) = *(const f32x4*)(X + off) + acc[ai][bj][m][n];
                    }
                asm volatile("" ::: "memory");
            }
    }
};
struct EpiQ {
    static constexpr bool PERM = true;
    bf16_t *QN, *QR; const float* cqpart; const float *ropeC, *ropeS;
    __device__ __forceinline__ void operator()(const Acc& acc, const Unit& u, int wr, int wc, int fr, int fq) const {
#pragma unroll
        for (int ai = 0; ai < 2; ++ai)
#pragma unroll
            for (int m = 0; m < 4; ++m) {
                const int row = EPI_ROW(u, ai, wr, m, fr);
                const f32x4* pp = (const f32x4*)(cqpart + (size_t)row * 12);
                const f32x4 p0 = pp[0], p1 = pp[1], p2 = pp[2];
                const float ss = ((p0[0] + p0[1]) + (p0[2] + p0[3])) + ((p1[0] + p1[1]) + (p1[2] + p1[3])) + ((p2[0] + p2[1]) + (p2[2] + p2[3]));
                const float rstd = __builtin_amdgcn_rsqf(ss * (1.f / QL) + EPS);
                const int b = row >> 12, s = row & (NS - 1);
#pragma unroll
                for (int bj = 0; bj < 2; ++bj) {
                    const int c0 = u.pn * 256 + bj * 128 + wc * 32 + 8 * fq;
                    f32x4 v0 = acc[ai][bj][m][0] * rstd, v1 = acc[ai][bj][m][1] * rstd;
                    if (u.pn < 4) {
                        const int h = c0 >> 7, d = c0 & 127;
                        *(u32x4*)(QN + (((size_t)(b * NH + h)) * NS + s) * 128 + d) = pack8u(v0, v1);
                    } else {
                        const int cc = c0 - 1024, h = cc >> 6, i0 = cc & 63, j0 = i0 >> 1;
                        const f32x4 cs = *(const f32x4*)(ropeC + s * 32 + j0), sn = *(const f32x4*)(ropeS + s * 32 + j0);
                        f32x4 o0, o1;
                        o0[0] = v0[0] * cs[0] - v0[1] * sn[0]; o0[1] = v0[0] * sn[0] + v0[1] * cs[0];
                        o0[2] = v0[2] * cs[1] - v0[3] * sn[1]; o0[3] = v0[2] * sn[1] + v0[3] * cs[1];
                        o1[0] = v1[0] * cs[2] - v1[1] * sn[2]; o1[1] = v1[0] * sn[2] + v1[1] * cs[2];
                        o1[2] = v1[2] * cs[3] - v1[3] * sn[3]; o1[3] = v1[2] * sn[3] + v1[3] * cs[3];
                        *(u32x4*)(QR + (((size_t)(b * NH + h)) * NS + s) * RD + i0) = pack8u(o0, o1);
                    }
                }
                asm volatile("" ::: "memory");
            }
    }
};
struct EpiKV {
    static constexpr bool PERM = true;
    bf16_t *KN, *VV; const float* ckvpart;
    __device__ __forceinline__ void operator()(const Acc& acc, const Unit& u, int wr, int wc, int fr, int fq) const {
#pragma unroll
        for (int ai = 0; ai < 2; ++ai)
#pragma unroll
            for (int m = 0; m < 4; ++m) {
                const int row = EPI_ROW(u, ai, wr, m, fr);
                const f32x4* pp = (const f32x4*)(ckvpart + (size_t)row * 8);
                const f32x4 p0 = pp[0], p1 = pp[1];
                const float ss = ((p0[0] + p0[1]) + (p0[2] + p0[3])) + ((p1[0] + p1[1]) + (p1[2] + p1[3]));
                const float rstd = __builtin_amdgcn_rsqf(ss * (1.f / KVL) + EPS);
                const int b = row >> 12, s = row & (NS - 1);
                const size_t o = (((size_t)(b * NH + u.pn)) * NS + s) * 128 + wc * 32 + 8 * fq;
                *(u32x4*)(KN + o) = pack8u(acc[ai][0][m][0] * rstd, acc[ai][0][m][1] * rstd);
                *(u32x4*)(VV + o) = pack8u(acc[ai][1][m][0] * rstd, acc[ai][1][m][1] * rstd);
                asm volatile("" ::: "memory");
            }
    }
};
struct EpiRouter {
    static constexpr bool PERM = false;
    float* LOG;
    __device__ __forceinline__ void operator()(const Acc& acc, const Unit& u, int wr, int wc, int fr, int fq) const {
        if (wc > 2) return;
#pragma unroll
        for (int ai = 0; ai < 2; ++ai)
#pragma unroll
            for (int m = 0; m < 4; ++m) {
                const int row = EPI_ROW(u, ai, wr, m, fr);
#pragma unroll
                for (int n = 0; n < 2; ++n) { const int c = wc * 32 + 16 * n + 4 * fq; if (c < 72) *(f32x4*)(LOG + (size_t)row * 72 + c) = acc[ai][0][m][n]; }
            }
    }
};
struct EpiGU {
    static constexpr bool PERM = true;
    bf16_t* HID;
    __device__ __forceinline__ void operator()(const Acc& acc, const Unit& u, int wr, int wc, int fr, int fq) const {
#pragma unroll
        for (int ai = 0; ai < 2; ++ai)
#pragma unroll
            for (int m = 0; m < 4; ++m) {
                const int slot = EPI_ROW(u, ai, wr, m, fr);
                f32x4 h0, h1;
#pragma unroll
                for (int j = 0; j < 4; ++j) { const float g0 = acc[ai][0][m][0][j], g1 = acc[ai][0][m][1][j];
                    h0[j] = g0 * fsigmoid(g0) * acc[ai][1][m][0][j]; h1[j] = g1 * fsigmoid(g1) * acc[ai][1][m][1][j]; }
                *(u32x4*)(HID + (size_t)slot * DEXP + u.pn * 128 + wc * 32 + 8 * fq) = pack8u(h0, h1);
            }
    }
};
struct EpiDown {
    static constexpr bool PERM = true;
    bf16_t* YS; const int* rowtok; const float* roww;
    __device__ __forceinline__ void operator()(const Acc& acc, const Unit& u, int wr, int wc, int fr, int fq) const {
#pragma unroll
        for (int ai = 0; ai < 2; ++ai)
#pragma unroll
            for (int m = 0; m < 4; ++m) {
                const int slot = EPI_ROW(u, ai, wr, m, fr);
                const int t = rowtok[slot];
                if (t >= 0) {
                    const float w = roww[slot];
                    bf16_t* dst = YS + ((size_t)(t & 1) * MROWS + (t >> 1)) * DM + u.pn * 256 + wc * 32 + 8 * fq;
#pragma unroll
                    for (int bj = 0; bj < 2; ++bj) *(u32x4*)(dst + bj * 128) = pack8u(acc[ai][bj][m][0] * w, acc[ai][bj][m][1] * w);
                }
                asm volatile("" ::: "memory");
            }
    }
};
struct EpiPP {
    static constexpr bool PERM = true;
    bf16_t* PP;
    __device__ __forceinline__ void operator()(const Acc& acc, const Unit& u, int wr, int wc, int fr, int fq) const {
#pragma unroll
        for (int ai = 0; ai < 2; ++ai)
#pragma unroll
            for (int m = 0; m < 4; ++m) {
                const int row = EPI_ROW(u, ai, wr, m, fr);
#pragma unroll
                for (int bj = 0; bj < 2; ++bj) *(u32x4*)(PP + (size_t)row * DM + u.pn * 256 + bj * 128 + wc * 32 + 8 * fq) = pack8u(acc[ai][bj][m][0], acc[ai][bj][m][1]);
            }
    }
};
struct EpiPLE {
    static constexpr bool PERM = false;
    float* H; const bf16_t* PP; const float* rstd3;
    __device__ __forceinline__ void operator()(const Acc& acc, const Unit& u, int wr, int wc, int fr, int fq) const {
#pragma unroll
        for (int ai = 0; ai < 2; ++ai)
#pragma unroll
            for (int m = 0; m < 4; ++m) {
                const int row = EPI_ROW(u, ai, wr, m, fr);
                const float rs = rstd3[row];
#pragma unroll
                for (int bj = 0; bj < 2; ++bj)
#pragma unroll
                    for (int n = 0; n < 2; ++n) {
                        const size_t off = (size_t)row * DM + u.pn * 256 + bj * 128 + wc * 32 + 16 * n + 4 * fq;
                        const u32x2 pw = *(const u32x2*)(PP + off);
                        const f32x4 pp = {bflo(pw.x), bfhi(pw.x), bflo(pw.y), bfhi(pw.y)};
                        f32x4 h = *(const f32x4*)(H + off); const f32x4 a = acc[ai][bj][m][n];
#pragma unroll
                        for (int j = 0; j < 4; ++j) h[j] += fsigmoid(a[j] * rs) * pp[j];
                        *(f32x4*)(H + off) = h;
                    }
                asm volatile("" ::: "memory");
            }
    }
};
}

namespace att {
constexpr int SHM_V = 16384, SHM_KN = 16384, SHM_KR = 8192;
constexpr int OFF_V = 0, OFF_KN = 32768, OFF_KR = 65536, OFF_WS = 81920;
constexpr float SCALE = 0.07216878364870322f;
constexpr float THR = 8.f;
#define KSWZ(row, colB) ((row) * 256 + ((colB) ^ (((row) & 7) << 4)))
#define KRSWZ(row, colB) ((row) * 128 + ((colB) ^ ((((row) >> 1) & 7) << 4)))
#define SBAR() __builtin_amdgcn_sched_barrier(0)
__device__ __forceinline__ int v_st(int k, int c) { const int kk = (k & ~0xC) | ((k & 4) << 1) | ((k & 8) >> 1); return ((kk >> 3) * 4 + (c >> 5)) * 512 + ((kk & 7) * 32 + (c & 31)) * 2; }
__device__ __forceinline__ int v_rd_base(int lane) { return ((lane & 3) << 3) | (((lane >> 2) & 3) << 6) | (((lane >> 4) & 1) << 5) | (((lane >> 5) & 1) << 8); }
constexpr int v_rd_off(int d0, int ks, int half) { return d0 * 512 + ks * 4096 + half * 2048; }
__device__ __forceinline__ int crow(int r, int hi) { return (r & 3) + 8 * (r >> 2) + 4 * hi; }

__device__ __forceinline__ void partialSM(f32x16& p0, f32x16& p1, float& m_reg, float& mn, float& alpha) {
    float pmax = p0[0];
#pragma unroll
    for (int r = 1; r < 16; ++r) pmax = fmaxf(pmax, p0[r]);
#pragma unroll
    for (int r = 0; r < 16; ++r) pmax = fmaxf(pmax, p1[r]);
    { auto rr = __builtin_amdgcn_permlane32_swap(__float_as_uint(pmax), __float_as_uint(pmax), false, false);
      pmax = fmaxf(__uint_as_float(rr[0]), __uint_as_float(rr[1])); }
    constexpr float C2 = 1.4426950408889634f * SCALE;
    if (__builtin_expect(__all((pmax - m_reg) * SCALE <= THR), 1)) { mn = m_reg; alpha = 1.f; }
    else { mn = fmaxf(m_reg, pmax); alpha = __builtin_amdgcn_exp2f((m_reg - mn) * C2); m_reg = mn; }
    const float mnL = -mn * C2;
#pragma unroll
    for (int r = 0; r < 16; ++r) p0[r] = fmaf(p0[r], C2, mnL);
#pragma unroll
    for (int r = 0; r < 16; ++r) p1[r] = fmaf(p1[r], C2, mnL);
#pragma unroll
    for (int r = 0; r < 16; ++r) p0[r] = __builtin_amdgcn_exp2f(p0[r]);
}
__device__ __forceinline__ void finishSM(f32x16& p0, f32x16& p1, float alpha, float& l_reg, bf16x8& pa0, bf16x8& pa1, bf16x8& pa2, bf16x8& pa3) {
#pragma unroll
    for (int r = 0; r < 16; ++r) p1[r] = __builtin_amdgcn_exp2f(p1[r]);
    float ps = 0;
#pragma unroll
    for (int r = 0; r < 16; ++r) ps += p0[r];
#pragma unroll
    for (int r = 0; r < 16; ++r) ps += p1[r];
    { auto rr = __builtin_amdgcn_permlane32_swap(__float_as_uint(ps), __float_as_uint(ps), false, false);
      ps = __uint_as_float(rr[0]) + __uint_as_float(rr[1]); }
    l_reg = l_reg * alpha + ps;
#define PK4(P, B_, OUT) do { unsigned a0 = cvtpk(P[B_+0], P[B_+1]), a1 = cvtpk(P[B_+2], P[B_+3]);                          \
        unsigned b0 = cvtpk(P[B_+4], P[B_+5]), b1 = cvtpk(P[B_+6], P[B_+7]);                                             \
        auto r0 = __builtin_amdgcn_permlane32_swap(a0, b0, false, false); auto r1 = __builtin_amdgcn_permlane32_swap(a1, b1, false, false); \
        u32x4 w = {r0[0], r1[0], r0[1], r1[1]}; OUT = *reinterpret_cast<bf16x8*>(&w); } while (0)
    PK4(p0, 0, pa0); PK4(p0, 8, pa1); PK4(p1, 0, pa2); PK4(p1, 8, pa3);
#undef PK4
}
template <int KB>
__device__ __forceinline__ void qkt(f32x16& p0, f32x16& p1, const char* lds, int r32, int hi, const bf16x8* qr) {
    p0 = f32x16{}; p1 = f32x16{};
    const char* kb[4];
#pragma unroll
    for (int dd = 0; dd < 4; ++dd) kb[dd] = lds + OFF_KN + KB * SHM_KN + KSWZ(r32, (dd * 16 + hi * 8) * 2);
#pragma unroll
    for (int d0 = 0; d0 < 8; ++d0) { const char* a = kb[d0 & 3] + (d0 >> 2) * 128;
        bf16x8 b0 = *reinterpret_cast<const bf16x8*>(a);
        bf16x8 b1 = *reinterpret_cast<const bf16x8*>(a + 32 * 256);
        p0 = __builtin_amdgcn_mfma_f32_32x32x16_bf16(b0, qr[d0], p0, 0, 0, 0);
        p1 = __builtin_amdgcn_mfma_f32_32x32x16_bf16(b1, qr[d0], p1, 0, 0, 0); }
#pragma unroll
    for (int dd = 0; dd < 4; ++dd) { const char* a = lds + OFF_KR + KB * SHM_KR + KRSWZ(r32, (dd * 16 + hi * 8) * 2);
        bf16x8 b0 = *reinterpret_cast<const bf16x8*>(a);
        bf16x8 b1 = *reinterpret_cast<const bf16x8*>(a + 32 * 128);
        p0 = __builtin_amdgcn_mfma_f32_32x32x16_bf16(b0, qr[8 + dd], p0, 0, 0, 0);
        p1 = __builtin_amdgcn_mfma_f32_32x32x16_bf16(b1, qr[8 + dd], p1, 0, 0, 0); }
}
#define TRRD(dst, off) asm volatile("ds_read_b64_tr_b16 %0, %1 offset:%2" : "=&v"(dst) : "v"(vb0), "i"(off) : "memory")
template <int VB, int D0, int OI>
__device__ __forceinline__ void pv_d0(f32x16* o, int vb0, bf16x8 pa0, bf16x8 pa1, bf16x8 pa2, bf16x8 pa3) {
    s16x4 l0, l1, l2, l3, h0, h1, h2, h3; constexpr int b_ = VB * SHM_V + v_rd_off(D0, 0, 0);
    TRRD(l0, b_); TRRD(h0, b_ + 2048); TRRD(l1, b_ + 4096); TRRD(h1, b_ + 6144); TRRD(l2, b_ + 8192); TRRD(h2, b_ + 10240); TRRD(l3, b_ + 12288); TRRD(h3, b_ + 14336);
    asm volatile("s_waitcnt lgkmcnt(0)" ::: "memory"); SBAR();
    o[OI] = __builtin_amdgcn_mfma_f32_32x32x16_bf16(pa0, (bf16x8){l0[0], l0[1], l0[2], l0[3], h0[0], h0[1], h0[2], h0[3]}, o[OI], 0, 0, 0);
    o[OI] = __builtin_amdgcn_mfma_f32_32x32x16_bf16(pa1, (bf16x8){l1[0], l1[1], l1[2], l1[3], h1[0], h1[1], h1[2], h1[3]}, o[OI], 0, 0, 0);
    o[OI] = __builtin_amdgcn_mfma_f32_32x32x16_bf16(pa2, (bf16x8){l2[0], l2[1], l2[2], l2[3], h2[0], h2[1], h2[2], h2[3]}, o[OI], 0, 0, 0);
    o[OI] = __builtin_amdgcn_mfma_f32_32x32x16_bf16(pa3, (bf16x8){l3[0], l3[1], l3[2], l3[3], h3[0], h3[1], h3[2], h3[3]}, o[OI], 0, 0, 0);
}
template <int VB>
__device__ __forceinline__ void pv_tile(f32x16* o, int vb0, bf16x8 pa0, bf16x8 pa1, bf16x8 pa2, bf16x8 pa3) {
    pv_d0<VB, 0, 0>(o, vb0, pa0, pa1, pa2, pa3); pv_d0<VB, 1, 1>(o, vb0, pa0, pa1, pa2, pa3);
    pv_d0<VB, 2, 2>(o, vb0, pa0, pa1, pa2, pa3); pv_d0<VB, 3, 3>(o, vb0, pa0, pa1, pa2, pa3);
}
template <int VB, int CH>
__device__ __forceinline__ void pv_half(f32x16* o, int vb0, bf16x8 pa0, bf16x8 pa1, bf16x8 pa2, bf16x8 pa3) {
    pv_d0<VB, 2 * CH, 0>(o, vb0, pa0, pa1, pa2, pa3); pv_d0<VB, 2 * CH + 1, 1>(o, vb0, pa0, pa1, pa2, pa3);
}

__device__ __forceinline__ void attn_block(char* lds, const bf16_t* QN, const bf16_t* QR, const bf16_t* KN, const bf16_t* KPE, const bf16_t* VV, bf16_t* O, int bh, int qb) {
    int tid = threadIdx.x; asm volatile("" : "+v"(tid));
    const int wid = __builtin_amdgcn_readfirstlane(tid >> 6), lane = tid & 63, r32 = lane & 31, hi = lane >> 5;
    const int b = bh >> 3, h = bh & 7, P0 = qb * 256, NT = 4 * qb + 4;
    const int cw = (P0 + 32 * wid) >> 6;
    bf16x8 qr[12];
    { const bf16_t* qn = QN + ((size_t)bh * NS + P0 + wid * 32 + r32) * 128; const bf16_t* qp = QR + ((size_t)bh * NS + P0 + wid * 32 + r32) * RD;
#pragma unroll
      for (int d0 = 0; d0 < 8; ++d0) qr[d0] = *(const bf16x8*)(qn + d0 * 16 + hi * 8);
#pragma unroll
      for (int dd = 0; dd < 4; ++dd) qr[8 + dd] = *(const bf16x8*)(qp + dd * 16 + hi * 8); }
    const bf16_t* Kh = KN + (size_t)bh * NS * 128; const bf16_t* Vh = VV + (size_t)bh * NS * 128; const bf16_t* Kp = KPE + (size_t)b * NS * RD;
    const int sr = tid >> 4, sc = (tid & 15) * 8, rr = tid >> 3, rc = (tid & 7) * 8;
    const int kws = KSWZ(sr, sc * 2), vst0 = v_st(sr, sc), vst1 = v_st(32 + sr, sc), krw = KRSWZ(rr, rc * 2);
    const int vb0 = (int)(uintptr_t)(lds + OFF_V) + v_rd_base(lane);
    float* wsf = (float*)(lds + OFF_WS) + wid * 64; float* li_l = wsf; float* al_l = wsf + 32;
    bf16x8 sk0, sk1, sv0, sv1, skr;
#define SLOAD(k0) do { sk0 = *(const bf16x8*)(Kh + (size_t)((k0) + sr) * 128 + sc); sk1 = *(const bf16x8*)(Kh + (size_t)((k0) + 32 + sr) * 128 + sc); \
        sv0 = *(const bf16x8*)(Vh + (size_t)((k0) + sr) * 128 + sc); sv1 = *(const bf16x8*)(Vh + (size_t)((k0) + 32 + sr) * 128 + sc); \
        skr = *(const bf16x8*)(Kp + (size_t)((k0) + rr) * RD + rc); } while (0)
#define SWRITE(bf) do { *(bf16x8*)(lds + OFF_KN + (bf) * SHM_KN + kws) = sk0; *(bf16x8*)(lds + OFF_KN + (bf) * SHM_KN + kws + 32 * 256) = sk1; \
        *(bf16x8*)(lds + OFF_V + (bf) * SHM_V + vst0) = sv0; *(bf16x8*)(lds + OFF_V + (bf) * SHM_V + vst1) = sv1; \
        *(bf16x8*)(lds + OFF_KR + (bf) * SHM_KR + krw) = skr; } while (0)
    float m_reg = -1e30f, l_reg = 0.f; f32x16 o[4] = {};
    __syncthreads();
    SLOAD(0); SWRITE(0);
    __syncthreads();
#define COMPUTE(KB) do { f32x16 p0, p1; float mn, alpha; bf16x8 pa0, pa1, pa2, pa3; \
        qkt<KB>(p0, p1, lds, r32, hi, qr); partialSM(p0, p1, m_reg, mn, alpha); \
        if (__any(alpha < 1.f)) { if (hi == 0) al_l[r32] = alpha; asm volatile("s_waitcnt lgkmcnt(0)" ::: "memory"); \
            _Pragma("unroll") for (int r = 0; r < 16; ++r) { const float a_ = al_l[crow(r, hi)]; _Pragma("unroll") for (int d_ = 0; d_ < 4; ++d_) o[d_][r] *= a_; } } \
        finishSM(p0, p1, alpha, l_reg, pa0, pa1, pa2, pa3); SBAR(); \
        pv_tile<KB>(o, vb0, pa0, pa1, pa2, pa3); } while (0)
    for (int t = 0; t < NT; t += 2) {
        SLOAD((t + 1) * 64);
        if (t <= cw) COMPUTE(0);
        SWRITE(1);
        __syncthreads();
        if (t + 2 < NT) SLOAD((t + 2) * 64);
        if (t + 1 <= cw) COMPUTE(1);
        if (t + 2 < NT) SWRITE(0);
        __syncthreads();
    }
#undef COMPUTE
#undef SLOAD
#undef SWRITE
    if (hi == 0) li_l[r32] = l_reg;
    asm volatile("s_waitcnt lgkmcnt(0)" ::: "memory");
    float rli[16];
#pragma unroll
    for (int r = 0; r < 16; ++r) rli[r] = __builtin_amdgcn_rcpf(li_l[crow(r, hi)]);
    bf16_t* Ow = O + ((size_t)b * NS + P0 + wid * 32) * DM + h * 128;
#pragma unroll
    for (int r = 0; r < 16; ++r) { const int orow = crow(r, hi);
#pragma unroll
        for (int d0 = 0; d0 < 4; ++d0) { const float v = o[d0][r] * rli[r]; const float vn = __shfl_xor(v, 1);
            if ((r32 & 1) == 0) *(unsigned*)(Ow + (size_t)orow * DM + d0 * 32 + r32) = cvtpk(v, vn); } }
}
__device__ __forceinline__ void attn_phase(char* lds, const bf16_t* QN, const bf16_t* QR, const bf16_t* KN, const bf16_t* KPE, const bf16_t* VV, bf16_t* O, int G, int blk) {
    for (int L = blk; L < 512; L += G) {
        const int xcd = L & 7, k = L >> 3, bh = xcd * 8 + (k >> 3), y = k & 7;
        attn_block(lds, QN, QR, KN, KPE, VV, O, bh, 15 - y);
        attn_block(lds, QN, QR, KN, KPE, VV, O, bh, y);
    }
}

__device__ __forceinline__ void spatial_phase(char* lds, const bf16_t* U, const bf16_t* V, const float* vpart, const float* g_gv, const bf16_t* Wsp, const float* bsp, bf16_t* Y, int G, int blk0) {
    int tid = threadIdx.x; asm volatile("" : "+v"(tid));
    const int wid = __builtin_amdgcn_readfirstlane(tid >> 6), lane = tid & 63, r32 = lane & 31, hi = lane >> 5;
    float* mu_l = (float*)(lds + 40960); float* rs_l = mu_l + 128;
    const int vb0 = (int)(uintptr_t)(lds + OFF_V) + v_rd_base(lane);
    const int sr = tid >> 4, sc = (tid & 15) * 8;
    const int ts = (wid & 3) * 32, ch = wid >> 2;
    for (int blk = blk0; blk < MROWS / 128; blk += G) {
        __syncthreads();
        if (tid < 128) { const f32x2* pp = (const f32x2*)(vpart + (size_t)(blk * 128 + tid) * 96); float s = 0.f, q = 0.f;
            for (int i = 0; i < 48; ++i) { const f32x2 v = pp[i]; s += v.x; q += v.y; }
            const float mean = s * (1.f / GWID); float var = q * (1.f / GWID) - mean * mean; var = var < 0.f ? 0.f : var;
            mu_l[tid] = mean; rs_l[tid] = __builtin_amdgcn_rsqf(var + EPS); }
        __syncthreads();
        for (int g = 0; g < 12; ++g) {
            { f32x4 gg0 = *(const f32x4*)(g_gv + g * 128 + sc), gg1 = *(const f32x4*)(g_gv + g * 128 + sc + 4);
#pragma unroll
              for (int q = 0; q < 4; ++q) { const int s = sr + 32 * q; const u32x4 w = *(const u32x4*)(V + (size_t)(blk * 128 + s) * GWID + g * 128 + sc);
                f32x4 a, b2; unpack8(w, a, b2); const float mu = mu_l[s], rs = rs_l[s];
                a = (a - mu) * rs * gg0; b2 = (b2 - mu) * rs * gg1;
                *(bf16x8*)(lds + OFF_V + (q >> 1) * SHM_V + v_st(s & 63, sc)) = pack8(a, b2); } }
            __syncthreads();
            f32x16 o[2] = {};
            const bf16_t* wrow = Wsp + ((size_t)(g * 128 + ts + r32)) * 128 + hi * 8;
            { bf16x8 pa0 = *(const bf16x8*)(wrow), pa1 = *(const bf16x8*)(wrow + 16), pa2 = *(const bf16x8*)(wrow + 32), pa3 = *(const bf16x8*)(wrow + 48);
              if (ch == 0) pv_half<0, 0>(o, vb0, pa0, pa1, pa2, pa3); else pv_half<0, 1>(o, vb0, pa0, pa1, pa2, pa3); }
            if (ts >= 64) { bf16x8 pa0 = *(const bf16x8*)(wrow + 64), pa1 = *(const bf16x8*)(wrow + 80), pa2 = *(const bf16x8*)(wrow + 96), pa3 = *(const bf16x8*)(wrow + 112);
              if (ch == 0) pv_half<1, 0>(o, vb0, pa0, pa1, pa2, pa3); else pv_half<1, 1>(o, vb0, pa0, pa1, pa2, pa3); }
#pragma unroll
            for (int r = 0; r < 16; ++r) { const int t = ts + crow(r, hi); const float bb = bsp[g * 128 + t];
#pragma unroll
                for (int dd = 0; dd < 2; ++dd) { const size_t idx = (size_t)(blk * 128 + t) * GWID + g * 128 + (2 * ch + dd) * 32 + r32;
                    const float yv = bf2f(U[idx]) * (o[dd][r] + bb); const float yn = __shfl_xor(yv, 1);
                    if ((r32 & 1) == 0) *(unsigned*)(Y + idx) = cvtpk(yv, yn); } }
            __syncthreads();
        }
    }
}
#undef TRRD
#undef KSWZ
#undef KRSWZ
#undef SBAR
}


#define XB_TMO      128
#define XB_XCNT(j)  (256  + 64 * (j))
#define XB_XSUB(j)  (1280 + 64 * (j))
#define XB_XGEN(j)  (2304 + 64 * (j))
#define XB_TOP      3328
#define XB_TOPGEN   3392
#define XCD_BAR_WORDS 3456
#define XB_SPIN_CAP (1u << 18)
__device__ __forceinline__ unsigned xb_ld(unsigned* p)              { return __hip_atomic_load(p, __ATOMIC_RELAXED, __HIP_MEMORY_SCOPE_AGENT); }
__device__ __forceinline__ unsigned xb_add(unsigned* p, unsigned v) { return __hip_atomic_fetch_add(p, v, __ATOMIC_RELAXED, __HIP_MEMORY_SCOPE_AGENT); }
__device__ __forceinline__ unsigned xb_xcc_id() { return (unsigned)__builtin_amdgcn_s_getreg((3 << 11) | 20) & 0xFu; }
#define XB_SPIN(cond, bar) do { unsigned _sp = 0; while (cond) { __builtin_amdgcn_s_sleep(1); \
    if ((++_sp & 255u) == 0u) { if (xb_ld(&(bar)[XB_TMO])) break; if (_sp > XB_SPIN_CAP) { atomicAdd(&(bar)[XB_TMO], 1u); break; } } } } while (0)
struct XcdBarrier { unsigned* bar; unsigned x; volatile LAS unsigned* st; };
__device__ __forceinline__ XcdBarrier xcd_barrier_post(unsigned* bar, volatile LAS unsigned* st) {
    XcdBarrier b; b.bar = bar; b.x = xb_xcc_id(); b.st = st;
    if (threadIdx.x == 0) (void)xb_add(&bar[XB_XCNT(b.x)], 1u);
    return b;
}
__device__ __forceinline__ void xcd_barrier_complete(unsigned* bar, unsigned x, unsigned& nloc, unsigned& nx) {
    const unsigned G = gridDim.x * gridDim.y * gridDim.z;
    unsigned sum, cnt, mine, sp = 0u;
    for (;;) {
        sum = 0u; cnt = 0u; mine = 0u;
#pragma unroll
        for (unsigned j = 0; j < 16; ++j) { const unsigned c = xb_ld(&bar[XB_XCNT(j)]); sum += c; cnt += (c > 0u) ? 1u : 0u; mine = (j == x) ? c : mine; }
        if (sum == G) break;
        __builtin_amdgcn_s_sleep(1);
        if ((++sp & 255u) == 0u) { if (xb_ld(&bar[XB_TMO])) break; if (sp > XB_SPIN_CAP) { atomicAdd(&bar[XB_TMO], 1u); break; } }
    }
    nloc = mine > 0u ? mine : 1u; nx = cnt > 0u ? cnt : 1u;
}
__device__ __forceinline__ void xcd_barrier(const XcdBarrier& b) {
    asm volatile("s_waitcnt vmcnt(0)" ::: "memory");
    __syncthreads();
    if (threadIdx.x == 0) {
        unsigned* bar = b.bar;
        __builtin_amdgcn_s_waitcnt(0);
        unsigned nloc = b.st[0], nx = b.st[1];
        if (nloc == 0u) { xcd_barrier_complete(bar, b.x, nloc, nx); b.st[0] = nloc; b.st[1] = nx; }
        const unsigned old = xb_add(&bar[XB_XSUB(b.x)], 1u);
        const unsigned gen = old / nloc;
        if (old + 1u == (gen + 1u) * nloc) {
            __builtin_amdgcn_fence(__ATOMIC_RELEASE, "agent");
            asm volatile("s_waitcnt vmcnt(0)" ::: "memory");
            const unsigned og = xb_add(&bar[XB_TOP], 1u);
            const unsigned tg = og / nx;
            if (og + 1u == (tg + 1u) * nx) xb_add(&bar[XB_TOPGEN], 1u);
            else XB_SPIN(xb_ld(&bar[XB_TOPGEN]) == tg, bar);
            __builtin_amdgcn_fence(__ATOMIC_ACQUIRE, "agent");
            xb_add(&bar[XB_XGEN(b.x)], 1u);
            asm volatile("s_waitcnt vmcnt(0)" ::: "memory");
        } else {
            XB_SPIN(xb_ld(&bar[XB_XGEN(b.x)]) == gen, bar);
            __builtin_amdgcn_fence(__ATOMIC_ACQUIRE, "agent");
            asm volatile("s_waitcnt vmcnt(0)" ::: "memory");
        }
    }
    __syncthreads();
}

constexpr int NWAVES = 8, NTHREADS = 512;
constexpr int LDS_BYTES = 147456;
constexpr int NPHASE = 17;

struct Args {
    const float* in[26]; float* out; unsigned char* ws; int ph_lo, ph_hi;
};

enum { MAP_ID = 0, MAP_WIN = 1, MAP_WUQ = 2, MAP_GATE = 3, MAP_UP = 4 };
__device__ __forceinline__ int rowmap(int kind, int n) {
    if (kind == MAP_WIN) {
        if (n < 3072) return n;
        if (n < 3456) return SEG_CQ + (n - 3072);
        if (n < 3712) return SEG_CKV + (n - 3456);
        if (n < 3776) { const int j = n - 3712; return SEG_KR + (j < 32 ? 2 * j : 2 * (j - 32) + 1); }
        if (n < 4800) return SEG_GA + (n - 3776);
        return SEG_GB + (n - 4800);
    }
    if (kind == MAP_WUQ) { const int h = n / 192, r = n % 192; if (r < 128) return h * 128 + r; const int j = r - 128; return 1024 + h * 64 + (j < 32 ? 2 * j : 2 * (j - 32) + 1); }
    if (kind == MAP_GATE) return (n >> 7) * 256 + (n & 127);
    if (kind == MAP_UP) return (n >> 7) * 256 + 128 + (n & 127);
    return n;
}
__device__ __forceinline__ void transpose_item(const float* W, int K, int N, const float* kscale, bf16_t* WT, int kind, LAS float* scr, int item, int lane) {
    const int nblk = N / 32, kb = item / nblk, nb = item % nblk, k0 = 64 * kb, n0 = 32 * nb;
#pragma unroll 8
    for (int i = 0; i < 32; ++i) { const int kk = 2 * i + (lane >> 5); float v = W[(size_t)(k0 + kk) * N + n0 + (lane & 31)]; if (kscale) v *= kscale[k0 + kk]; scr[kk * 33 + (lane & 31)] = v; }
    asm volatile("s_waitcnt lgkmcnt(0)" ::: "memory");
    const int c = lane & 7;
#pragma unroll
    for (int j = 0; j < 4; ++j) { const int n = (lane >> 3) + 8 * j; const LAS float* s = scr + (8 * c) * 33 + n;
        u32x4 o; o.x = cvtpk(s[0 * 33], s[1 * 33]); o.y = cvtpk(s[2 * 33], s[3 * 33]); o.z = cvtpk(s[4 * 33], s[5 * 33]); o.w = cvtpk(s[6 * 33], s[7 * 33]);
        *(u32x4*)(WT + (size_t)rowmap(kind, n0 + n) * K + k0 + 8 * c) = o; }
    asm volatile("s_waitcnt lgkmcnt(0)" ::: "memory");
}
__device__ __forceinline__ void transpose_job(const float* W, int K, int N, const float* kscale, bf16_t* WT, int kind, LAS float* scr, int gw, int NGW, int lane) {
    const int nitems = (K / 64) * (N / 32);
    for (int it = gw; it < nitems; it += NGW) transpose_item(W, K, N, kscale, WT, kind, scr, it, lane);
}
__device__ __forceinline__ void rms_row_to_bf16(const float* xrow, const float* gain, bf16_t* orow, int lane) {
    const f32x4* xr = (const f32x4*)xrow + lane; f32x4 v[4]; float s = 0.f;
#pragma unroll
    for (int j = 0; j < 4; ++j) { v[j] = xr[64 * j]; s += (v[j][0] * v[j][0] + v[j][1] * v[j][1]) + (v[j][2] * v[j][2] + v[j][3] * v[j][3]); }
    const float rstd = 1.f / sqrtf(wave_sum(s) * (1.f / DM) + EPS);
    u32x2* o8 = (u32x2*)orow + lane;
#pragma unroll
    for (int j = 0; j < 4; ++j) { const f32x4 g = ((const f32x4*)gain)[lane + 64 * j]; const f32x4 w = v[j] * rstd * g; o8[64 * j] = (u32x2){cvtpk(w[0], w[1]), cvtpk(w[2], w[3])}; }
}

__global__ void __launch_bounds__(NTHREADS, 2) fwd_kernel(Args args) {
    extern __shared__ __attribute__((aligned(16))) unsigned char lds[];
    LAS unsigned char* ldsl = (LAS unsigned char*)lds;
    const int tid = threadIdx.x, lane = tid & 63, wave = __builtin_amdgcn_readfirstlane(tid >> 6);
    const int G = gridDim.x, blk = blockIdx.x;
    const int gw = blk * NWAVES + wave, NGW = G * NWAVES;
    unsigned char* ws = args.ws;
    const float* x = args.in[0]; const float* p_in = args.in[1]; const float* g_mix = args.in[2]; const float* w_in = args.in[3]; const float* g_gv = args.in[4];
    const float* w_spatial = args.in[5]; const float* b_spatial = args.in[6]; const float* w_gproj = args.in[7]; const float* g_cq = args.in[8]; const float* w_uq = args.in[9];
    const float* g_ckv = args.in[10]; const float* w_ukv = args.in[11]; const float* w_mla_o = args.in[12]; const float* w_out = args.in[13]; const float* g_moe = args.in[14];
    const float* w_router_g = args.in[15]; const float* b_router_g = args.in[16]; const float* w_router_e = args.in[17]; const float* b_router_e = args.in[18];
    const float* w_e_gate = args.in[19]; const float* w_e_up = args.in[20]; const float* w_e_down = args.in[21]; const float* g_ple = args.in[22];
    const float* w_ple_gate = args.in[23]; const float* w_ple_proj = args.in[24]; const float* g_final = args.in[25];
    float* out = args.out;
    int* ctl = (int*)(ws + WS_CTL); int* chunkcnt = (int*)(ws + WS_CHUNKCNT); u32x4* tokinfo = (u32x4*)(ws + WS_TOKINFO);
    int* rowtok = (int*)(ws + WS_ROWTOK); float* roww = (float*)(ws + WS_ROWW);
    float* ropeC = (float*)(ws + WS_ROPEC); float* ropeS = (float*)(ws + WS_ROPES);
    bf16_t* Win_t = (bf16_t*)(ws + WS_WIN); bf16_t* Wgp_t = (bf16_t*)(ws + WS_WGP); bf16_t* Wuq_t = (bf16_t*)(ws + WS_WUQ); bf16_t* Wukv_t = (bf16_t*)(ws + WS_WUKV);
    bf16_t* Wo_t = (bf16_t*)(ws + WS_WO); bf16_t* Wout_t = (bf16_t*)(ws + WS_WOUT); bf16_t* Wr_t = (bf16_t*)(ws + WS_WR); bf16_t* Wpg_t = (bf16_t*)(ws + WS_WPG);
    bf16_t* Wpp_t = (bf16_t*)(ws + WS_WPP); bf16_t* Wsp = (bf16_t*)(ws + WS_WSP); bf16_t* Pb = (bf16_t*)(ws + WS_PB);
    float* vpart = (float*)(ws + WS_VPART); float* cqpart = (float*)(ws + WS_CQPART); float* ckvpart = (float*)(ws + WS_CKVPART); float* rstd3 = (float*)(ws + WS_RSTD3);
    bf16_t* Ub = (bf16_t*)(ws + WS_U); bf16_t* Vb = (bf16_t*)(ws + WS_V); bf16_t* GA = (bf16_t*)(ws + WS_GA); bf16_t* GB = (bf16_t*)(ws + WS_GB);
    bf16_t* CQ = (bf16_t*)(ws + WS_CQ); bf16_t* CKV = (bf16_t*)(ws + WS_CKV); bf16_t* KPE = (bf16_t*)(ws + WS_KPE);
    bf16_t* QN = (bf16_t*)(ws + WS_QN); bf16_t* KN = (bf16_t*)(ws + WS_KN); bf16_t* VV = (bf16_t*)(ws + WS_VV); bf16_t* QR = (bf16_t*)(ws + WS_QR);
    bf16_t* Mb = (bf16_t*)(ws + WS_MB); bf16_t* Wgu_t = (bf16_t*)(ws + WS_WGU); bf16_t* Wd_t = (bf16_t*)(ws + WS_WD); float* LOG = (float*)(ws + WS_LOG);
    bf16_t* HID = (bf16_t*)(ws + WS_HID); bf16_t* YS = (bf16_t*)(ws + WS_YS); bf16_t* H2b = (bf16_t*)(ws + WS_H2B); bf16_t* PP = (bf16_t*)(ws + WS_PP);
    bf16_t* XA = (bf16_t*)out; bf16_t* Yb = (bf16_t*)out; bf16_t* Ob = (bf16_t*)out; float* H = out;

    const int lo = args.ph_lo, hi = args.ph_hi;
#ifndef PHMASK
#define PHMASK 0xFFFFFFFFu
#endif
#define IN(k) (((PHMASK >> (k)) & 1u) && lo <= (k) && (k) < hi)
#ifndef CG_SEAM0
#define CG_SEAM0 1
#endif
#define SEAM(k) do { if (IN(k) && IN((k) + 1)) { if (CG_SEAM0 && (k) == 0) { __threadfence(); cg::this_grid().sync(); } else xcd_barrier(bar); } } while (0)
    volatile LAS unsigned* bst = (volatile LAS unsigned*)(ldsl + LDS_BYTES - 16);
    if (tid < 4) bst[tid] = 0u;
    __syncthreads();
    XcdBarrier bar; bar.bar = (unsigned*)(ws + WS_BAR); bar.x = 0; bar.st = nullptr;
    if (hi - lo > 1) bar = xcd_barrier_post((unsigned*)(ws + WS_BAR), bst);

    if (IN(0)) {
        LAS float* scr = (LAS float*)(ldsl + wave * 16384);
        transpose_job(w_in, DM, 5824, nullptr, Win_t, MAP_WIN, scr, gw, NGW, lane);
        transpose_job(w_gproj, GWID, DM, nullptr, Wgp_t, MAP_ID, scr, gw, NGW, lane);
        transpose_job(w_uq, QL, 1536, g_cq, Wuq_t, MAP_WUQ, scr, gw, NGW, lane);
        transpose_job(w_ukv, KVL, 2048, g_ckv, Wukv_t, MAP_ID, scr, gw, NGW, lane);
        transpose_job(w_mla_o, DM, DM, nullptr, Wo_t, MAP_ID, scr, gw, NGW, lane);
        transpose_job(w_out, DM, DM, nullptr, Wout_t, MAP_ID, scr, gw, NGW, lane);
        transpose_job(w_ple_gate, DM, DM, g_ple, Wpg_t, MAP_ID, scr, gw, NGW, lane);
        transpose_job(w_ple_proj, PLE, DM, nullptr, Wpp_t, MAP_ID, scr, gw, NGW, lane);
        const int gt = blk * NTHREADS + tid, NGT = G * NTHREADS;
        for (int i = gt; i < 64 * DM; i += NGT) Win_t[(size_t)SEG_PAD * DM + i] = 0;
        for (int i = gt; i < 256 * DM; i += NGT) { const int n = i >> 10, k = i & 1023; float v = 0.f;
            if (n < 8) v = w_router_g[k * 8 + n]; else if (n < 72) v = w_router_e[k * 64 + (n - 8)];
            Wr_t[i] = (bf16_t)(cvtpk(v, 0.f) & 0xffffu); }
        for (int i = gt; i < 12 * 128 * 128; i += NGT) { const int t = (i >> 7) & 127, s = i & 127; const float v = ((s >> 6) <= (t >> 6)) ? w_spatial[i] : 0.f; Wsp[i] = (bf16_t)(cvtpk(v, 0.f) & 0xffffu); }
        for (int i = gt; i < NS * 32; i += NGT) { const int s = i >> 5, j = i & 31; const double inv = exp(-(double)j * (1.0 / 32.0) * 9.210340371976184); const double a = (double)s * inv;
            ropeC[i] = (float)cos(a); ropeS[i] = (float)sin(a); }
        for (int i = gt; i < MROWS * PLE / 4; i += NGT) { const f32x4 v = ((const f32x4*)p_in)[i]; ((u32x2*)Pb)[i] = (u32x2){cvtpk(v[0], v[1]), cvtpk(v[2], v[3])}; }
        for (int m = gw; m < MROWS; m += NGW) rms_row_to_bf16(x + (size_t)m * DM, g_mix, XA + (size_t)m * DM, lane);
    }
    SEAM(0);
    if (IN(1)) {
        pg8::SchedDense S; S.init(XA, Win_t, MROWS, ZN, DM, G, blk);
        pg8::EpiZ E{Ub, Vb, GA, GB, CQ, CKV, KPE, vpart, cqpart, ckvpart, ropeC, ropeS};
        pg8::gemm_phase(ldsl, DM, S, E);
    }
    SEAM(1);
    if (IN(2)) { att::spatial_phase((char*)lds, Ub, Vb, vpart, g_gv, Wsp, b_spatial, Yb, G, blk); }
    SEAM(2);
    if (IN(3)) {
#ifndef SUBMASK
#define SUBMASK 7
#endif
        if (SUBMASK & 1) { pg8::SchedDense S; S.init(Yb, Wgp_t, MROWS, DM, GWID, G, blk); pg8::EpiMul E{GA}; pg8::gemm_phase(ldsl, GWID, S, E); }
        __syncthreads();
        if (SUBMASK & 2) { pg8::SchedDense S; S.init(CQ, Wuq_t, MROWS, 1536, QL, G, blk); pg8::EpiQ E{QN, QR, cqpart, ropeC, ropeS}; pg8::gemm_phase(ldsl, QL, S, E); }
        __syncthreads();
        if (SUBMASK & 4) { pg8::SchedDense S; S.init(CKV, Wukv_t, MROWS, 2048, KVL, G, blk); pg8::EpiKV E{KN, VV, ckvpart}; pg8::gemm_phase(ldsl, KVL, S, E); }
    }
    SEAM(3);
    if (IN(4)) { att::attn_phase((char*)lds, QN, QR, KN, KPE, VV, Ob, G, blk); }
    SEAM(4);
    if (IN(5)) {
        { pg8::SchedDense S; S.init(Ob, Wo_t, MROWS, DM, DM, G, blk); pg8::EpiMulAdd E{GA, GB}; pg8::gemm_phase(ldsl, DM, S, E); }
        __syncthreads();
        LAS float* scr = (LAS float*)(ldsl + wave * 16384);
        for (int it = gw; it < NEXP * 128; it += NGW) { const int e = it >> 7, sub = it & 127;
            transpose_item(w_e_gate + (size_t)e * DM * DEXP, DM, DEXP, nullptr, Wgu_t + (size_t)e * 512 * DM, MAP_GATE, scr, sub, lane);
            transpose_item(w_e_up + (size_t)e * DM * DEXP, DM, DEXP, nullptr, Wgu_t + (size_t)e * 512 * DM, MAP_UP, scr, sub, lane);
            transpose_item(w_e_down + (size_t)e * DEXP * DM, DEXP, DM, nullptr, Wd_t + (size_t)e * DM * DEXP, MAP_ID, scr, sub, lane); }
    }
    SEAM(5);
    if (IN(6)) { pg8::SchedDense S; S.init(GA, Wout_t, MROWS, DM, DM, G, blk); pg8::EpiRes E{x, H}; pg8::gemm_phase(ldsl, DM, S, E); }
    SEAM(6);
    if (IN(7)) { for (int m = gw; m < MROWS; m += NGW) rms_row_to_bf16(H + (size_t)m * DM, g_moe, Mb + (size_t)m * DM, lane); }
    SEAM(7);
    if (IN(8)) { pg8::SchedDense S; S.init(Mb, Wr_t, MROWS, 256, DM, G, blk); pg8::EpiRouter E{LOG}; pg8::gemm_phase(ldsl, DM, S, E); }
    SEAM(8);
    if (IN(9)) {
        LAS int* hist = (LAS int*)ldsl;
        for (int chunk = blk; chunk < MROWS / 128; chunk += G) {
            __syncthreads();
            if (tid < 64) hist[tid] = 0;
            __syncthreads();
            if (tid < 128) {
                const int tok = chunk * 128 + tid; const float* lg = LOG + (size_t)tok * 72;
                float gl[8]; float gm = -1e30f;
#pragma unroll
                for (int i = 0; i < 8; ++i) { gl[i] = lg[i]; gm = fmaxf(gm, gl[i]); }
                float gs = 0.f;
#pragma unroll
                for (int i = 0; i < 8; ++i) { gl[i] = expf(gl[i] - gm); gs += gl[i]; }
                int gi = 0; float gbest = -1e30f, gw_ = 0.f;
#pragma unroll
                for (int i = 0; i < 8; ++i) { const float pr = gl[i] / gs; const float sc_ = pr + b_router_g[i]; if (sc_ > gbest) { gbest = sc_; gi = i; gw_ = pr; } }
                float el[8]; float em = -1e30f;
#pragma unroll
                for (int i = 0; i < 8; ++i) { el[i] = lg[8 + gi * 8 + i]; em = fmaxf(em, el[i]); }
                float es = 0.f;
#pragma unroll
                for (int i = 0; i < 8; ++i) { el[i] = expf(el[i] - em); es += el[i]; }
                int i0 = 0, i1 = 0; float s0 = -1e30f, s1 = -1e30f, p0 = 0.f, p1 = 0.f;
#pragma unroll
                for (int i = 0; i < 8; ++i) { const float pr = el[i] / es; const float sc_ = pr + b_router_e[gi * 8 + i];
                    if (sc_ > s0) { s1 = s0; i1 = i0; p1 = p0; s0 = sc_; i0 = i; p0 = pr; } else if (sc_ > s1) { s1 = sc_; i1 = i; p1 = pr; } }
                const float den = p0 + p1; const float w0 = gw_ * (p0 / den), w1 = gw_ * (p1 / den);
                const int e0 = gi * 8 + i0, e1 = gi * 8 + i1;
                const int r0 = __hip_atomic_fetch_add(&hist[e0], 1, __ATOMIC_RELAXED, __HIP_MEMORY_SCOPE_WORKGROUP);
                const int r1 = __hip_atomic_fetch_add(&hist[e1], 1, __ATOMIC_RELAXED, __HIP_MEMORY_SCOPE_WORKGROUP);
                tokinfo[tok] = (u32x4){(unsigned)(e0 | (r0 << 8)), (unsigned)(e1 | (r1 << 8)), __float_as_uint(w0), __float_as_uint(w1)};
            }
            __syncthreads();
            if (tid < 64) chunkcnt[chunk * 64 + tid] = hist[tid];
        }
    }
    SEAM(9);
    if (IN(10)) {
        LAS int* tot = (LAS int*)ldsl; LAS int* base = tot + 64; LAS int* cbase = tot + 128;
        if (tid < 64) { int s = 0; for (int c = 0; c < MROWS / 128; ++c) s += chunkcnt[c * 64 + tid]; tot[tid] = s; }
        __syncthreads();
        if (tid == 0) { int acc = 0; for (int e = 0; e < 64; ++e) { base[e] = acc; acc += (tot[e] + 255) & ~255; }
            if (blk == 0) { ctl[0] = acc >> 8; int rt = 0; for (int e = 0; e < 64; ++e) { const int n = (tot[e] + 255) >> 8; for (int i = 0; i < n; ++i) ctl[16 + rt++] = e; } } }
        __syncthreads();
        for (int e = blk; e < 64; e += G) { const int b0 = base[e] + tot[e], b1 = base[e] + ((tot[e] + 255) & ~255); for (int s = b0 + tid; s < b1; s += NTHREADS) { rowtok[s] = -1; roww[s] = 0.f; } }
        for (int chunk = blk; chunk < MROWS / 128; chunk += G) {
            __syncthreads();
            if (tid < 64) { int s = 0; for (int c = 0; c < chunk; ++c) s += chunkcnt[c * 64 + tid]; cbase[tid] = s; }
            __syncthreads();
            if (tid < 128) { const int tok = chunk * 128 + tid; const u32x4 ti = tokinfo[tok];
                const int e0 = ti.x & 255, r0 = ti.x >> 8, e1 = ti.y & 255, r1 = ti.y >> 8;
                const int s0 = base[e0] + cbase[e0] + r0, s1 = base[e1] + cbase[e1] + r1;
                rowtok[s0] = tok * 2; roww[s0] = __uint_as_float(ti.z); rowtok[s1] = tok * 2 + 1; roww[s1] = __uint_as_float(ti.w); }
        }
    }
    SEAM(10);
    if (IN(11)) { pg8::SchedGU S{Mb, rowtok, Wgu_t, ctl + 16, ctl[0], G, blk}; pg8::EpiGU E{HID}; pg8::gemm_phase(ldsl, DM, S, E); }
    SEAM(11);
    if (IN(12)) { pg8::SchedDown S{HID, Wd_t, ctl + 16, ctl[0], G, blk}; pg8::EpiDown E{YS, rowtok, roww}; pg8::gemm_phase(ldsl, DEXP, S, E); }
    SEAM(12);
    if (IN(13)) {
        for (int m = gw; m < MROWS; m += NGW) {
            f32x4* hr = (f32x4*)(H + (size_t)m * DM) + lane; const u32x2* y0 = (const u32x2*)(YS + (size_t)m * DM) + lane; const u32x2* y1 = (const u32x2*)(YS + ((size_t)MROWS + m) * DM) + lane;
            u32x2* hb = (u32x2*)(H2b + (size_t)m * DM) + lane; float s = 0.f;
#pragma unroll
            for (int j = 0; j < 4; ++j) { f32x4 v = hr[64 * j]; const u32x2 a = y0[64 * j], b = y1[64 * j];
                v[0] += bflo(a.x) + bflo(b.x); v[1] += bfhi(a.x) + bfhi(b.x); v[2] += bflo(a.y) + bflo(b.y); v[3] += bfhi(a.y) + bfhi(b.y);
                hr[64 * j] = v; hb[64 * j] = (u32x2){cvtpk(v[0], v[1]), cvtpk(v[2], v[3])};
                s += (v[0] * v[0] + v[1] * v[1]) + (v[2] * v[2] + v[3] * v[3]); }
            s = wave_sum(s);
            if (lane == 0) rstd3[m] = 1.f / sqrtf(s * (1.f / DM) + EPS);
        }
    }
    SEAM(13);
    if (IN(14)) {
        { pg8::SchedDense S; S.init(Pb, Wpp_t, MROWS, DM, PLE, G, blk); pg8::EpiPP E{PP}; pg8::gemm_phase(ldsl, PLE, S, E); }
        __syncthreads();
        { pg8::SchedDense S; S.init(H2b, Wpg_t, MROWS, DM, DM, G, blk); pg8::EpiPLE E{H, PP, rstd3}; pg8::gemm_phase(ldsl, DM, S, E); }
    }
    SEAM(14);
    if (IN(15)) {
        for (int m = gw; m < MROWS; m += NGW) {
            f32x4* hr = (f32x4*)(H + (size_t)m * DM) + lane; f32x4 v[4]; float s = 0.f;
#pragma unroll
            for (int j = 0; j < 4; ++j) { v[j] = hr[64 * j]; s += (v[j][0] * v[j][0] + v[j][1] * v[j][1]) + (v[j][2] * v[j][2] + v[j][3] * v[j][3]); }
            const float rstd = 1.f / sqrtf(wave_sum(s) * (1.f / DM) + EPS);
#pragma unroll
            for (int j = 0; j < 4; ++j) hr[64 * j] = v[j] * rstd * ((const f32x4*)g_final)[lane + 64 * j];
        }
    }
#undef IN
#undef SEAM
}

extern "C" void kernel_launch(void* const* d_in, const int* in_sizes, int n_in, void* d_out, int out_size, void* d_ws, size_t ws_size, hipStream_t stream) {
    static int grid = 0;
    if (grid == 0) {
        if (n_in != 26 || out_size != MROWS * DM || ws_size < WS_END) { fprintf(stderr, "kernel_launch: unexpected shapes (n_in %d out %d ws %zu)\n", n_in, out_size, ws_size); grid = -1; return; }
        int dev = 0, cus = 0, per_cu = 0;
        (void)hipGetDevice(&dev); (void)hipDeviceGetAttribute(&cus, hipDeviceAttributeMultiprocessorCount, dev);
        if (hipFuncSetAttribute((const void*)fwd_kernel, hipFuncAttributeMaxDynamicSharedMemorySize, LDS_BYTES) != hipSuccess) { fprintf(stderr, "kernel_launch: hipFuncSetAttribute failed\n"); grid = -1; return; }
        if (hipOccupancyMaxActiveBlocksPerMultiprocessor(&per_cu, (const void*)fwd_kernel, NTHREADS, LDS_BYTES) != hipSuccess || per_cu < 1) { fprintf(stderr, "kernel_launch: occupancy query says %d\n", per_cu); per_cu = 1; }
        (void)hipGetLastError();
        grid = cus > 0 ? cus : 256;
    }
    if (grid < 0) return;
    Args a{};
    for (int i = 0; i < 26; ++i) a.in[i] = (const float*)d_in[i];
    a.out = (float*)d_out; a.ws = (unsigned char*)d_ws;
    if (hipMemsetAsync((char*)d_ws + WS_BAR, 0, BAR_ZERO_BYTES, stream) != hipSuccess) { fprintf(stderr, "kernel_launch: memset failed\n"); return; }
#if MK_N_LAUNCHES == 1
    a.ph_lo = 0; a.ph_hi = NPHASE;
    void* params[] = {&a};
    hipError_t e = hipLaunchCooperativeKernel((const void*)fwd_kernel, dim3(grid), dim3(NTHREADS), params, LDS_BYTES, stream);
    if (e != hipSuccess) fprintf(stderr, "kernel_launch: cooperative launch failed: %s\n", hipGetErrorString(e));
#else
    for (int ph = 0; ph < 16; ++ph) { a.ph_lo = ph; a.ph_hi = ph + 1; hipLaunchKernelGGL(fwd_kernel, dim3(grid), dim3(NTHREADS), LDS_BYTES, stream, a); }
#endif
}
```

```cpp
#include <hip/hip_runtime.h>
#include <hip/hip_cooperative_groups.h>
#include <cstdio>
#include <cstdint>
namespace cg = cooperative_groups;

#ifndef MK_N_LAUNCHES
#define MK_N_LAUNCHES 1
#endif

#define LAS __attribute__((address_space(3)))
typedef unsigned short bf16_t;
typedef short bf16x8 __attribute__((ext_vector_type(8)));
typedef short s16x4 __attribute__((ext_vector_type(4)));
typedef float f32x4 __attribute__((ext_vector_type(4)));
typedef float f32x2 __attribute__((ext_vector_type(2)));
typedef float f32x16 __attribute__((ext_vector_type(16)));
typedef unsigned u32x4 __attribute__((ext_vector_type(4)));
typedef unsigned u32x2 __attribute__((ext_vector_type(2)));

constexpr int NB = 8, NS = 4096, DM = 1024, MROWS = NB * NS;
constexpr int GWID = 1536, QL = 384, KVL = 256, RD = 64, NH = 8, PLE = 256;
constexpr int ZN = 5888;
constexpr int SEG_V = 1536, SEG_GA = 3072, SEG_GB = 4096, SEG_CQ = 5120, SEG_CKV = 5504, SEG_KR = 5760, SEG_PAD = 5824;
constexpr int NEXP = 64, DEXP = 256;
constexpr int MAXSLOT = 2 * MROWS + NEXP * 256;
constexpr float EPS = 1e-6f;

constexpr size_t MiB = 1u << 20;
constexpr size_t WS_CTL = 0;
constexpr size_t WS_BAR = 8192, BAR_ZERO_BYTES = 16384;
constexpr size_t WS_CHUNKCNT = 64 * 1024;
constexpr size_t WS_TOKINFO = 128 * 1024;
constexpr size_t WS_ROWTOK = 1 * MiB;
constexpr size_t WS_ROWW = 1 * MiB + 384 * 1024;
constexpr size_t WS_ROWRS = 1 * MiB + 768 * 1024;
constexpr size_t WS_TOKSLOT = 2 * MiB + 128 * 1024;
constexpr size_t WS_ROPEC = 2 * MiB + 512 * 1024, WS_ROPES = 3 * MiB;
constexpr size_t WS_WIN = 4 * MiB;
constexpr size_t WS_WGP = 16 * MiB;
constexpr size_t WS_WUQ = 19 * MiB;
constexpr size_t WS_WUKV = 20 * MiB + 512 * 1024;
constexpr size_t WS_WO = 21 * MiB + 512 * 1024;
constexpr size_t WS_WOUT = 23 * MiB + 512 * 1024;
constexpr size_t WS_WR = 25 * MiB + 512 * 1024;
constexpr size_t WS_WPG = 26 * MiB;
constexpr size_t WS_WPP = 28 * MiB;
constexpr size_t WS_WSP = 28 * MiB + 512 * 1024;
constexpr size_t WS_PB = 29 * MiB;
constexpr size_t WS_VPART = 45 * MiB;
constexpr size_t WS_CQPART = 57 * MiB;
constexpr size_t WS_CKVPART = 58 * MiB + 512 * 1024;
constexpr size_t WS_HPART = 59 * MiB + 512 * 1024;
constexpr size_t WS_RSTD3 = 63 * MiB + 512 * 1024;
constexpr size_t WS_TOKRS = 63 * MiB + 768 * 1024;
constexpr size_t WS_RQ = 63 * MiB + 128 * 1024, WS_RKV = 63 * MiB + 256 * 1024;
constexpr size_t WS_U = 64 * MiB, WS_V = 160 * MiB, WS_GA = 256 * MiB, WS_GB = 320 * MiB, WS_CQ = 384 * MiB, WS_CKV = 408 * MiB, WS_KPE = 424 * MiB;
constexpr size_t WS_QN = 64 * MiB, WS_KN = 128 * MiB, WS_VV = 192 * MiB, WS_QR = 428 * MiB;
constexpr size_t WS_MB = 64 * MiB, WS_WGU = 128 * MiB, WS_WD = 192 * MiB, WS_LOG = 224 * MiB;
constexpr size_t WS_HID = 256 * MiB, WS_YS = 320 * MiB, WS_H2B = 64 * MiB, WS_PP = 128 * MiB, WS_H3B = 192 * MiB;
constexpr size_t WS_END = 512 * MiB;

typedef __bf16 bf16x2_t __attribute__((ext_vector_type(2)));
__device__ __forceinline__ unsigned cvtpk(float lo, float hi) { const bf16x2_t v = {(__bf16)lo, (__bf16)hi}; return __builtin_bit_cast(unsigned, v); }
__device__ __forceinline__ float bflo(unsigned w) { return __uint_as_float(w << 16); }
__device__ __forceinline__ float bfhi(unsigned w) { return __uint_as_float(w & 0xffff0000u); }
__device__ __forceinline__ float bf2f(bf16_t b) { return __uint_as_float(((unsigned)b) << 16); }
__device__ __forceinline__ u32x4 pack8u(f32x4 a, f32x4 b) { u32x4 w = {cvtpk(a[0], a[1]), cvtpk(a[2], a[3]), cvtpk(b[0], b[1]), cvtpk(b[2], b[3])}; return w; }
__device__ __forceinline__ bf16x8 pack8(f32x4 a, f32x4 b) { u32x4 w = pack8u(a, b); return *reinterpret_cast<bf16x8*>(&w); }
__device__ __forceinline__ void unpack8(u32x4 w, f32x4& a, f32x4& b) { a = (f32x4){bflo(w.x), bfhi(w.x), bflo(w.y), bfhi(w.y)}; b = (f32x4){bflo(w.z), bfhi(w.z), bflo(w.w), bfhi(w.w)}; }
__device__ __forceinline__ float fsigmoid(float x) { return __builtin_amdgcn_rcpf(1.f + __builtin_amdgcn_exp2f(-1.4426950408889634f * x)); }
__device__ __forceinline__ float gelu_tanh(float x) { const float u = x * (1.f + 0.044715f * x * x); return x * fsigmoid(1.5957691216057308f * u); }
__device__ __forceinline__ float wave_sum(float v) {
#pragma unroll
    for (int o = 1; o < 64; o <<= 1) v += __shfl_xor(v, o);
    return v;
}
__device__ __forceinline__ float quad_sum(float v) {
    const auto a = __builtin_amdgcn_permlane32_swap(__float_as_uint(v), __float_as_uint(v), false, false);
    v = __uint_as_float(a[0]) + __uint_as_float(a[1]);
    const auto b = __builtin_amdgcn_permlane16_swap(__float_as_uint(v), __float_as_uint(v), false, false);
    return __uint_as_float(b[0]) + __uint_as_float(b[1]);
}
__device__ __forceinline__ f32x2 sigmoid2(f32x2 v) { const f32x2 a = v * (-1.4426950408889634f); f32x2 e; e.x = __builtin_amdgcn_exp2f(a.x); e.y = __builtin_amdgcn_exp2f(a.y);
    const f32x2 d = e + 1.0f; f32x2 r; r.x = __builtin_amdgcn_rcpf(d.x); r.y = __builtin_amdgcn_rcpf(d.y); return r; }
__device__ __forceinline__ f32x2 gelu2(f32x2 v) { const f32x2 t = v * v; const f32x2 w = t * (-0.10294323936f) + (-2.30220819881f); const f32x2 a = v * w;
    f32x2 e; e.x = __builtin_amdgcn_exp2f(a.x); e.y = __builtin_amdgcn_exp2f(a.y); const f32x2 d = e + 1.0f; f32x2 r; r.x = __builtin_amdgcn_rcpf(d.x); r.y = __builtin_amdgcn_rcpf(d.y); return v * r; }
__device__ __forceinline__ f32x4 sigmoid4(f32x4 v) { const f32x2 a = sigmoid2((f32x2){v[0], v[1]}), b = sigmoid2((f32x2){v[2], v[3]}); return (f32x4){a.x, a.y, b.x, b.y}; }
__device__ __forceinline__ f32x4 gelu4(f32x4 v) { const f32x2 a = gelu2((f32x2){v[0], v[1]}), b = gelu2((f32x2){v[2], v[3]}); return (f32x4){a.x, a.y, b.x, b.y}; }

namespace pg8 {
constexpr int BM = 256, BK = 64, HALF = 128, HTB = HALF * BK * 2, STAGE_BYTES = 8 * HTB, NXCD = 8, WGM = 8;
__host__ __device__ __forceinline__ int lds_byte(int r, int c) { const int st = (r >> 4) * 2 + (c >> 5), rr = r & 15, cc = c & 31, ob = rr * 64 + cc * 2; return st * 1024 + (ob ^ (((ob >> 9) & 1) << 5)); }
__host__ __device__ __forceinline__ void stage_rc(int b, int& R, int& C) { const int st = b / 1024, sb = b % 1024, swz = sb ^ (((sb >> 9) & 1) << 5); R = (st >> 1) * 16 + swz / 64; C = (st & 1) * 32 + (swz % 64) / 2; }
__host__ __device__ __forceinline__ int perm32(int rho) { const int n = rho >> 4, i = rho & 15; return 8 * (i >> 2) + 4 * n + (i & 3); }

struct Unit { int pm, pn, ex; };

struct SchedDense {
    const bf16_t* A; const bf16_t* Bt; int K; int nM, nN, nwg, G, c;
    __device__ void init(const bf16_t* A_, const bf16_t* Bt_, int M, int N, int K_, int G_, int c_) { A = A_; Bt = Bt_; K = K_; nM = M / BM; nN = N / BM; nwg = nM * nN; G = G_; c = c_; }
    __device__ __forceinline__ bool next(int i, Unit& u) const {
        const long L = (long)i * G + c; if (L >= nwg) return false;
        int wgid = (int)L; { const int q = nwg / NXCD, r = nwg % NXCD, xcd = wgid % NXCD, off = wgid / NXCD; wgid = (xcd < r ? xcd * (q + 1) : r * (q + 1) + (xcd - r) * q) + off; }
        const int nig = WGM * nN, gid = wgid / nig, fm = gid * WGM, gsz = (nM - fm) < WGM ? (nM - fm) : WGM;
        u.pm = fm + ((wgid % nig) % gsz); u.pn = (wgid % nig) / gsz; u.ex = 0; return true;
    }
    __device__ __forceinline__ const char* a_ptr(const Unit& u) const { return (const char*)A + (size_t)u.pm * BM * K * 2; }
    __device__ __forceinline__ const char* b_ptr(const Unit& u) const { return (const char*)Bt + (size_t)u.pn * BM * K * 2; }
    __device__ __forceinline__ void a_off(const Unit&, const int (&R)[2], const int (&C)[2], unsigned (&vo)[2][2]) const {
#pragma unroll
        for (int h = 0; h < 2; ++h)
#pragma unroll
            for (int i = 0; i < 2; ++i) vo[h][i] = (unsigned)((h * HALF + R[i]) * K + C[i]) * 2u;
    }
};
struct SchedRouter {
    const bf16_t* A; const bf16_t* Bt; int c;
    __device__ __forceinline__ bool next(int i, Unit& u) const { if (i > 0 || c >= 256) return false; u.pm = c >> 1; u.pn = 0; u.ex = c & 1; return true; }
    __device__ __forceinline__ const char* a_ptr(const Unit& u) const { return (const char*)A + ((size_t)u.pm * BM * DM + (size_t)u.ex * 512) * 2; }
    __device__ __forceinline__ const char* b_ptr(const Unit& u) const { return (const char*)Bt + (size_t)u.ex * 512 * 2; }
    __device__ __forceinline__ void a_off(const Unit&, const int (&R)[2], const int (&C)[2], unsigned (&vo)[2][2]) const {
#pragma unroll
        for (int h = 0; h < 2; ++h)
#pragma unroll
            for (int i = 0; i < 2; ++i) vo[h][i] = (unsigned)((h * HALF + R[i]) * DM + C[i]) * 2u;
    }
};
struct SchedGU {
    const bf16_t* A; const int* rowtok; const bf16_t* Bt; const int* tile_e; int ntiles; int G, c;
    __device__ __forceinline__ bool next(int i, Unit& u) const {
        const int L = i * G + c; if (L >= ntiles * 2) return false;
        u.pm = L >> 1; u.pn = L & 1; u.ex = tile_e[u.pm]; return true;
    }
    __device__ __forceinline__ const char* a_ptr(const Unit&) const { return (const char*)A; }
    __device__ __forceinline__ const char* b_ptr(const Unit& u) const { return (const char*)Bt + ((size_t)u.ex * 512 + (size_t)u.pn * 256) * DM * 2; }
    __device__ __forceinline__ void a_off(const Unit& u, const int (&R)[2], const int (&C)[2], unsigned (&vo)[2][2]) const {
#pragma unroll
        for (int h = 0; h < 2; ++h)
#pragma unroll
            for (int i = 0; i < 2; ++i) { const int t = rowtok[u.pm * BM + h * HALF + R[i]]; const int tok = t < 0 ? 0 : (t >> 1); vo[h][i] = (unsigned)(tok * DM + C[i]) * 2u; }
    }
};
struct SchedDown {
    const bf16_t* A; const bf16_t* Bt; const int* tile_e; int ntiles; int G, c;
    __device__ __forceinline__ bool next(int i, Unit& u) const {
        const int L = i * G + c; if (L >= ntiles * 4) return false;
        u.pm = L >> 2; u.pn = L & 3; u.ex = tile_e[u.pm]; return true;
    }
    __device__ __forceinline__ const char* a_ptr(const Unit& u) const { return (const char*)A + (size_t)u.pm * BM * DEXP * 2; }
    __device__ __forceinline__ const char* b_ptr(const Unit& u) const { return (const char*)Bt + ((size_t)u.ex * DM + (size_t)u.pn * 256) * DEXP * 2; }
    __device__ __forceinline__ void a_off(const Unit&, const int (&R)[2], const int (&C)[2], unsigned (&vo)[2][2]) const {
#pragma unroll
        for (int h = 0; h < 2; ++h)
#pragma unroll
            for (int i = 0; i < 2; ++i) vo[h][i] = (unsigned)((h * HALF + R[i]) * DEXP + C[i]) * 2u;
    }
};

template <class Epi, class Sched>
__device__ __forceinline__ void gemm_phase(LAS unsigned char* lds, const int K_, const Sched& S, const Epi& E, const int pitch_ = 0) {
    int tid = threadIdx.x; asm volatile("" : "+v"(tid));
    int K = K_; asm volatile("" : "+s"(K));
    const int P = pitch_ ? pitch_ : K_;
    const int wid = __builtin_amdgcn_readfirstlane(tid >> 6), lane = tid & 63, wr = wid >> 2, wc = wid & 3, fr = lane & 15, fq = lane >> 4;
    const int nt = K / BK;
    int RA[2], CA[2]; unsigned voffB[2];
#pragma unroll
    for (int i = 0; i < 2; ++i) { int R, C; stage_rc(tid * 16 + i * 8192, R, C); const int Rb = Epi::PERM ? ((R & ~31) + perm32(R & 31)) : R;
        RA[i] = R; CA[i] = C; voffB[i] = (unsigned)(Rb * P + C) * 2u; }
    const size_t kstep = (size_t)(BK * 2);
    const size_t hstep = (size_t)HALF * P * 2;
    const unsigned ldsw = (unsigned)wid * 1024u;
    const int aoff = lds_byte(wr * 64 + fr, fq * 8), boff = lds_byte(wc * 32 + fr, fq * 8);
#define PG8_SA(b, h) (((b) * 2 + (h)) * HTB)
#define PG8_SB(b, h) ((4 + (b) * 2 + (h)) * HTB)
#define PG8_STAGE(bufoff, gbase, voff) do { _Pragma("unroll") for (int _i = 0; _i < 2; ++_i) \
        __builtin_amdgcn_global_load_lds((const unsigned*)((const char*)(gbase) + (voff)[_i]), (LAS unsigned*)(lds + (bufoff) + ldsw + _i * 8192), 16, 0, 0); } while (0)
#define PG8_LDA(dst, b, h) do { _Pragma("unroll") for (int m = 0; m < 4; ++m) _Pragma("unroll") for (int k = 0; k < 2; ++k) dst[m][k] = *(const LAS bf16x8*)(lds + PG8_SA(b, h) + aoff + m * 2048 + k * 1024); } while (0)
#define PG8_LDB(dst, b, h) do { _Pragma("unroll") for (int n = 0; n < 2; ++n) _Pragma("unroll") for (int k = 0; k < 2; ++k) dst[n][k] = *(const LAS bf16x8*)(lds + PG8_SB(b, h) + boff + n * 2048 + k * 1024); } while (0)
#define PG8_MMA(ai, bj, At, Bt) do { __builtin_amdgcn_s_setprio(1); _Pragma("unroll") for (int m = 0; m < 4; ++m) _Pragma("unroll") for (int n = 0; n < 2; ++n) _Pragma("unroll") for (int k = 0; k < 2; ++k) \
        acc[ai][bj][m][n] = __builtin_amdgcn_mfma_f32_16x16x32_bf16(Bt[n][k], At[m][k], acc[ai][bj][m][n], 0, 0, 0); __builtin_amdgcn_s_setprio(0); } while (0)
#define PG8_WAIT_V(n) asm volatile("s_waitcnt vmcnt(" #n ")" ::: "memory")
#define PG8_WAIT_L(n) asm volatile("s_waitcnt lgkmcnt(" #n ")" ::: "memory")
#define PG8_BAR __builtin_amdgcn_s_barrier()
#define PG8_SCHED __builtin_amdgcn_sched_barrier(0)
    Unit cur, nxt; int ui = 0;
    if (!S.next(0, cur)) return;
    f32x4 acc[2][2][4][2];
#pragma unroll
    for (int a = 0; a < 2; ++a)
#pragma unroll
        for (int b = 0; b < 2; ++b)
#pragma unroll
            for (int m = 0; m < 4; ++m)
#pragma unroll
                for (int n = 0; n < 2; ++n) acc[a][b][m][n] = (f32x4){0.f, 0.f, 0.f, 0.f};
    bf16x8 At[4][2], B0[2][2], B1[2][2];
    unsigned voC[2][2], voN[2][2];
    const char* cA = S.a_ptr(cur); const char* cB = S.b_ptr(cur);
    S.a_off(cur, RA, CA, voC);
    PG8_STAGE(PG8_SB(0, 0), cB, voffB); PG8_STAGE(PG8_SB(0, 1), cB + hstep, voffB); PG8_STAGE(PG8_SA(0, 0), cA, voC[0]); PG8_STAGE(PG8_SA(0, 1), cA, voC[1]);
    if (wr == 1) PG8_BAR;
    PG8_WAIT_V(2); PG8_BAR;
    PG8_STAGE(PG8_SB(1, 0), cB + kstep, voffB); PG8_STAGE(PG8_SA(1, 0), cA + kstep, voC[0]); PG8_STAGE(PG8_SB(1, 1), cB + hstep + kstep, voffB);
    PG8_WAIT_V(6); PG8_BAR;
    for (;;) {
        const bool has_next = S.next(ui + 1, nxt);
        const char* nA = has_next ? S.a_ptr(nxt) : cA; const char* nB = has_next ? S.b_ptr(nxt) : cB;
        if (has_next) S.a_off(nxt, RA, CA, voN);
        else {
#pragma unroll
            for (int h = 0; h < 2; ++h)
#pragma unroll
                for (int i = 0; i < 2; ++i) voN[h][i] = voC[h][i]; }
#pragma nounroll
        for (int t = 0; t < nt; t += 2) {
            const bool last = (t == nt - 2);
            const char* a1 = cA + (size_t)(t + 1) * kstep;
            const char* a2 = last ? nA : cA + (size_t)(t + 2) * kstep; const char* b2 = last ? nB : cB + (size_t)(t + 2) * kstep;
            const char* a3 = a2 + kstep; const char* b3 = b2 + kstep;
            unsigned v2[2][2];
#pragma unroll
            for (int h = 0; h < 2; ++h)
#pragma unroll
                for (int i = 0; i < 2; ++i) v2[h][i] = last ? voN[h][i] : voC[h][i];
            PG8_LDB(B0, 0, 0); PG8_LDB(B1, 0, 1); PG8_SCHED; PG8_LDA(At, 0, 0); PG8_STAGE(PG8_SA(1, 1), a1, voC[1]);
            PG8_WAIT_V(8); PG8_WAIT_L(0); PG8_BAR; PG8_MMA(0, 0, At, B0); PG8_MMA(0, 1, At, B1); PG8_BAR; PG8_SCHED;
            PG8_LDA(At, 0, 1); PG8_STAGE(PG8_SB(0, 0), b2, voffB); PG8_STAGE(PG8_SB(0, 1), b2 + hstep, voffB); PG8_STAGE(PG8_SA(0, 0), a2, v2[0]);
            PG8_WAIT_V(8); PG8_WAIT_L(0); PG8_BAR; PG8_MMA(1, 0, At, B0); PG8_MMA(1, 1, At, B1); PG8_BAR; PG8_SCHED;
            PG8_LDB(B0, 1, 0); PG8_LDB(B1, 1, 1); PG8_SCHED; PG8_LDA(At, 1, 0); PG8_STAGE(PG8_SA(0, 1), a2, v2[1]);
            PG8_WAIT_V(8); PG8_WAIT_L(0); PG8_BAR; PG8_MMA(0, 0, At, B0); PG8_MMA(0, 1, At, B1); PG8_BAR; PG8_SCHED;
            PG8_LDA(At, 1, 1); PG8_STAGE(PG8_SB(1, 0), b3, voffB); PG8_STAGE(PG8_SB(1, 1), b3 + hstep, voffB); PG8_STAGE(PG8_SA(1, 0), a3, v2[0]);
            PG8_WAIT_V(8); PG8_WAIT_L(0); PG8_BAR; PG8_MMA(1, 0, At, B0); PG8_MMA(1, 1, At, B1); PG8_BAR; PG8_SCHED;
        }
        if (wr == 0) PG8_BAR;
        E(acc, cur, wr, wc, fr, fq);
        if (!has_next) break;
#pragma unroll
        for (int a = 0; a < 2; ++a)
#pragma unroll
            for (int b = 0; b < 2; ++b)
#pragma unroll
                for (int m = 0; m < 4; ++m)
#pragma unroll
                    for (int n = 0; n < 2; ++n) acc[a][b][m][n] = (f32x4){0.f, 0.f, 0.f, 0.f};
        cur = nxt; cA = nA; cB = nB; ++ui;
#pragma unroll
        for (int h = 0; h < 2; ++h)
#pragma unroll
            for (int i = 0; i < 2; ++i) voC[h][i] = voN[h][i];
        if (wr == 1) PG8_BAR;
    }
    PG8_WAIT_V(0);
    PG8_BAR;
#undef PG8_SA
#undef PG8_SB
#undef PG8_STAGE
#undef PG8_LDA
#undef PG8_LDB
#undef PG8_MMA
#undef PG8_WAIT_V
#undef PG8_WAIT_L
#undef PG8_BAR
#undef PG8_SCHED
}

typedef f32x4 Acc[2][2][4][2];
#define EPI_ROW(u, ai, wr, m, fr) ((u).pm * 256 + (ai) * 128 + (wr) * 64 + (m) * 16 + (fr))

struct EpiZ {
    static constexpr bool PERM = true;
    bf16_t *U, *V, *GA, *GB, *CQ, *CKV, *KPE; float *vpart, *cqpart, *ckvpart; const float *ropeC, *ropeS;
    __device__ __forceinline__ void operator()(const Acc& acc, const Unit& u, int wr, int wc, int fr, int fq) const {
        const int row0 = u.pm * 256 + wr * 64 + fr;
#define ZROWS(...) _Pragma("unroll") for (int ai = 0; ai < 2; ++ai) _Pragma("unroll") for (int m = 0; m < 4; ++m) { const int row = row0 + 128 * ai + 16 * m; const f32x4 a0 = acc[ai][bj][m][0], a1 = acc[ai][bj][m][1]; __VA_ARGS__ }
#pragma unroll
        for (int bj = 0; bj < 2; ++bj) {
            const int cb = u.pn * 256 + bj * 128 + wc * 32;
            const int c0 = cb + 8 * fq;
            if (cb < SEG_V) {
                bf16_t* p = U + (size_t)row0 * GWID + c0;
                ZROWS( __builtin_nontemporal_store(pack8u(gelu4(a0), gelu4(a1)), (u32x4*)(p + (size_t)(128 * ai + 16 * m) * GWID)); )
            } else if (cb < SEG_GA) {
                bf16_t* p = V + (size_t)row0 * GWID + (c0 - SEG_V); float* sp = vpart + ((size_t)row0 * 48 + ((cb - SEG_V) >> 5)) * 2;
                ZROWS( const f32x4 v0 = gelu4(a0), v1 = gelu4(a1); __builtin_nontemporal_store(pack8u(v0, v1), (u32x4*)(p + (size_t)(128 * ai + 16 * m) * GWID));
                       const f32x4 sv = v0 + v1, qv = v0 * v0 + v1 * v1; float s_ = quad_sum((sv[0] + sv[1]) + (sv[2] + sv[3])), q_ = quad_sum((qv[0] + qv[1]) + (qv[2] + qv[3]));
                       if (fq == 0) *(f32x2*)(sp + (size_t)(128 * ai + 16 * m) * 96) = (f32x2){s_, q_}; )
            } else if (cb < SEG_CQ) {
                bf16_t* p = (cb < SEG_GB ? GA + (c0 - SEG_GA) : GB + (c0 - SEG_GB)) + (size_t)row0 * DM;
                ZROWS( __builtin_nontemporal_store(pack8u(sigmoid4(a0), sigmoid4(a1)), (u32x4*)(p + (size_t)(128 * ai + 16 * m) * DM)); )
            } else if (cb < SEG_CKV) {
                bf16_t* p = CQ + (size_t)row0 * QL + (c0 - SEG_CQ); float* sp = cqpart + (size_t)row0 * 12 + ((cb - SEG_CQ) >> 5);
                ZROWS( __builtin_nontemporal_store(pack8u(a0, a1), (u32x4*)(p + (size_t)(128 * ai + 16 * m) * QL)); const f32x4 qv = a0 * a0 + a1 * a1; const float q_ = quad_sum((qv[0] + qv[1]) + (qv[2] + qv[3]));
                       if (fq == 0) sp[(size_t)(128 * ai + 16 * m) * 12] = q_; )
            } else if (cb < SEG_KR) {
                bf16_t* p = CKV + (size_t)row0 * KVL + (c0 - SEG_CKV); float* sp = ckvpart + (size_t)row0 * 8 + ((cb - SEG_CKV) >> 5);
                ZROWS( __builtin_nontemporal_store(pack8u(a0, a1), (u32x4*)(p + (size_t)(128 * ai + 16 * m) * KVL)); const f32x4 qv = a0 * a0 + a1 * a1; const float q_ = quad_sum((qv[0] + qv[1]) + (qv[2] + qv[3]));
                       if (fq == 0) sp[(size_t)(128 * ai + 16 * m) * 8] = q_; )
            } else if (cb < SEG_PAD) {
                const int j0 = (c0 - SEG_KR) >> 1;
                ZROWS( const int s = row & (NS - 1); const f32x4 cs = *(const f32x4*)(ropeC + s * 32 + j0), sn = *(const f32x4*)(ropeS + s * 32 + j0);
                       f32x4 o0, o1;
                       o0[0] = a0[0] * cs[0] - a0[1] * sn[0]; o0[1] = a0[0] * sn[0] + a0[1] * cs[0];
                       o0[2] = a0[2] * cs[1] - a0[3] * sn[1]; o0[3] = a0[2] * sn[1] + a0[3] * cs[1];
                       o1[0] = a1[0] * cs[2] - a1[1] * sn[2]; o1[1] = a1[0] * sn[2] + a1[1] * cs[2];
                       o1[2] = a1[2] * cs[3] - a1[3] * sn[3]; o1[3] = a1[2] * sn[3] + a1[3] * cs[3];
                       __builtin_nontemporal_store(pack8u(o0, o1), (u32x4*)(KPE + (size_t)row * RD + (c0 - SEG_KR))); )
            }
        }
#undef ZROWS
    }
};
struct EpiMul {
    static constexpr bool PERM = true;
    bf16_t* G;
    __device__ __forceinline__ void operator()(const Acc& acc, const Unit& u, int wr, int wc, int fr, int fq) const {
#pragma unroll
        for (int ai = 0; ai < 2; ++ai) {
            u32x4 g[4][2];
#pragma unroll
            for (int m = 0; m < 4; ++m)
#pragma unroll
                for (int bj = 0; bj < 2; ++bj) g[m][bj] = __builtin_nontemporal_load((const u32x4*)(G + (size_t)EPI_ROW(u, ai, wr, m, fr) * DM + u.pn * 256 + bj * 128 + wc * 32 + 8 * fq));
#pragma unroll
            for (int m = 0; m < 4; ++m)
#pragma unroll
                for (int bj = 0; bj < 2; ++bj) { f32x4 g0, g1; unpack8(g[m][bj], g0, g1);
                    __builtin_nontemporal_store(pack8u(g0 * acc[ai][bj][m][0], g1 * acc[ai][bj][m][1]), (u32x4*)(G + (size_t)EPI_ROW(u, ai, wr, m, fr) * DM + u.pn * 256 + bj * 128 + wc * 32 + 8 * fq)); }
            asm volatile("" ::: "memory");
        }
    }
};
struct EpiMulAdd {
    static constexpr bool PERM = true;
    bf16_t* MA; const bf16_t* GB;
    __device__ __forceinline__ void operator()(const Acc& acc, const Unit& u, int wr, int wc, int fr, int fq) const {
#pragma unroll
        for (int ai = 0; ai < 2; ++ai) {
            u32x4 a[4][2], g[4][2];
#pragma unroll
            for (int m = 0; m < 4; ++m)
#pragma unroll
                for (int bj = 0; bj < 2; ++bj) { const size_t off = (size_t)EPI_ROW(u, ai, wr, m, fr) * DM + u.pn * 256 + bj * 128 + wc * 32 + 8 * fq; a[m][bj] = __builtin_nontemporal_load((const u32x4*)(MA + off)); g[m][bj] = __builtin_nontemporal_load((const u32x4*)(GB + off)); }
#pragma unroll
            for (int m = 0; m < 4; ++m)
#pragma unroll
                for (int bj = 0; bj < 2; ++bj) { const size_t off = (size_t)EPI_ROW(u, ai, wr, m, fr) * DM + u.pn * 256 + bj * 128 + wc * 32 + 8 * fq;
                    f32x4 a0, a1, g0, g1; unpack8(a[m][bj], a0, a1); unpack8(g[m][bj], g0, g1);
                    *(u32x4*)(MA + off) = pack8u(a0 + g0 * acc[ai][bj][m][0], a1 + g1 * acc[ai][bj][m][1]); }
            asm volatile("" ::: "memory");
        }
    }
};
struct EpiRes {
    static constexpr bool PERM = true;
    const float* X; bf16_t* Hb; float* hpart;
    __device__ __forceinline__ void operator()(const Acc& acc, const Unit& u, int wr, int wc, int fr, int fq) const {
#pragma unroll
        for (int ai = 0; ai < 2; ++ai) {
            f32x4 xv[4][2][2];
#pragma unroll
            for (int m = 0; m < 4; ++m)
#pragma unroll
                for (int bj = 0; bj < 2; ++bj) { const size_t off = (size_t)EPI_ROW(u, ai, wr, m, fr) * DM + u.pn * 256 + bj * 128 + wc * 32 + 8 * fq; xv[m][bj][0] = __builtin_nontemporal_load((const f32x4*)(X + off)); xv[m][bj][1] = __builtin_nontemporal_load((const f32x4*)(X + off + 4)); }
#pragma unroll
            for (int m = 0; m < 4; ++m)
#pragma unroll
                for (int bj = 0; bj < 2; ++bj) {
                    const int row = EPI_ROW(u, ai, wr, m, fr), c0 = u.pn * 256 + bj * 128 + wc * 32 + 8 * fq;
                    const f32x4 v0 = xv[m][bj][0] + acc[ai][bj][m][0], v1 = xv[m][bj][1] + acc[ai][bj][m][1];
                    *(u32x4*)(Hb + (size_t)row * DM + c0) = pack8u(v0, v1);
                    float q = (v0[0] * v0[0] + v0[1] * v0[1]) + (v0[2] * v0[2] + v0[3] * v0[3]) + (v1[0] * v1[0] + v1[1] * v1[1]) + (v1[2] * v1[2] + v1[3] * v1[3]);
                    q = quad_sum(q);
                    if (fq == 0) hpart[(size_t)row * 32 + (c0 >> 5)] = q;
                }
            asm volatile("" ::: "memory");
        }
    }
};
struct EpiQ {
    static constexpr bool PERM = true;
    bf16_t *QN, *QR; const float* rq; const float *ropeC, *ropeS;
    __device__ __forceinline__ void operator()(const Acc& acc, const Unit& u, int wr, int wc, int fr, int fq) const {
        float rs[2][4];
#pragma unroll
        for (int ai = 0; ai < 2; ++ai)
#pragma unroll
            for (int m = 0; m < 4; ++m) rs[ai][m] = rq[EPI_ROW(u, ai, wr, m, fr)];
        if (u.pn < 4) {
#pragma unroll
            for (int ai = 0; ai < 2; ++ai)
#pragma unroll
                for (int m = 0; m < 4; ++m) { const int row = EPI_ROW(u, ai, wr, m, fr), b = row >> 12, s = row & (NS - 1); const float rstd = rs[ai][m];
#pragma unroll
                    for (int bj = 0; bj < 2; ++bj) { const int c0 = u.pn * 256 + bj * 128 + wc * 32 + 8 * fq, h = c0 >> 7, d = c0 & 127;
                        *(u32x4*)(QN + (((size_t)(b * NH + h)) * NS + s) * 128 + d) = pack8u(acc[ai][bj][m][0] * rstd, acc[ai][bj][m][1] * rstd); } }
        } else {
#pragma unroll
            for (int ai = 0; ai < 2; ++ai) {
                f32x4 cs[4][2], sn[4][2];
#pragma unroll
                for (int m = 0; m < 4; ++m)
#pragma unroll
                    for (int bj = 0; bj < 2; ++bj) { const int s = EPI_ROW(u, ai, wr, m, fr) & (NS - 1), j0 = ((u.pn * 256 + bj * 128 + wc * 32 + 8 * fq - 1024) & 63) >> 1;
                        cs[m][bj] = *(const f32x4*)(ropeC + s * 32 + j0); sn[m][bj] = *(const f32x4*)(ropeS + s * 32 + j0); }
#pragma unroll
                for (int m = 0; m < 4; ++m) { const int row = EPI_ROW(u, ai, wr, m, fr), b = row >> 12, s = row & (NS - 1); const float rstd = rs[ai][m];
#pragma unroll
                    for (int bj = 0; bj < 2; ++bj) { const int cc = u.pn * 256 + bj * 128 + wc * 32 + 8 * fq - 1024, h = cc >> 6, i0 = cc & 63;
                        const f32x4 v0 = acc[ai][bj][m][0] * rstd, v1 = acc[ai][bj][m][1] * rstd, c = cs[m][bj], n = sn[m][bj];
                        f32x4 o0, o1;
                        o0[0] = v0[0] * c[0] - v0[1] * n[0]; o0[1] = v0[0] * n[0] + v0[1] * c[0];
                        o0[2] = v0[2] * c[1] - v0[3] * n[1]; o0[3] = v0[2] * n[1] + v0[3] * c[1];
                        o1[0] = v1[0] * c[2] - v1[1] * n[2]; o1[1] = v1[0] * n[2] + v1[1] * c[2];
                        o1[2] = v1[2] * c[3] - v1[3] * n[3]; o1[3] = v1[2] * n[3] + v1[3] * c[3];
                        *(u32x4*)(QR + (((size_t)(b * NH + h)) * NS + s) * RD + i0) = pack8u(o0, o1); } }
                asm volatile("" ::: "memory");
            }
        }
    }
};
struct EpiKV {
    static constexpr bool PERM = true;
    bf16_t *KN, *VV; const float* rkv;
    __device__ __forceinline__ void operator()(const Acc& acc, const Unit& u, int wr, int wc, int fr, int fq) const {
        float rs[2][4];
#pragma unroll
        for (int ai = 0; ai < 2; ++ai)
#pragma unroll
            for (int m = 0; m < 4; ++m) rs[ai][m] = rkv[EPI_ROW(u, ai, wr, m, fr)];
#pragma unroll
        for (int ai = 0; ai < 2; ++ai)
#pragma unroll
            for (int m = 0; m < 4; ++m) {
                const int row = EPI_ROW(u, ai, wr, m, fr); const float rstd = rs[ai][m];
                const int b = row >> 12, s = row & (NS - 1);
                const size_t o = (((size_t)(b * NH + u.pn)) * NS + s) * 128 + wc * 32 + 8 * fq;
                *(u32x4*)(KN + o) = pack8u(acc[ai][0][m][0] * rstd, acc[ai][0][m][1] * rstd);
                *(u32x4*)(VV + o) = pack8u(acc[ai][1][m][0] * rstd, acc[ai][1][m][1] * rstd);
            }
    }
};
struct EpiRouter {
    static constexpr bool PERM = false;
    float* LOG;
    __device__ __forceinline__ void operator()(const Acc& acc, const Unit& u, int wr, int wc, int fr, int fq) const {
        if (wc > 2) return;
#pragma unroll
        for (int ai = 0; ai < 2; ++ai)
#pragma unroll
            for (int m = 0; m < 4; ++m) {
                const int row = EPI_ROW(u, ai, wr, m, fr);
#pragma unroll
                for (int n = 0; n < 2; ++n) { const int c = wc * 32 + 16 * n + 4 * fq; if (c < 72) *(f32x4*)(LOG + ((size_t)u.ex * MROWS + row) * 72 + c) = acc[ai][0][m][n]; }
            }
    }
};
struct EpiGU {
    static constexpr bool PERM = true;
    bf16_t* HID; const float* rowrs;
    __device__ __forceinline__ void operator()(const Acc& acc, const Unit& u, int wr, int wc, int fr, int fq) const {
#pragma unroll
        for (int ai = 0; ai < 2; ++ai)
#pragma unroll
            for (int m = 0; m < 4; ++m) {
                const int slot = EPI_ROW(u, ai, wr, m, fr);
                const float rs = rowrs[slot];
                const f32x4 g0 = acc[ai][0][m][0] * rs, g1 = acc[ai][0][m][1] * rs;
                const f32x4 h0 = g0 * sigmoid4(g0) * (acc[ai][1][m][0] * rs), h1 = g1 * sigmoid4(g1) * (acc[ai][1][m][1] * rs);
                if (rs != 0.f) *(u32x4*)(HID + (size_t)slot * DEXP + u.pn * 128 + wc * 32 + 8 * fq) = pack8u(h0, h1);
            }
    }
};
struct EpiDown {
    static constexpr bool PERM = true;
    bf16_t* YS; const float* roww;
    __device__ __forceinline__ void operator()(const Acc& acc, const Unit& u, int wr, int wc, int fr, int fq) const {
        float ww[2][4];
#pragma unroll
        for (int ai = 0; ai < 2; ++ai)
#pragma unroll
            for (int m = 0; m < 4; ++m) ww[ai][m] = roww[EPI_ROW(u, ai, wr, m, fr)];
#pragma unroll
        for (int ai = 0; ai < 2; ++ai)
#pragma unroll
            for (int m = 0; m < 4; ++m) {
                const float w = ww[ai][m];
                bf16_t* dst = YS + (size_t)EPI_ROW(u, ai, wr, m, fr) * DM + u.pn * 256 + wc * 32 + 8 * fq;
                if (w >= 0.f) {
#pragma unroll
                    for (int bj = 0; bj < 2; ++bj) *(u32x4*)(dst + bj * 128) = pack8u(acc[ai][bj][m][0] * w, acc[ai][bj][m][1] * w); }
            }
    }
};
struct EpiPP {
    static constexpr bool PERM = true;
    bf16_t* PP;
    __device__ __forceinline__ void operator()(const Acc& acc, const Unit& u, int wr, int wc, int fr, int fq) const {
#pragma unroll
        for (int ai = 0; ai < 2; ++ai)
#pragma unroll
            for (int m = 0; m < 4; ++m) {
                const int row = EPI_ROW(u, ai, wr, m, fr);
#pragma unroll
                for (int bj = 0; bj < 2; ++bj) *(u32x4*)(PP + (size_t)row * DM + u.pn * 256 + bj * 128 + wc * 32 + 8 * fq) = pack8u(acc[ai][bj][m][0], acc[ai][bj][m][1]);
            }
    }
};
struct EpiPLE {
    static constexpr bool PERM = true;
    const bf16_t* H2b; bf16_t* H3b; const bf16_t* PP; const float* rstd3;
    __device__ __forceinline__ void operator()(const Acc& acc, const Unit& u, int wr, int wc, int fr, int fq) const {
        float rs[2][4];
#pragma unroll
        for (int ai = 0; ai < 2; ++ai)
#pragma unroll
            for (int m = 0; m < 4; ++m) rs[ai][m] = rstd3[EPI_ROW(u, ai, wr, m, fr)];
#pragma unroll
        for (int ai = 0; ai < 2; ++ai)
#pragma unroll
            for (int mh = 0; mh < 2; ++mh) {
                u32x4 hv[2][2], pv[2][2];
#pragma unroll
                for (int mm = 0; mm < 2; ++mm)
#pragma unroll
                    for (int bj = 0; bj < 2; ++bj) { const size_t off = (size_t)EPI_ROW(u, ai, wr, 2 * mh + mm, fr) * DM + u.pn * 256 + bj * 128 + wc * 32 + 8 * fq; hv[mm][bj] = *(const u32x4*)(H2b + off); pv[mm][bj] = *(const u32x4*)(PP + off); }
#pragma unroll
                for (int mm = 0; mm < 2; ++mm)
#pragma unroll
                    for (int bj = 0; bj < 2; ++bj) { const int m = 2 * mh + mm; const size_t off = (size_t)EPI_ROW(u, ai, wr, m, fr) * DM + u.pn * 256 + bj * 128 + wc * 32 + 8 * fq;
                        f32x4 h0, h1, p0, p1; unpack8(hv[mm][bj], h0, h1); unpack8(pv[mm][bj], p0, p1);
                        const f32x4 a0 = acc[ai][bj][m][0], a1 = acc[ai][bj][m][1]; const float r = rs[ai][m];
                        h0 += sigmoid4(a0 * r) * p0; h1 += sigmoid4(a1 * r) * p1;
                        *(u32x4*)(H3b + off) = pack8u(h0, h1); }
                asm volatile("" ::: "memory");
            }
    }
};
}

namespace att {
constexpr int SHM_V = 16384, SHM_KN = 16384, SHM_KR = 8192;
constexpr int OFF_V = 0, OFF_KN = 32768, OFF_KR = 65536, OFF_WS = 81920;
constexpr float SCALE = 0.07216878364870322f;
constexpr float THR = 8.f;
#define KSWZ(row, colB) ((row) * 256 + ((colB) ^ (((row) & 15) << 4)))
#define KRSWZ(row, colB) ((row) * 128 + ((colB) ^ ((((row) >> 1) & 7) << 4)))
#define SBAR() __builtin_amdgcn_sched_barrier(0)
__device__ __forceinline__ int v_st(int k, int c) { const int kk = (k & ~0xC) | ((k & 4) << 1) | ((k & 8) >> 1); return ((kk >> 3) * 4 + (c >> 5)) * 512 + ((kk & 7) * 32 + (c & 31)) * 2; }
__device__ __forceinline__ int v_rd_base(int lane) { return ((lane & 3) << 3) | (((lane >> 2) & 3) << 6) | (((lane >> 4) & 1) << 5) | (((lane >> 5) & 1) << 8); }
constexpr int v_rd_off(int d0, int ks, int half) { return d0 * 512 + ks * 4096 + half * 2048; }
__device__ __forceinline__ int crow(int r, int hi) { return (r & 3) + 8 * (r >> 2) + 4 * hi; }

__device__ __forceinline__ void partialSM(f32x16& p0, f32x16& p1, float& m_reg, float& mn, float& alpha) {
    float pmax = p0[0];
#pragma unroll
    for (int r = 1; r < 16; ++r) pmax = fmaxf(pmax, p0[r]);
#pragma unroll
    for (int r = 0; r < 16; ++r) pmax = fmaxf(pmax, p1[r]);
    { auto rr = __builtin_amdgcn_permlane32_swap(__float_as_uint(pmax), __float_as_uint(pmax), false, false);
      pmax = fmaxf(__uint_as_float(rr[0]), __uint_as_float(rr[1])); }
    constexpr float C2 = 1.4426950408889634f * SCALE;
    if (__builtin_expect(__all((pmax - m_reg) * SCALE <= THR), 1)) { mn = m_reg; alpha = 1.f; }
    else { mn = fmaxf(m_reg, pmax); alpha = __builtin_amdgcn_exp2f((m_reg - mn) * C2); m_reg = mn; }
    const float mnL = -mn * C2;
#pragma unroll
    for (int r = 0; r < 16; ++r) p0[r] = fmaf(p0[r], C2, mnL);
#pragma unroll
    for (int r = 0; r < 16; ++r) p1[r] = fmaf(p1[r], C2, mnL);
#pragma unroll
    for (int r = 0; r < 16; ++r) p0[r] = __builtin_amdgcn_exp2f(p0[r]);
}
__device__ __forceinline__ void finishSM(f32x16& p0, f32x16& p1, float alpha, float& l_reg, bf16x8& pa0, bf16x8& pa1, bf16x8& pa2, bf16x8& pa3) {
#pragma unroll
    for (int r = 0; r < 16; ++r) p1[r] = __builtin_amdgcn_exp2f(p1[r]);
    float ps = 0;
#pragma unroll
    for (int r = 0; r < 16; ++r) ps += p0[r];
#pragma unroll
    for (int r = 0; r < 16; ++r) ps += p1[r];
    { auto rr = __builtin_amdgcn_permlane32_swap(__float_as_uint(ps), __float_as_uint(ps), false, false);
      ps = __uint_as_float(rr[0]) + __uint_as_float(rr[1]); }
    l_reg = l_reg * alpha + ps;
#define PK4(P, B_, OUT) do { unsigned a0 = cvtpk(P[B_+0], P[B_+1]), a1 = cvtpk(P[B_+2], P[B_+3]);                          \
        unsigned b0 = cvtpk(P[B_+4], P[B_+5]), b1 = cvtpk(P[B_+6], P[B_+7]);                                             \
        auto r0 = __builtin_amdgcn_permlane32_swap(a0, b0, false, false); auto r1 = __builtin_amdgcn_permlane32_swap(a1, b1, false, false); \
        u32x4 w = {r0[0], r1[0], r0[1], r1[1]}; OUT = *reinterpret_cast<bf16x8*>(&w); } while (0)
    PK4(p0, 0, pa0); PK4(p0, 8, pa1); PK4(p1, 0, pa2); PK4(p1, 8, pa3);
#undef PK4
}
template <int KB>
__device__ __forceinline__ void qkt(f32x16& p0, f32x16& p1, const char* lds, int r32, int hi, const bf16x8* qr) {
    p0 = f32x16{}; p1 = f32x16{};
    int ko[4];
#pragma unroll
    for (int dd = 0; dd < 4; ++dd) ko[dd] = KSWZ(r32, (dd * 16 + hi * 8) * 2);
#pragma unroll
    for (int d0 = 0; d0 < 8; ++d0) { const char* a = lds + OFF_KN + KB * SHM_KN + ((d0 >> 2) ? (ko[d0 & 3] ^ 128) : ko[d0 & 3]);
        bf16x8 b0 = *reinterpret_cast<const bf16x8*>(a);
        bf16x8 b1 = *reinterpret_cast<const bf16x8*>(a + 32 * 256);
        p0 = __builtin_amdgcn_mfma_f32_32x32x16_bf16(b0, qr[d0], p0, 0, 0, 0);
        p1 = __builtin_amdgcn_mfma_f32_32x32x16_bf16(b1, qr[d0], p1, 0, 0, 0); }
#pragma unroll
    for (int dd = 0; dd < 4; ++dd) { const char* a = lds + OFF_KR + KB * SHM_KR + KRSWZ(r32, (dd * 16 + hi * 8) * 2);
        bf16x8 b0 = *reinterpret_cast<const bf16x8*>(a);
        bf16x8 b1 = *reinterpret_cast<const bf16x8*>(a + 32 * 128);
        p0 = __builtin_amdgcn_mfma_f32_32x32x16_bf16(b0, qr[8 + dd], p0, 0, 0, 0);
        p1 = __builtin_amdgcn_mfma_f32_32x32x16_bf16(b1, qr[8 + dd], p1, 0, 0, 0); }
}
#define TRRD(dst, off) asm volatile("ds_read_b64_tr_b16 %0, %1 offset:%2" : "=&v"(dst) : "v"(vb0), "i"(off) : "memory")
template <int VB, int D0, int OI>
__device__ __forceinline__ void pv_d0(f32x16* o, int vb0, bf16x8 pa0, bf16x8 pa1, bf16x8 pa2, bf16x8 pa3) {
    s16x4 l0, l1, l2, l3, h0, h1, h2, h3; constexpr int b_ = VB * SHM_V + v_rd_off(D0, 0, 0);
    TRRD(l0, b_); TRRD(h0, b_ + 2048); TRRD(l1, b_ + 4096); TRRD(h1, b_ + 6144); TRRD(l2, b_ + 8192); TRRD(h2, b_ + 10240); TRRD(l3, b_ + 12288); TRRD(h3, b_ + 14336);
    asm volatile("s_waitcnt lgkmcnt(0)" ::: "memory"); SBAR();
    o[OI] = __builtin_amdgcn_mfma_f32_32x32x16_bf16(pa0, (bf16x8){l0[0], l0[1], l0[2], l0[3], h0[0], h0[1], h0[2], h0[3]}, o[OI], 0, 0, 0);
    o[OI] = __builtin_amdgcn_mfma_f32_32x32x16_bf16(pa1, (bf16x8){l1[0], l1[1], l1[2], l1[3], h1[0], h1[1], h1[2], h1[3]}, o[OI], 0, 0, 0);
    o[OI] = __builtin_amdgcn_mfma_f32_32x32x16_bf16(pa2, (bf16x8){l2[0], l2[1], l2[2], l2[3], h2[0], h2[1], h2[2], h2[3]}, o[OI], 0, 0, 0);
    o[OI] = __builtin_amdgcn_mfma_f32_32x32x16_bf16(pa3, (bf16x8){l3[0], l3[1], l3[2], l3[3], h3[0], h3[1], h3[2], h3[3]}, o[OI], 0, 0, 0);
}
template <int VB>
__device__ __forceinline__ void pv_tile(f32x16* o, int vb0, bf16x8 pa0, bf16x8 pa1, bf16x8 pa2, bf16x8 pa3) {
    pv_d0<VB, 0, 0>(o, vb0, pa0, pa1, pa2, pa3); pv_d0<VB, 1, 1>(o, vb0, pa0, pa1, pa2, pa3);
    pv_d0<VB, 2, 2>(o, vb0, pa0, pa1, pa2, pa3); pv_d0<VB, 3, 3>(o, vb0, pa0, pa1, pa2, pa3);
}
template <int VB, int CH>
__device__ __forceinline__ void pv_half(f32x16* o, int vb0, bf16x8 pa0, bf16x8 pa1, bf16x8 pa2, bf16x8 pa3) {
    pv_d0<VB, 2 * CH, 0>(o, vb0, pa0, pa1, pa2, pa3); pv_d0<VB, 2 * CH + 1, 1>(o, vb0, pa0, pa1, pa2, pa3);
}

__device__ __forceinline__ void attn_block(char* lds, const bf16_t* QN, const bf16_t* QR, const bf16_t* KN, const bf16_t* KPE, const bf16_t* VV, bf16_t* O, int bh, int qb) {
    int tid = threadIdx.x; asm volatile("" : "+v"(tid));
    const int wid = __builtin_amdgcn_readfirstlane(tid >> 6), lane = tid & 63, r32 = lane & 31, hi = lane >> 5;
    const int b = bh >> 3, h = bh & 7, P0 = qb * 256, NT = 4 * qb + 4;
    const int cw = (P0 + 32 * wid) >> 6;
    bf16x8 qr[12];
    { const bf16_t* qn = QN + ((size_t)bh * NS + P0 + wid * 32 + r32) * 128; const bf16_t* qp = QR + ((size_t)bh * NS + P0 + wid * 32 + r32) * RD;
#pragma unroll
      for (int d0 = 0; d0 < 8; ++d0) qr[d0] = *(const bf16x8*)(qn + d0 * 16 + hi * 8);
#pragma unroll
      for (int dd = 0; dd < 4; ++dd) qr[8 + dd] = *(const bf16x8*)(qp + dd * 16 + hi * 8); }
    const bf16_t* Kh = KN + (size_t)bh * NS * 128; const bf16_t* Vh = VV + (size_t)bh * NS * 128; const bf16_t* Kp = KPE + (size_t)b * NS * RD;
    const int sr = tid >> 4, sc = (tid & 15) * 8, rr = tid >> 3, rc = (tid & 7) * 8;
    const int kws = KSWZ(sr, sc * 2), vst0 = v_st(sr, sc), vst1 = v_st(32 + sr, sc), krw = KRSWZ(rr, rc * 2);
    const int vb0 = (int)(uintptr_t)(lds + OFF_V) + v_rd_base(lane);
    float* wsf = (float*)(lds + OFF_WS) + wid * 64; float* li_l = wsf; float* al_l = wsf + 32;
    bf16x8 sk0, sk1, sv0, sv1, skr;
#define SLOAD(k0) do { sk0 = *(const bf16x8*)(Kh + (size_t)((k0) + sr) * 128 + sc); sk1 = *(const bf16x8*)(Kh + (size_t)((k0) + 32 + sr) * 128 + sc); \
        sv0 = *(const bf16x8*)(Vh + (size_t)((k0) + sr) * 128 + sc); sv1 = *(const bf16x8*)(Vh + (size_t)((k0) + 32 + sr) * 128 + sc); \
        skr = *(const bf16x8*)(Kp + (size_t)((k0) + rr) * RD + rc); } while (0)
#define SWRITE(bf) do { *(bf16x8*)(lds + OFF_KN + (bf) * SHM_KN + kws) = sk0; *(bf16x8*)(lds + OFF_KN + (bf) * SHM_KN + kws + 32 * 256) = sk1; \
        *(bf16x8*)(lds + OFF_V + (bf) * SHM_V + vst0) = sv0; *(bf16x8*)(lds + OFF_V + (bf) * SHM_V + vst1) = sv1; \
        *(bf16x8*)(lds + OFF_KR + (bf) * SHM_KR + krw) = skr; } while (0)
    float m_reg = -1e30f, l_reg = 0.f; f32x16 o[4] = {};
    __syncthreads();
    SLOAD(0); SWRITE(0);
    __syncthreads();
#define COMPUTE(KB) do { f32x16 p0, p1; float mn, alpha; bf16x8 pa0, pa1, pa2, pa3; \
        qkt<KB>(p0, p1, lds, r32, hi, qr); partialSM(p0, p1, m_reg, mn, alpha); \
        if (__any(alpha < 1.f)) { if (hi == 0) al_l[r32] = alpha; asm volatile("s_waitcnt lgkmcnt(0)" ::: "memory"); \
            _Pragma("unroll") for (int r = 0; r < 16; ++r) { const float a_ = al_l[crow(r, hi)]; _Pragma("unroll") for (int d_ = 0; d_ < 4; ++d_) o[d_][r] *= a_; } } \
        finishSM(p0, p1, alpha, l_reg, pa0, pa1, pa2, pa3); SBAR(); \
        pv_tile<KB>(o, vb0, pa0, pa1, pa2, pa3); } while (0)
    for (int t = 0; t < NT; t += 2) {
        SLOAD((t + 1) * 64);
        if (t <= cw) COMPUTE(0);
        SWRITE(1);
        __syncthreads();
        if (t + 2 < NT) SLOAD((t + 2) * 64);
        if (t + 1 <= cw) COMPUTE(1);
        if (t + 2 < NT) SWRITE(0);
        __syncthreads();
    }
#undef COMPUTE
#undef SLOAD
#undef SWRITE
    if (hi == 0) li_l[r32] = l_reg;
    asm volatile("s_waitcnt lgkmcnt(0)" ::: "memory");
    float rli[16];
#pragma unroll
    for (int r = 0; r < 16; ++r) rli[r] = __builtin_amdgcn_rcpf(li_l[crow(r, hi)]);
    bf16_t* Ow = O + ((size_t)b * NS + P0 + wid * 32) * DM + h * 128;
    char* ot = lds + wid * 8192;
#pragma unroll
    for (int r = 0; r < 16; ++r) { const int orow = crow(r, hi);
#pragma unroll
        for (int d0 = 0; d0 < 4; ++d0) *(__bf16*)(ot + orow * 256 + (d0 * 32 + r32) * 2) = (__bf16)(o[d0][r] * rli[r]); }
    asm volatile("s_waitcnt lgkmcnt(0)" ::: "memory");
#pragma unroll
    for (int j = 0; j < 8; ++j) { const int id = lane + 64 * j, row = id >> 4, cc = id & 15;
        *(u32x4*)(Ow + (size_t)row * DM + cc * 8) = *(const u32x4*)(ot + row * 256 + cc * 16); }
}
__device__ __forceinline__ void attn_phase(char* lds, const bf16_t* QN, const bf16_t* QR, const bf16_t* KN, const bf16_t* KPE, const bf16_t* VV, bf16_t* O, int G, int blk) {
    for (int L = blk; L < 512; L += G) {
        const int xcd = L & 7, k = L >> 3, bh = xcd * 8 + (k >> 3), y = k & 7;
        attn_block(lds, QN, QR, KN, KPE, VV, O, bh, 15 - y);
        attn_block(lds, QN, QR, KN, KPE, VV, O, bh, y);
    }
}

__device__ __forceinline__ void spatial_phase(char* lds, const bf16_t* U, const bf16_t* V, const float* vpart, const float* g_gv, const bf16_t* Wsp, const float* bsp, bf16_t* Y, int G, int blk0) {
    int tid = threadIdx.x; asm volatile("" : "+v"(tid));
    const int wid = __builtin_amdgcn_readfirstlane(tid >> 6), lane = tid & 63, r32 = lane & 31, hi = lane >> 5;
    constexpr int OFF_S = 32768, SP = 132, OFF_MU = OFF_S + 128 * SP * 4;
    float* S_l = (float*)(lds + OFF_S); float* mu_l = (float*)(lds + OFF_MU); float* rs_l = mu_l + 128;
    const int vb0 = (int)(uintptr_t)(lds + OFF_V) + v_rd_base(lane);
    const int sr = tid >> 4, sc = (tid & 15) * 8;
    const int ts = (wid & 3) * 32, ch = wid >> 2;
    for (int blk = blk0; blk < MROWS / 128; blk += G) {
        __syncthreads();
        if (tid < 128) { const f32x2* pp = (const f32x2*)(vpart + (size_t)(blk * 128 + tid) * 96); float s = 0.f, q = 0.f;
            for (int i = 0; i < 48; ++i) { const f32x2 v = pp[i]; s += v.x; q += v.y; }
            const float mean = s * (1.f / GWID); float var = q * (1.f / GWID) - mean * mean; var = var < 0.f ? 0.f : var;
            mu_l[tid] = mean; rs_l[tid] = __builtin_amdgcn_rsqf(var + EPS); }
        float* bs_l = rs_l + 128;
        for (int i = tid; i < 12 * 128; i += 512) bs_l[i] = bsp[i];
        const size_t rowbase = (size_t)(blk * 128 + sr) * GWID + sc;
        u32x4 vv[4], uu[4]; bf16x8 pw[8];
        const bf16_t* wrow0 = Wsp + ((size_t)(ts + r32)) * 128 + hi * 8;
#pragma unroll
        for (int q = 0; q < 4; ++q) { vv[q] = __builtin_nontemporal_load((const u32x4*)(V + rowbase + (size_t)(32 * q) * GWID)); uu[q] = __builtin_nontemporal_load((const u32x4*)(U + rowbase + (size_t)(32 * q) * GWID)); }
#pragma unroll
        for (int k = 0; k < 8; ++k) pw[k] = *(const bf16x8*)(wrow0 + 16 * k);
        __syncthreads();
        for (int g = 0; g < 12; ++g) {
            u32x4 uc[4]; bf16x8 pc[8];
            { const f32x4 gg0 = *(const f32x4*)(g_gv + g * 128 + sc), gg1 = *(const f32x4*)(g_gv + g * 128 + sc + 4);
#pragma unroll
              for (int q = 0; q < 4; ++q) { const int s = sr + 32 * q; f32x4 a, b2; unpack8(vv[q], a, b2); const float mu = mu_l[s], rs = rs_l[s];
                a = (a - mu) * rs * gg0; b2 = (b2 - mu) * rs * gg1;
                *(bf16x8*)(lds + OFF_V + (q >> 1) * SHM_V + v_st(s & 63, sc)) = pack8(a, b2); uc[q] = uu[q]; } }
#pragma unroll
            for (int k = 0; k < 8; ++k) pc[k] = pw[k];
            if (g + 1 < 12) {
#pragma unroll
                for (int q = 0; q < 4; ++q) { vv[q] = __builtin_nontemporal_load((const u32x4*)(V + rowbase + (size_t)(32 * q) * GWID + (g + 1) * 128)); uu[q] = __builtin_nontemporal_load((const u32x4*)(U + rowbase + (size_t)(32 * q) * GWID + (g + 1) * 128)); }
#pragma unroll
                for (int k = 0; k < 8; ++k) pw[k] = *(const bf16x8*)(wrow0 + (size_t)(g + 1) * 128 * 128 + 16 * k); }
            __syncthreads();
            f32x16 o[2] = {};
            if (ch == 0) pv_half<0, 0>(o, vb0, pc[0], pc[1], pc[2], pc[3]); else pv_half<0, 1>(o, vb0, pc[0], pc[1], pc[2], pc[3]);
            if (ts >= 64) { if (ch == 0) pv_half<1, 0>(o, vb0, pc[4], pc[5], pc[6], pc[7]); else pv_half<1, 1>(o, vb0, pc[4], pc[5], pc[6], pc[7]); }
#pragma unroll
            for (int r = 0; r < 16; ++r) { const int t = ts + crow(r, hi); const float bb = bs_l[g * 128 + t];
#pragma unroll
                for (int dd = 0; dd < 2; ++dd) S_l[t * SP + (2 * ch + dd) * 32 + r32] = o[dd][r] + bb; }
            __syncthreads();
#pragma unroll
            for (int q = 0; q < 4; ++q) { const int s = sr + 32 * q; const f32x4 s0 = *(const f32x4*)(S_l + s * SP + sc), s1 = *(const f32x4*)(S_l + s * SP + sc + 4);
                f32x4 a, b2; unpack8(uc[q], a, b2);
                *(u32x4*)(Y + rowbase + (size_t)(32 * q) * GWID + g * 128) = pack8u(a * s0, b2 * s1); }
        }
    }
}
#undef TRRD
#undef KSWZ
#undef KRSWZ
#undef SBAR
}


#define XB_TMO      128
#define XB_XCNT(j)  (256  + 64 * (j))
#define XB_XSUB(j)  (1280 + 64 * (j))
#define XB_XGEN(j)  (2304 + 64 * (j))
#define XB_TOP      3328
#define XB_TOPGEN   3392
#define XCD_BAR_WORDS 3456
#define XB_SPIN_CAP (1u << 18)
__device__ __forceinline__ unsigned xb_ld(unsigned* p)              { return __hip_atomic_load(p, __ATOMIC_RELAXED, __HIP_MEMORY_SCOPE_AGENT); }
__device__ __forceinline__ unsigned xb_add(unsigned* p, unsigned v) { return __hip_atomic_fetch_add(p, v, __ATOMIC_RELAXED, __HIP_MEMORY_SCOPE_AGENT); }
__device__ __forceinline__ unsigned xb_xcc_id() { return (unsigned)__builtin_amdgcn_s_getreg((3 << 11) | 20) & 0xFu; }
#define XB_SPIN(cond, bar) do { unsigned _sp = 0; while (cond) { __builtin_amdgcn_s_sleep(1); \
    if ((++_sp & 255u) == 0u) { if (xb_ld(&(bar)[XB_TMO])) break; if (_sp > XB_SPIN_CAP) { atomicAdd(&(bar)[XB_TMO], 1u); break; } } } } while (0)
struct XcdBarrier { unsigned* bar; unsigned x; volatile LAS unsigned* st; };
__device__ __forceinline__ XcdBarrier xcd_barrier_post(unsigned* bar, volatile LAS unsigned* st) {
    XcdBarrier b; b.bar = bar; b.x = xb_xcc_id(); b.st = st;
    if (threadIdx.x == 0) (void)xb_add(&bar[XB_XCNT(b.x)], 1u);
    return b;
}
__device__ __forceinline__ void xcd_barrier_complete(unsigned* bar, unsigned x, unsigned& nloc, unsigned& nx) {
    const unsigned G = gridDim.x * gridDim.y * gridDim.z;
    unsigned sum, cnt, mine, sp = 0u;
    for (;;) {
        sum = 0u; cnt = 0u; mine = 0u;
#pragma unroll
        for (unsigned j = 0; j < 16; ++j) { const unsigned c = xb_ld(&bar[XB_XCNT(j)]); sum += c; cnt += (c > 0u) ? 1u : 0u; mine = (j == x) ? c : mine; }
        if (sum == G) break;
        __builtin_amdgcn_s_sleep(1);
        if ((++sp & 255u) == 0u) { if (xb_ld(&bar[XB_TMO])) break; if (sp > XB_SPIN_CAP) { atomicAdd(&bar[XB_TMO], 1u); break; } }
    }
    nloc = mine > 0u ? mine : 1u; nx = cnt > 0u ? cnt : 1u;
}
__device__ __forceinline__ void xcd_barrier(const XcdBarrier& b) {
    asm volatile("s_waitcnt vmcnt(0)" ::: "memory");
    __syncthreads();
    if (threadIdx.x == 0) {
        unsigned* bar = b.bar;
        __builtin_amdgcn_s_waitcnt(0);
        unsigned nloc = b.st[0], nx = b.st[1];
        if (nloc == 0u) { xcd_barrier_complete(bar, b.x, nloc, nx); b.st[0] = nloc; b.st[1] = nx; }
        const unsigned old = xb_add(&bar[XB_XSUB(b.x)], 1u);
        const unsigned gen = old / nloc;
        if (old + 1u == (gen + 1u) * nloc) {
            __builtin_amdgcn_fence(__ATOMIC_RELEASE, "agent");
            asm volatile("s_waitcnt vmcnt(0)" ::: "memory");
            const unsigned og = xb_add(&bar[XB_TOP], 1u);
            const unsigned tg = og / nx;
            if (og + 1u == (tg + 1u) * nx) xb_add(&bar[XB_TOPGEN], 1u);
            else XB_SPIN(xb_ld(&bar[XB_TOPGEN]) == tg, bar);
            __builtin_amdgcn_fence(__ATOMIC_ACQUIRE, "agent");
            xb_add(&bar[XB_XGEN(b.x)], 1u);
            asm volatile("s_waitcnt vmcnt(0)" ::: "memory");
        } else {
            XB_SPIN(xb_ld(&bar[XB_XGEN(b.x)]) == gen, bar);
            __builtin_amdgcn_fence(__ATOMIC_ACQUIRE, "agent");
            asm volatile("s_waitcnt vmcnt(0)" ::: "memory");
        }
    }
    __syncthreads();
}

constexpr int NWAVES = 8, NTHREADS = 512;
constexpr int LDS_BYTES = 147456;
constexpr int NPHASE = 17;

struct Args {
    const float* in[26]; float* out; unsigned char* ws; int ph_lo, ph_hi;
};

enum { MAP_ID = 0, MAP_WIN = 1, MAP_WUQ = 2, MAP_GATE = 3, MAP_UP = 4 };
__device__ __forceinline__ int rowmap(int kind, int n) {
    if (kind == MAP_WIN) {
        if (n < 3072) return n;
        if (n < 3456) return SEG_CQ + (n - 3072);
        if (n < 3712) return SEG_CKV + (n - 3456);
        if (n < 3776) { const int j = n - 3712; return SEG_KR + (j < 32 ? 2 * j : 2 * (j - 32) + 1); }
        if (n < 4800) return SEG_GA + (n - 3776);
        return SEG_GB + (n - 4800);
    }
    if (kind == MAP_WUQ) { const int h = n / 192, r = n % 192; if (r < 128) return h * 128 + r; const int j = r - 128; return 1024 + h * 64 + (j < 32 ? 2 * j : 2 * (j - 32) + 1); }
    if (kind == MAP_GATE) return (n >> 7) * 256 + (n & 127);
    if (kind == MAP_UP) return (n >> 7) * 256 + 128 + (n & 127);
    return n;
}
__device__ __forceinline__ void transpose_item(const float* W, int K, int N, const float* kscale, bf16_t* WT, int kind, LAS float* scr, int item, int lane) {
    const int nblk = N / 32, kb = item / nblk, nb = item % nblk, k0 = 64 * kb, n0 = 32 * nb;
    float tv[32];
#pragma unroll
    for (int i = 0; i < 32; ++i) { const int kk = 2 * i + (lane >> 5); tv[i] = __builtin_nontemporal_load(W + (size_t)(k0 + kk) * N + n0 + (lane & 31)); }
    if (kscale) {
#pragma unroll
        for (int i = 0; i < 32; ++i) tv[i] *= kscale[k0 + 2 * i + (lane >> 5)]; }
#pragma unroll
    for (int i = 0; i < 32; ++i) scr[(2 * i + (lane >> 5)) * 33 + (lane & 31)] = tv[i];
    asm volatile("s_waitcnt lgkmcnt(0)" ::: "memory");
    const int c = lane & 7;
#pragma unroll
    for (int j = 0; j < 4; ++j) { const int n = (lane >> 3) + 8 * j; const LAS float* s = scr + (8 * c) * 33 + n;
        u32x4 o; o.x = cvtpk(s[0 * 33], s[1 * 33]); o.y = cvtpk(s[2 * 33], s[3 * 33]); o.z = cvtpk(s[4 * 33], s[5 * 33]); o.w = cvtpk(s[6 * 33], s[7 * 33]);
        *(u32x4*)(WT + (size_t)rowmap(kind, n0 + n) * K + k0 + 8 * c) = o; }
    asm volatile("s_waitcnt lgkmcnt(0)" ::: "memory");
}
__device__ __forceinline__ void transpose_job(const float* W, int K, int N, const float* kscale, bf16_t* WT, int kind, LAS float* scr, int gw, int NGW, int lane) {
    const int nitems = (K / 64) * (N / 32);
    for (int it = gw; it < nitems; it += NGW) transpose_item(W, K, N, kscale, WT, kind, scr, it, lane);
}
template <int NR>
__device__ __forceinline__ void rms_rows_to_bf16(const float* x, const float* gain, bf16_t* o, int m0, int mstride, int lane) {
    f32x4 v[NR][4];
#pragma unroll
    for (int r = 0; r < NR; ++r) { const f32x4* xr = (const f32x4*)(x + (size_t)(m0 + r * mstride) * DM) + lane;
#pragma unroll
        for (int j = 0; j < 4; ++j) v[r][j] = __builtin_nontemporal_load(xr + 64 * j); }
    f32x4 g[4];
#pragma unroll
    for (int j = 0; j < 4; ++j) g[j] = ((const f32x4*)gain)[lane + 64 * j];
#pragma unroll
    for (int r = 0; r < NR; ++r) { float s = 0.f;
#pragma unroll
        for (int j = 0; j < 4; ++j) s += (v[r][j][0] * v[r][j][0] + v[r][j][1] * v[r][j][1]) + (v[r][j][2] * v[r][j][2] + v[r][j][3] * v[r][j][3]);
        const float rstd = 1.f / sqrtf(wave_sum(s) * (1.f / DM) + EPS);
        u32x2* o8 = (u32x2*)(o + (size_t)(m0 + r * mstride) * DM) + lane;
#pragma unroll
        for (int j = 0; j < 4; ++j) { const f32x4 w = v[r][j] * rstd * g[j]; o8[64 * j] = (u32x2){cvtpk(w[0], w[1]), cvtpk(w[2], w[3])}; } }
}

__global__ void __launch_bounds__(NTHREADS, 2) fwd_kernel(Args args) {
    extern __shared__ __attribute__((aligned(16))) unsigned char lds[];
    LAS unsigned char* ldsl = (LAS unsigned char*)lds;
    const int tid = threadIdx.x, lane = tid & 63, wave = __builtin_amdgcn_readfirstlane(tid >> 6);
    const int G = gridDim.x, blk = blockIdx.x;
    const int gw = blk * NWAVES + wave, NGW = G * NWAVES;
    unsigned char* ws = args.ws;
    const float* x = args.in[0]; const float* p_in = args.in[1]; const float* g_mix = args.in[2]; const float* w_in = args.in[3]; const float* g_gv = args.in[4];
    const float* w_spatial = args.in[5]; const float* b_spatial = args.in[6]; const float* w_gproj = args.in[7]; const float* g_cq = args.in[8]; const float* w_uq = args.in[9];
    const float* g_ckv = args.in[10]; const float* w_ukv = args.in[11]; const float* w_mla_o = args.in[12]; const float* w_out = args.in[13]; const float* g_moe = args.in[14];
    const float* w_router_g = args.in[15]; const float* b_router_g = args.in[16]; const float* w_router_e = args.in[17]; const float* b_router_e = args.in[18];
    const float* w_e_gate = args.in[19]; const float* w_e_up = args.in[20]; const float* w_e_down = args.in[21]; const float* g_ple = args.in[22];
    const float* w_ple_gate = args.in[23]; const float* w_ple_proj = args.in[24]; const float* g_final = args.in[25];
    float* out = args.out;
    int* ctl = (int*)(ws + WS_CTL); int* chunkcnt = (int*)(ws + WS_CHUNKCNT); u32x4* tokinfo = (u32x4*)(ws + WS_TOKINFO);
    int* rowtok = (int*)(ws + WS_ROWTOK); float* roww = (float*)(ws + WS_ROWW); int* tokslot = (int*)(ws + WS_TOKSLOT);
    float* ropeC = (float*)(ws + WS_ROPEC); float* ropeS = (float*)(ws + WS_ROPES);
    bf16_t* Win_t = (bf16_t*)(ws + WS_WIN); bf16_t* Wgp_t = (bf16_t*)(ws + WS_WGP); bf16_t* Wuq_t = (bf16_t*)(ws + WS_WUQ); bf16_t* Wukv_t = (bf16_t*)(ws + WS_WUKV);
    bf16_t* Wo_t = (bf16_t*)(ws + WS_WO); bf16_t* Wout_t = (bf16_t*)(ws + WS_WOUT); bf16_t* Wr_t = (bf16_t*)(ws + WS_WR); bf16_t* Wpg_t = (bf16_t*)(ws + WS_WPG);
    bf16_t* Wpp_t = (bf16_t*)(ws + WS_WPP); bf16_t* Wsp = (bf16_t*)(ws + WS_WSP); bf16_t* Pb = (bf16_t*)(ws + WS_PB);
    float* vpart = (float*)(ws + WS_VPART); float* cqpart = (float*)(ws + WS_CQPART); float* ckvpart = (float*)(ws + WS_CKVPART); float* rstd3 = (float*)(ws + WS_RSTD3);
    float* rq = (float*)(ws + WS_RQ); float* rkv = (float*)(ws + WS_RKV); float* hpart = (float*)(ws + WS_HPART); float* tokrs = (float*)(ws + WS_TOKRS); float* rowrs = (float*)(ws + WS_ROWRS); bf16_t* H3b = (bf16_t*)(ws + WS_H3B);
    bf16_t* Ub = (bf16_t*)(ws + WS_U); bf16_t* Vb = (bf16_t*)(ws + WS_V); bf16_t* GA = (bf16_t*)(ws + WS_GA); bf16_t* GB = (bf16_t*)(ws + WS_GB);
    bf16_t* CQ = (bf16_t*)(ws + WS_CQ); bf16_t* CKV = (bf16_t*)(ws + WS_CKV); bf16_t* KPE = (bf16_t*)(ws + WS_KPE);
    bf16_t* QN = (bf16_t*)(ws + WS_QN); bf16_t* KN = (bf16_t*)(ws + WS_KN); bf16_t* VV = (bf16_t*)(ws + WS_VV); bf16_t* QR = (bf16_t*)(ws + WS_QR);
    bf16_t* Mb = (bf16_t*)(ws + WS_MB); bf16_t* Wgu_t = (bf16_t*)(ws + WS_WGU); bf16_t* Wd_t = (bf16_t*)(ws + WS_WD); float* LOG = (float*)(ws + WS_LOG);
    bf16_t* HID = (bf16_t*)(ws + WS_HID); bf16_t* YS = (bf16_t*)(ws + WS_YS); bf16_t* H2b = (bf16_t*)(ws + WS_H2B); bf16_t* PP = (bf16_t*)(ws + WS_PP);
    bf16_t* XA = (bf16_t*)out; bf16_t* Yb = (bf16_t*)out; bf16_t* Ob = (bf16_t*)out;

    const int lo = args.ph_lo, hi = args.ph_hi;
#ifndef PHMASK
#define PHMASK 0xFFFFFFFFu
#endif
#define IN(k) (((PHMASK >> (k)) & 1u) && lo <= (k) && (k) < hi)
#ifndef CG_SEAM0
#define CG_SEAM0 0
#endif
#ifdef PROBE_LO
#define STAMP(k) do { if (blk == 0 && tid == 0) ((unsigned long long*)(ws + 4096))[(k)] = __builtin_amdgcn_s_memrealtime(); } while (0)
#else
#define STAMP(k) do { } while (0)
#endif
#define SEAM(k) do { if (IN(k) && (IN((k) + 1) || ((k) == 6 && IN(8)))) { if (CG_SEAM0 && (k) == 0) { __threadfence(); cg::this_grid().sync(); } else xcd_barrier(bar); } STAMP((k) + 1); } while (0)
    volatile LAS unsigned* bst = (volatile LAS unsigned*)(ldsl + LDS_BYTES - 16);
    if (tid < 4) bst[tid] = 0u;
    __syncthreads();
    XcdBarrier bar; bar.bar = (unsigned*)(ws + WS_BAR); bar.x = 0; bar.st = nullptr;
    if (hi - lo > 1) bar = xcd_barrier_post((unsigned*)(ws + WS_BAR), bst);

    STAMP(0);
    if (IN(0)) {
        LAS float* scr = (LAS float*)(ldsl + wave * 16384);
        transpose_job(w_in, DM, 5824, nullptr, Win_t, MAP_WIN, scr, gw, NGW, lane);
        if (G != 256) {
        transpose_job(w_gproj, GWID, DM, nullptr, Wgp_t, MAP_ID, scr, gw, NGW, lane);
        transpose_job(w_uq, QL, 1536, g_cq, Wuq_t, MAP_WUQ, scr, gw, NGW, lane);
        transpose_job(w_ukv, KVL, 2048, g_ckv, Wukv_t, MAP_ID, scr, gw, NGW, lane);
        transpose_job(w_mla_o, DM, DM, nullptr, Wo_t, MAP_ID, scr, gw, NGW, lane);
        transpose_job(w_out, DM, DM, nullptr, Wout_t, MAP_ID, scr, gw, NGW, lane);
        transpose_job(w_ple_gate, DM, DM, g_ple, Wpg_t, MAP_ID, scr, gw, NGW, lane);
        transpose_job(w_ple_proj, PLE, DM, nullptr, Wpp_t, MAP_ID, scr, gw, NGW, lane);
        }
        for (int m = gw; m < MROWS; m += 4 * NGW) rms_rows_to_bf16<4>(x, g_mix, XA, m, NGW, lane);
        const int gt = blk * NTHREADS + tid, NGT = G * NTHREADS;
        for (int i = gt; i < 64 * DM; i += NGT) Win_t[(size_t)SEG_PAD * DM + i] = 0;
        for (int i = gt; i < 256 * DM; i += NGT) { const int n = i >> 10, k = i & 1023; float v = 0.f;
            if (n < 8) v = w_router_g[k * 8 + n] * g_moe[k]; else if (n < 72) v = w_router_e[k * 64 + (n - 8)] * g_moe[k];
            Wr_t[i] = (bf16_t)(cvtpk(v, 0.f) & 0xffffu); }
        for (int i = gt; i < 12 * 128 * 128; i += NGT) { const int t = (i >> 7) & 127, s = i & 127; const float v = ((s >> 6) <= (t >> 6)) ? w_spatial[i] : 0.f; Wsp[i] = (bf16_t)(cvtpk(v, 0.f) & 0xffffu); }
        for (int i = gt; i < NS * 32; i += NGT) { const int s = i >> 5, j = i & 31; const double inv = exp(-(double)j * (1.0 / 32.0) * 9.210340371976184); const double a = (double)s * inv;
            ropeC[i] = (float)cos(a); ropeS[i] = (float)sin(a); }
        if (G != 256) for (int i = gt; i < MROWS * PLE / 4; i += 4 * NGT) { f32x4 v[4];
#pragma unroll
            for (int q = 0; q < 4; ++q) v[q] = __builtin_nontemporal_load((const f32x4*)p_in + i + q * NGT);
#pragma unroll
            for (int q = 0; q < 4; ++q) __builtin_nontemporal_store((u32x2){cvtpk(v[q][0], v[q][1]), cvtpk(v[q][2], v[q][3])}, (u32x2*)Pb + i + q * NGT); }
    }
    SEAM(0);
    if (IN(1)) {
        pg8::SchedDense S; S.init(XA, Win_t, MROWS, ZN, DM, G, blk);
        pg8::EpiZ E{Ub, Vb, GA, GB, CQ, CKV, KPE, vpart, cqpart, ckvpart, ropeC, ropeS};
        pg8::gemm_phase(ldsl, DM, S, E);
        if (G == 256 && blk >= 128) {
            __syncthreads();
            LAS float* scr = (LAS float*)(ldsl + wave * 16384); const int gw2 = (blk - 128) * NWAVES + wave, NGW2 = 128 * NWAVES;
            transpose_job(w_gproj, GWID, DM, nullptr, Wgp_t, MAP_ID, scr, gw2, NGW2, lane);
            transpose_job(w_uq, QL, 1536, g_cq, Wuq_t, MAP_WUQ, scr, gw2, NGW2, lane);
            transpose_job(w_ukv, KVL, 2048, g_ckv, Wukv_t, MAP_ID, scr, gw2, NGW2, lane);
            transpose_job(w_mla_o, DM, DM, nullptr, Wo_t, MAP_ID, scr, gw2, NGW2, lane);
            transpose_job(w_out, DM, DM, nullptr, Wout_t, MAP_ID, scr, gw2, NGW2, lane);
            transpose_job(w_ple_gate, DM, DM, g_ple, Wpg_t, MAP_ID, scr, gw2, NGW2, lane);
            transpose_job(w_ple_proj, PLE, DM, nullptr, Wpp_t, MAP_ID, scr, gw2, NGW2, lane);
        }
    }
    SEAM(1);
    if (IN(2)) { for (int row = blk * NTHREADS + tid; row < MROWS; row += G * NTHREADS) {
            const f32x4* a = (const f32x4*)(cqpart + (size_t)row * 12); const f32x4* b = (const f32x4*)(ckvpart + (size_t)row * 8);
            const f32x4 a0 = a[0], a1 = a[1], a2 = a[2], b0 = b[0], b1 = b[1];
            rq[row] = 1.f / sqrtf((((a0[0] + a0[1]) + (a0[2] + a0[3])) + ((a1[0] + a1[1]) + (a1[2] + a1[3])) + ((a2[0] + a2[1]) + (a2[2] + a2[3]))) * (1.f / QL) + EPS);
            rkv[row] = 1.f / sqrtf((((b0[0] + b0[1]) + (b0[2] + b0[3])) + ((b1[0] + b1[1]) + (b1[2] + b1[3]))) * (1.f / KVL) + EPS); }
        att::spatial_phase((char*)lds, Ub, Vb, vpart, g_gv, Wsp, b_spatial, Yb, G, blk); }
    SEAM(2);
    if (IN(3)) {
#ifndef SUBMASK
#define SUBMASK 7
#endif
        if (SUBMASK & 1) { pg8::SchedDense S; S.init(Yb, Wgp_t, MROWS, DM, GWID, G, blk); pg8::EpiMul E{GA}; pg8::gemm_phase(ldsl, GWID, S, E); }
        __syncthreads();
        if (SUBMASK & 2) { pg8::SchedDense S; S.init(CQ, Wuq_t, MROWS, 1536, QL, G, blk); pg8::EpiQ E{QN, QR, rq, ropeC, ropeS}; pg8::gemm_phase(ldsl, QL, S, E); }
        __syncthreads();
        if (SUBMASK & 4) { pg8::SchedDense S; S.init(CKV, Wukv_t, MROWS, 2048, KVL, G, blk); pg8::EpiKV E{KN, VV, rkv}; pg8::gemm_phase(ldsl, KVL, S, E); }
    }
    SEAM(3);
    if (IN(4)) { att::attn_phase((char*)lds, QN, QR, KN, KPE, VV, Ob, G, blk); }
    SEAM(4);
    if (IN(5)) {
        { pg8::SchedDense S; S.init(Ob, Wo_t, MROWS, DM, DM, G, blk); pg8::EpiMulAdd E{GA, GB}; pg8::gemm_phase(ldsl, DM, S, E); }
        __syncthreads();
        LAS float* scr = (LAS float*)(ldsl + wave * 16384);
        for (int it = gw; it < NEXP * 128; it += NGW) { const int e = it >> 7, sub = it & 127;
            transpose_item(w_e_gate + (size_t)e * DM * DEXP, DM, DEXP, g_moe, Wgu_t + (size_t)e * 512 * DM, MAP_GATE, scr, sub, lane);
            transpose_item(w_e_up + (size_t)e * DM * DEXP, DM, DEXP, g_moe, Wgu_t + (size_t)e * 512 * DM, MAP_UP, scr, sub, lane);
            transpose_item(w_e_down + (size_t)e * DEXP * DM, DEXP, DM, nullptr, Wd_t + (size_t)e * DM * DEXP, MAP_ID, scr, sub, lane); }
    }
    SEAM(5);
    if (IN(6)) { pg8::SchedDense S; S.init(GA, Wout_t, MROWS, DM, DM, G, blk); pg8::EpiRes E{x, Mb, hpart}; pg8::gemm_phase(ldsl, DM, S, E); }
    SEAM(6);
    if (IN(8)) { pg8::SchedRouter S{Mb, Wr_t, G == 256 ? blk : 256}; pg8::EpiRouter E{LOG}; pg8::gemm_phase(ldsl, 512, S, E, DM);
        if (G != 256) for (int c2 = blk; c2 < 256; c2 += G) { __syncthreads(); pg8::SchedRouter S2{Mb, Wr_t, c2}; pg8::gemm_phase(ldsl, 512, S2, E, DM); } }
    SEAM(8);
    if (IN(9)) {
        LAS int* hist = (LAS int*)ldsl;
        for (int chunk = blk; chunk < MROWS / 128; chunk += G) {
            __syncthreads();
            if (tid < 64) hist[tid] = 0;
            __syncthreads();
            if (tid < 128) {
                const int tok = chunk * 128 + tid; const float* lg = LOG + (size_t)tok * 72; const float* lg2 = lg + (size_t)MROWS * 72;
                float rs;
                { const f32x4* hp = (const f32x4*)(hpart + (size_t)tok * 32); float ss = 0.f;
#pragma unroll
                  for (int i = 0; i < 8; ++i) { const f32x4 v = hp[i]; ss += (v[0] + v[1]) + (v[2] + v[3]); }
                  rs = 1.f / sqrtf(ss * (1.f / DM) + EPS); tokrs[tok] = rs; }
                float gl[8]; float gm = -1e30f;
#pragma unroll
                for (int i = 0; i < 8; ++i) { gl[i] = (lg[i] + lg2[i]) * rs; gm = fmaxf(gm, gl[i]); }
                float gs = 0.f;
#pragma unroll
                for (int i = 0; i < 8; ++i) { gl[i] = expf(gl[i] - gm); gs += gl[i]; }
                int gi = 0; float gbest = -1e30f, gw_ = 0.f;
#pragma unroll
                for (int i = 0; i < 8; ++i) { const float pr = gl[i] / gs; const float sc_ = pr + b_router_g[i]; if (sc_ > gbest) { gbest = sc_; gi = i; gw_ = pr; } }
                float el[8]; float em = -1e30f;
#pragma unroll
                for (int i = 0; i < 8; ++i) { el[i] = (lg[8 + gi * 8 + i] + lg2[8 + gi * 8 + i]) * rs; em = fmaxf(em, el[i]); }
                float es = 0.f;
#pragma unroll
                for (int i = 0; i < 8; ++i) { el[i] = expf(el[i] - em); es += el[i]; }
                int i0 = 0, i1 = 0; float s0 = -1e30f, s1 = -1e30f, p0 = 0.f, p1 = 0.f;
#pragma unroll
                for (int i = 0; i < 8; ++i) { const float pr = el[i] / es; const float sc_ = pr + b_router_e[gi * 8 + i];
                    if (sc_ > s0) { s1 = s0; i1 = i0; p1 = p0; s0 = sc_; i0 = i; p0 = pr; } else if (sc_ > s1) { s1 = sc_; i1 = i; p1 = pr; } }
                const float den = p0 + p1; const float w0 = gw_ * (p0 / den), w1 = gw_ * (p1 / den);
                const int e0 = gi * 8 + i0, e1 = gi * 8 + i1;
                const int r0 = __hip_atomic_fetch_add(&hist[e0], 1, __ATOMIC_RELAXED, __HIP_MEMORY_SCOPE_WORKGROUP);
                const int r1 = __hip_atomic_fetch_add(&hist[e1], 1, __ATOMIC_RELAXED, __HIP_MEMORY_SCOPE_WORKGROUP);
                tokinfo[tok] = (u32x4){(unsigned)(e0 | (r0 << 8)), (unsigned)(e1 | (r1 << 8)), __float_as_uint(w0), __float_as_uint(w1)};
            }
            __syncthreads();
            if (tid < 64) chunkcnt[chunk * 64 + tid] = hist[tid];
        }
    }
    SEAM(9);
    if (IN(10)) {
        LAS int* cn = (LAS int*)ldsl;
        LAS int* part = cn + 256 * 64; LAS int* tot = part + 8 * 64; LAS int* base = tot + 64; LAS int* cbase = base + 64;
        for (int i = tid; i < 256 * 64 / 4; i += NTHREADS) ((LAS u32x4*)cn)[i] = ((const u32x4*)chunkcnt)[i];
        __syncthreads();
        { const int e = tid & 63, p8 = tid >> 6; int s2 = 0; for (int c = p8 * 32; c < p8 * 32 + 32; ++c) s2 += cn[c * 64 + e]; part[p8 * 64 + e] = s2; }
        __syncthreads();
        if (tid < 64) { int s2 = 0; for (int p8 = 0; p8 < 8; ++p8) s2 += part[p8 * 64 + tid]; tot[tid] = s2; }
        __syncthreads();
        if (tid == 0) { int acc = 0; for (int e = 0; e < 64; ++e) { base[e] = acc; acc += (tot[e] + 255) & ~255; }
            if (blk == 0) { ctl[0] = acc >> 8; int rt = 0; for (int e = 0; e < 64; ++e) { const int n = (tot[e] + 255) >> 8; for (int i = 0; i < n; ++i) ctl[16 + rt++] = e; } } }
        __syncthreads();
        for (int e = blk; e < 64; e += G) { const int b0 = base[e] + tot[e], b1 = base[e] + ((tot[e] + 255) & ~255); for (int s2 = b0 + tid; s2 < b1; s2 += NTHREADS) { rowtok[s2] = -1; roww[s2] = -1.f; rowrs[s2] = 0.f; } }
        for (int chunk = blk; chunk < MROWS / 128; chunk += G) {
            __syncthreads();
            if (tid < 64) { int s2 = 0; const int pf = chunk >> 5; for (int p8 = 0; p8 < pf; ++p8) s2 += part[p8 * 64 + tid]; for (int c = pf * 32; c < chunk; ++c) s2 += cn[c * 64 + tid]; cbase[tid] = s2; }
            __syncthreads();
            if (tid < 128) { const int tok = chunk * 128 + tid; const u32x4 ti = tokinfo[tok];
                const int e0 = ti.x & 255, r0 = ti.x >> 8, e1 = ti.y & 255, r1 = ti.y >> 8;
                const int s0 = base[e0] + cbase[e0] + r0, s1 = base[e1] + cbase[e1] + r1;
                const float rs = tokrs[tok]; rowrs[s0] = rs; rowrs[s1] = rs; *(int2*)(tokslot + 2 * tok) = make_int2(s0, s1);
                rowtok[s0] = tok * 2; roww[s0] = __uint_as_float(ti.z); rowtok[s1] = tok * 2 + 1; roww[s1] = __uint_as_float(ti.w); }
        }
    }
    SEAM(10);
    if (IN(11)) { pg8::SchedGU S{Mb, rowtok, Wgu_t, ctl + 16, ctl[0], G, blk}; pg8::EpiGU E{HID, rowrs}; pg8::gemm_phase(ldsl, DM, S, E);
        if (G == 256) {
            int nh = 2 * ctl[0] - 512; nh = nh < 0 ? 0 : (nh > 192 ? 192 : nh);
            if (blk >= nh) { const int NT2 = (256 - nh) * NTHREADS;
                for (int i = (blk - nh) * NTHREADS + tid; i < MROWS * PLE / 4; i += 4 * NT2) { f32x4 v[4];
#pragma unroll
                    for (int q = 0; q < 4; ++q) if (i + q * NT2 < MROWS * PLE / 4) v[q] = __builtin_nontemporal_load((const f32x4*)p_in + i + q * NT2);
#pragma unroll
                    for (int q = 0; q < 4; ++q) if (i + q * NT2 < MROWS * PLE / 4) __builtin_nontemporal_store((u32x2){cvtpk(v[q][0], v[q][1]), cvtpk(v[q][2], v[q][3])}, (u32x2*)Pb + i + q * NT2); } } } }
    SEAM(11);
    if (IN(12)) { pg8::SchedDown S{HID, Wd_t, ctl + 16, ctl[0], G, blk}; pg8::EpiDown E{YS, roww}; pg8::gemm_phase(ldsl, DEXP, S, E); }
    SEAM(12);
    if (IN(13)) {
        int2 sl[2];
#pragma unroll
        for (int r = 0; r < 2; ++r) sl[r] = *(const int2*)(tokslot + 2 * (gw + r * NGW));
        for (int m0 = gw; m0 < MROWS; m0 += 2 * NGW) {
            u32x2 hv[2][4], y0[2][4], y1[2][4];
#pragma unroll
            for (int r = 0; r < 2; ++r) { const int m = m0 + r * NGW;
                const int s0 = __builtin_amdgcn_readfirstlane(sl[r].x), s1 = __builtin_amdgcn_readfirstlane(sl[r].y);
#pragma unroll
                for (int j = 0; j < 4; ++j) { hv[r][j] = __builtin_nontemporal_load((const u32x2*)(Mb + (size_t)m * DM) + lane + 64 * j); y0[r][j] = __builtin_nontemporal_load((const u32x2*)(YS + (size_t)s0 * DM) + lane + 64 * j); y1[r][j] = __builtin_nontemporal_load((const u32x2*)(YS + (size_t)s1 * DM) + lane + 64 * j); } }
            if (m0 + 2 * NGW < MROWS) {
#pragma unroll
                for (int r = 0; r < 2; ++r) sl[r] = *(const int2*)(tokslot + 2 * (m0 + 2 * NGW + r * NGW)); }
#pragma unroll
            for (int r = 0; r < 2; ++r) { const int m = m0 + r * NGW; float s = 0.f;
#pragma unroll
                for (int j = 0; j < 4; ++j) { const u32x2 h = hv[r][j], a = y0[r][j], b = y1[r][j];
                    const float v0 = bflo(h.x) + bflo(a.x) + bflo(b.x), v1 = bfhi(h.x) + bfhi(a.x) + bfhi(b.x), v2 = bflo(h.y) + bflo(a.y) + bflo(b.y), v3 = bfhi(h.y) + bfhi(a.y) + bfhi(b.y);
                    ((u32x2*)(H2b + (size_t)m * DM))[lane + 64 * j] = (u32x2){cvtpk(v0, v1), cvtpk(v2, v3)};
                    s += (v0 * v0 + v1 * v1) + (v2 * v2 + v3 * v3); }
                s = wave_sum(s);
                if (lane == 0) rstd3[m] = 1.f / sqrtf(s * (1.f / DM) + EPS); }
        }
    }
    SEAM(13);
    if (IN(14)) {
        { pg8::SchedDense S; S.init(Pb, Wpp_t, MROWS, DM, PLE, G, blk); pg8::EpiPP E{PP}; pg8::gemm_phase(ldsl, PLE, S, E); }
        __syncthreads();
        { pg8::SchedDense S; S.init(H2b, Wpg_t, MROWS, DM, DM, G, blk); pg8::EpiPLE E{H2b, H3b, PP, rstd3}; pg8::gemm_phase(ldsl, DM, S, E); }
    }
    SEAM(14);
    if (IN(15)) {
        f32x4 gf[4];
#pragma unroll
        for (int j = 0; j < 4; ++j) gf[j] = ((const f32x4*)g_final)[lane + 64 * j];
        for (int m0 = gw; m0 < MROWS; m0 += 4 * NGW) {
            u32x2 hv[4][4];
#pragma unroll
            for (int r = 0; r < 4; ++r)
#pragma unroll
                for (int j = 0; j < 4; ++j) hv[r][j] = __builtin_nontemporal_load((const u32x2*)(H3b + (size_t)(m0 + r * NGW) * DM) + lane + 64 * j);
#pragma unroll
            for (int r = 0; r < 4; ++r) { float s = 0.f; f32x4 v[4];
#pragma unroll
                for (int j = 0; j < 4; ++j) { v[j] = (f32x4){bflo(hv[r][j].x), bfhi(hv[r][j].x), bflo(hv[r][j].y), bfhi(hv[r][j].y)}; s += (v[j][0] * v[j][0] + v[j][1] * v[j][1]) + (v[j][2] * v[j][2] + v[j][3] * v[j][3]); }
                const float rstd = 1.f / sqrtf(wave_sum(s) * (1.f / DM) + EPS);
                f32x4* orow = (f32x4*)(out + (size_t)(m0 + r * NGW) * DM) + lane;
#pragma unroll
                for (int j = 0; j < 4; ++j) __builtin_nontemporal_store(v[j] * rstd * gf[j], orow + 64 * j); }
        }
    }
#ifdef PROBE_LO
    if (blk == 0 && tid == 0) {
        const unsigned long long tend = __builtin_amdgcn_s_memrealtime();
        volatile unsigned long long* st = (volatile unsigned long long*)(ws + 4096);
        const unsigned long long t1 = (PROBE_HI >= 16) ? tend : st[PROBE_HI];
        const unsigned long long span = (t1 - st[PROBE_LO]) * PROBE_MULT;
        while (__builtin_amdgcn_s_memrealtime() - tend < span) __builtin_amdgcn_s_sleep(8);
    }
#endif
#undef IN
#undef SEAM
}

extern "C" void kernel_launch(void* const* d_in, const int* in_sizes, int n_in, void* d_out, int out_size, void* d_ws, size_t ws_size, hipStream_t stream) {
    static int grid = 0;
    if (grid == 0) {
        if (n_in != 26 || out_size != MROWS * DM || ws_size < WS_END) { fprintf(stderr, "kernel_launch: unexpected shapes (n_in %d out %d ws %zu)\n", n_in, out_size, ws_size); grid = -1; return; }
        int dev = 0, cus = 0, per_cu = 0;
        (void)hipGetDevice(&dev); (void)hipDeviceGetAttribute(&cus, hipDeviceAttributeMultiprocessorCount, dev);
        if (hipFuncSetAttribute((const void*)fwd_kernel, hipFuncAttributeMaxDynamicSharedMemorySize, LDS_BYTES) != hipSuccess) { fprintf(stderr, "kernel_launch: hipFuncSetAttribute failed\n"); grid = -1; return; }
        if (hipOccupancyMaxActiveBlocksPerMultiprocessor(&per_cu, (const void*)fwd_kernel, NTHREADS, LDS_BYTES) != hipSuccess || per_cu < 1) { fprintf(stderr, "kernel_launch: occupancy query says %d\n", per_cu); per_cu = 1; }
        (void)hipGetLastError();
        grid = cus > 0 ? cus : 256;
    }
    if (grid < 0) return;
    Args a{};
    for (int i = 0; i < 26; ++i) a.in[i] = (const float*)d_in[i];
    a.out = (float*)d_out; a.ws = (unsigned char*)d_ws;
    if (hipMemsetAsync((char*)d_ws + WS_BAR, 0, BAR_ZERO_BYTES, stream) != hipSuccess) { fprintf(stderr, "kernel_launch: memset failed\n"); return; }
#if MK_N_LAUNCHES == 1
    a.ph_lo = 0; a.ph_hi = NPHASE;
    void* params[] = {&a};
    hipError_t e = hipLaunchCooperativeKernel((const void*)fwd_kernel, dim3(grid), dim3(NTHREADS), params, LDS_BYTES, stream);
    if (e != hipSuccess) fprintf(stderr, "kernel_launch: cooperative launch failed: %s\n", hipGetErrorString(e));
#else
    for (int ph = 0; ph < 16; ++ph) { a.ph_lo = ph; a.ph_hi = ph + 1; hipLaunchKernelGGL(fwd_kernel, dim3(grid), dim3(NTHREADS), LDS_BYTES, stream, a); }
#endif
}
```

```cpp
#include <hip/hip_runtime.h>
#include <hip/hip_cooperative_groups.h>
#include <cstdio>
#include <cstdint>
namespace cg = cooperative_groups;

#ifndef MK_N_LAUNCHES
#define MK_N_LAUNCHES 1
#endif

#define LAS __attribute__((address_space(3)))
typedef unsigned short bf16_t;
typedef short bf16x8 __attribute__((ext_vector_type(8)));
typedef short s16x4 __attribute__((ext_vector_type(4)));
typedef float f32x4 __attribute__((ext_vector_type(4)));
typedef float f32x2 __attribute__((ext_vector_type(2)));
typedef float f32x16 __attribute__((ext_vector_type(16)));
typedef unsigned u32x4 __attribute__((ext_vector_type(4)));
typedef unsigned u32x2 __attribute__((ext_vector_type(2)));

constexpr int NB = 8, NS = 4096, DM = 1024, MROWS = NB * NS;
constexpr int GWID = 1536, QL = 384, KVL = 256, RD = 64, NH = 8, PLE = 256;
constexpr int ZN = 5888;
constexpr int SEG_V = 1536, SEG_GA = 3072, SEG_GB = 4096, SEG_CQ = 5120, SEG_CKV = 5504, SEG_KR = 5760, SEG_PAD = 5824;
constexpr int NEXP = 64, DEXP = 256;
constexpr int MAXSLOT = 2 * MROWS + NEXP * 256;
constexpr float EPS = 1e-6f;

constexpr size_t MiB = 1u << 20;
constexpr size_t WS_CTL = 0;
constexpr size_t WS_BAR = 8192, BAR_ZERO_BYTES = 16384;
constexpr size_t WS_CHUNKCNT = 64 * 1024;
constexpr size_t WS_TOKINFO = 128 * 1024;
constexpr size_t WS_ROWTOK = 1 * MiB;
constexpr size_t WS_ROWW = 1 * MiB + 384 * 1024;
constexpr size_t WS_ROWRS = 1 * MiB + 768 * 1024;
constexpr size_t WS_ROPEC = 2 * MiB + 512 * 1024, WS_ROPES = 3 * MiB;
constexpr size_t WS_WIN = 4 * MiB;
constexpr size_t WS_WGP = 16 * MiB;
constexpr size_t WS_WUQ = 19 * MiB;
constexpr size_t WS_WUKV = 20 * MiB + 512 * 1024;
constexpr size_t WS_WO = 21 * MiB + 512 * 1024;
constexpr size_t WS_WOUT = 23 * MiB + 512 * 1024;
constexpr size_t WS_WR = 25 * MiB + 512 * 1024;
constexpr size_t WS_WPG = 26 * MiB;
constexpr size_t WS_WPP = 28 * MiB;
constexpr size_t WS_WSP = 28 * MiB + 512 * 1024;
constexpr size_t WS_PB = 29 * MiB;
constexpr size_t WS_VPART = 45 * MiB;
constexpr size_t WS_CQPART = 57 * MiB;
constexpr size_t WS_CKVPART = 58 * MiB + 512 * 1024;
constexpr size_t WS_HPART = 59 * MiB + 512 * 1024;
constexpr size_t WS_RSTD3 = 63 * MiB + 512 * 1024;
constexpr size_t WS_TOKRS = 63 * MiB + 768 * 1024;
constexpr size_t WS_RQ = 63 * MiB + 128 * 1024, WS_RKV = 63 * MiB + 256 * 1024;
constexpr size_t WS_U = 64 * MiB, WS_V = 160 * MiB, WS_GA = 256 * MiB, WS_GB = 320 * MiB, WS_CQ = 384 * MiB, WS_CKV = 408 * MiB, WS_KPE = 424 * MiB;
constexpr size_t WS_QN = 64 * MiB, WS_KN = 128 * MiB, WS_VV = 192 * MiB, WS_QR = 428 * MiB;
constexpr size_t WS_MB = 64 * MiB, WS_WGU = 128 * MiB, WS_WD = 192 * MiB, WS_LOG = 224 * MiB;
constexpr size_t WS_HID = 256 * MiB, WS_YS = 320 * MiB, WS_H2B = 64 * MiB, WS_PP = 128 * MiB, WS_H3B = 192 * MiB;
constexpr size_t WS_END = 512 * MiB;

typedef __bf16 bf16x2_t __attribute__((ext_vector_type(2)));
__device__ __forceinline__ unsigned cvtpk(float lo, float hi) { const bf16x2_t v = {(__bf16)lo, (__bf16)hi}; return __builtin_bit_cast(unsigned, v); }
__device__ __forceinline__ float bflo(unsigned w) { return __uint_as_float(w << 16); }
__device__ __forceinline__ float bfhi(unsigned w) { return __uint_as_float(w & 0xffff0000u); }
__device__ __forceinline__ float bf2f(bf16_t b) { return __uint_as_float(((unsigned)b) << 16); }
__device__ __forceinline__ u32x4 pack8u(f32x4 a, f32x4 b) { u32x4 w = {cvtpk(a[0], a[1]), cvtpk(a[2], a[3]), cvtpk(b[0], b[1]), cvtpk(b[2], b[3])}; return w; }
__device__ __forceinline__ bf16x8 pack8(f32x4 a, f32x4 b) { u32x4 w = pack8u(a, b); return *reinterpret_cast<bf16x8*>(&w); }
__device__ __forceinline__ void unpack8(u32x4 w, f32x4& a, f32x4& b) { a = (f32x4){bflo(w.x), bfhi(w.x), bflo(w.y), bfhi(w.y)}; b = (f32x4){bflo(w.z), bfhi(w.z), bflo(w.w), bfhi(w.w)}; }
__device__ __forceinline__ float fsigmoid(float x) { return __builtin_amdgcn_rcpf(1.f + __builtin_amdgcn_exp2f(-1.4426950408889634f * x)); }
__device__ __forceinline__ float gelu_tanh(float x) { const float u = x * (1.f + 0.044715f * x * x); return x * fsigmoid(1.5957691216057308f * u); }
__device__ __forceinline__ float wave_sum(float v) {
#pragma unroll
    for (int o = 1; o < 64; o <<= 1) v += __shfl_xor(v, o);
    return v;
}
__device__ __forceinline__ float quad_sum(float v) {
    const auto a = __builtin_amdgcn_permlane32_swap(__float_as_uint(v), __float_as_uint(v), false, false);
    v = __uint_as_float(a[0]) + __uint_as_float(a[1]);
    const auto b = __builtin_amdgcn_permlane16_swap(__float_as_uint(v), __float_as_uint(v), false, false);
    return __uint_as_float(b[0]) + __uint_as_float(b[1]);
}
__device__ __forceinline__ f32x2 sigmoid2(f32x2 v) { const f32x2 a = v * (-1.4426950408889634f); f32x2 e; e.x = __builtin_amdgcn_exp2f(a.x); e.y = __builtin_amdgcn_exp2f(a.y);
    const f32x2 d = e + 1.0f; f32x2 r; r.x = __builtin_amdgcn_rcpf(d.x); r.y = __builtin_amdgcn_rcpf(d.y); return r; }
__device__ __forceinline__ f32x2 gelu2(f32x2 v) { const f32x2 t = v * v; const f32x2 w = t * (-0.10294323936f) + (-2.30220819881f); const f32x2 a = v * w;
    f32x2 e; e.x = __builtin_amdgcn_exp2f(a.x); e.y = __builtin_amdgcn_exp2f(a.y); const f32x2 d = e + 1.0f; f32x2 r; r.x = __builtin_amdgcn_rcpf(d.x); r.y = __builtin_amdgcn_rcpf(d.y); return v * r; }
__device__ __forceinline__ f32x4 sigmoid4(f32x4 v) { const f32x2 a = sigmoid2((f32x2){v[0], v[1]}), b = sigmoid2((f32x2){v[2], v[3]}); return (f32x4){a.x, a.y, b.x, b.y}; }
__device__ __forceinline__ f32x4 gelu4(f32x4 v) { const f32x2 a = gelu2((f32x2){v[0], v[1]}), b = gelu2((f32x2){v[2], v[3]}); return (f32x4){a.x, a.y, b.x, b.y}; }

namespace pg8 {
constexpr int BM = 256, BK = 64, HALF = 128, HTB = HALF * BK * 2, STAGE_BYTES = 8 * HTB, NXCD = 8, WGM = 8;
__host__ __device__ __forceinline__ int lds_byte(int r, int c) { const int st = (r >> 4) * 2 + (c >> 5), rr = r & 15, cc = c & 31, ob = rr * 64 + cc * 2; return st * 1024 + (ob ^ (((ob >> 9) & 1) << 5)); }
__host__ __device__ __forceinline__ void stage_rc(int b, int& R, int& C) { const int st = b / 1024, sb = b % 1024, swz = sb ^ (((sb >> 9) & 1) << 5); R = (st >> 1) * 16 + swz / 64; C = (st & 1) * 32 + (swz % 64) / 2; }
__host__ __device__ __forceinline__ int perm32(int rho) { const int n = rho >> 4, i = rho & 15; return 8 * (i >> 2) + 4 * n + (i & 3); }

struct Unit { int pm, pn, ex, li, hm, ro; };

struct SchedDense {
    const bf16_t* A; const bf16_t* Bt; int K; int nM, nN, nwg, G, c;
    __device__ void init(const bf16_t* A_, const bf16_t* Bt_, int M, int N, int K_, int G_, int c_) { A = A_; Bt = Bt_; K = K_; nM = M / BM; nN = N / BM; nwg = nM * nN; G = G_; c = c_; }
    __device__ __forceinline__ bool next(int i, Unit& u) const {
        const long L = (long)i * G + c; if (L >= nwg) return false;
        int wgid = (int)L; { const int q = nwg / NXCD, r = nwg % NXCD, xcd = wgid % NXCD, off = wgid / NXCD; wgid = (xcd < r ? xcd * (q + 1) : r * (q + 1) + (xcd - r) * q) + off; }
        const int nig = WGM * nN, gid = wgid / nig, fm = gid * WGM, gsz = (nM - fm) < WGM ? (nM - fm) : WGM;
        u.pm = fm + ((wgid % nig) % gsz); u.pn = (wgid % nig) / gsz; u.ex = 0; u.li = i; u.hm = 0; u.ro = 0; return true;
    }
    __device__ __forceinline__ const char* a_ptr(const Unit& u) const { return (const char*)A + (size_t)u.pm * BM * K * 2; }
    __device__ __forceinline__ const char* b_ptr(const Unit& u) const { return (const char*)Bt + (size_t)u.pn * BM * K * 2; }
    __device__ __forceinline__ void a_off(const Unit&, const int (&R)[2], const int (&C)[2], unsigned (&vo)[2][2]) const {
#pragma unroll
        for (int h = 0; h < 2; ++h)
#pragma unroll
            for (int i = 0; i < 2; ++i) vo[h][i] = (unsigned)((h * HALF + R[i]) * K + C[i]) * 2u;
    }
};
struct SchedRouter {
    const bf16_t* A; const bf16_t* Bt; int c;
    __device__ __forceinline__ bool next(int i, Unit& u) const { if (i > 0 || c >= 256) return false; u.pm = c >> 1; u.pn = 0; u.ex = c & 1; u.li = 0; u.hm = 0; u.ro = 0; return true; }
    __device__ __forceinline__ const char* a_ptr(const Unit& u) const { return (const char*)A + ((size_t)u.pm * BM * DM + (size_t)u.ex * 512) * 2; }
    __device__ __forceinline__ const char* b_ptr(const Unit& u) const { return (const char*)Bt + (size_t)u.ex * 512 * 2; }
    __device__ __forceinline__ void a_off(const Unit&, const int (&R)[2], const int (&C)[2], unsigned (&vo)[2][2]) const {
#pragma unroll
        for (int h = 0; h < 2; ++h)
#pragma unroll
            for (int i = 0; i < 2; ++i) vo[h][i] = (unsigned)((h * HALF + R[i]) * DM + C[i]) * 2u;
    }
};
struct SchedGU {
    const bf16_t* A; const LAS int* rowtok; const bf16_t* Bt; const LAS int* tile_e; int ntiles; int G, c;
    __device__ __forceinline__ bool next(int i, Unit& u) const {
        int L; u.hm = 0; u.ro = 0;
        if (G == 256 && i >= 2) { const int nh_ = 2 * (ntiles * 2 - 512); if (i > 2 || c >= nh_) return false; L = 512 + (c >> 1); u.hm = 1; u.ro = (c & 1) * HALF; }
        else { L = i * G + c; if (L >= ntiles * 2) return false; }
        u.pm = L >> 1; u.pn = L & 1; u.li = i; u.ex = __builtin_amdgcn_readfirstlane(tile_e[u.pm]); return true;
    }
    __device__ __forceinline__ const char* a_ptr(const Unit&) const { return (const char*)A; }
    __device__ __forceinline__ const char* b_ptr(const Unit& u) const { return (const char*)Bt + ((size_t)u.ex * 512 + (size_t)u.pn * 256) * DM * 2; }
    __device__ __forceinline__ void a_off(const Unit& u, const int (&R)[2], const int (&C)[2], unsigned (&vo)[2][2]) const {
#pragma unroll
        for (int h = 0; h < 2; ++h)
#pragma unroll
            for (int i = 0; i < 2; ++i) { const int t = rowtok[u.li * BM + (u.hm ? 0 : h * HALF) + R[i]]; const int tok = t < 0 ? 0 : (t >> 1); vo[h][i] = (unsigned)(tok * DM + C[i]) * 2u; }
    }
};
struct SchedDown {
    const bf16_t* A; const bf16_t* Bt; const LAS int* tile_e; int ntiles; int G, c;
    __device__ __forceinline__ bool next(int i, Unit& u) const {
        int L; u.hm = 0; u.ro = 0;
        if (G == 256 && i >= 4) { const int Lh = (i - 4) * 256 + c; if (Lh >= 2 * (ntiles * 4 - 1024)) return false; L = 1024 + (Lh >> 1); u.hm = 1; u.ro = (Lh & 1) * HALF; }
        else { L = i * G + c; if (L >= ntiles * 4) return false; }
        u.pm = L >> 2; u.pn = L & 3; u.li = i; u.ex = __builtin_amdgcn_readfirstlane(tile_e[u.pm]); return true;
    }
    __device__ __forceinline__ const char* a_ptr(const Unit& u) const { return (const char*)A + (size_t)u.pm * BM * DEXP * 2; }
    __device__ __forceinline__ const char* b_ptr(const Unit& u) const { return (const char*)Bt + ((size_t)u.ex * DM + (size_t)u.pn * 256) * DEXP * 2; }
    __device__ __forceinline__ void a_off(const Unit& u_, const int (&R)[2], const int (&C)[2], unsigned (&vo)[2][2]) const {
#pragma unroll
        for (int h = 0; h < 2; ++h)
#pragma unroll
            for (int i = 0; i < 2; ++i) vo[h][i] = (unsigned)(((u_.hm ? u_.ro : h * HALF) + R[i]) * DEXP + C[i]) * 2u;
    }
};

template <class Epi, class Sched, bool HALFU = false>
__device__ __forceinline__ void gemm_phase(LAS unsigned char* lds, const int K_, const Sched& S, const Epi& E, const int pitch_ = 0) {
    int tid = threadIdx.x; asm volatile("" : "+v"(tid));
    int K = K_; asm volatile("" : "+s"(K));
    const int P = pitch_ ? pitch_ : K_;
    const int wid = __builtin_amdgcn_readfirstlane(tid >> 6), lane = tid & 63, wr = wid >> 2, wc = wid & 3, fr = lane & 15, fq = lane >> 4;
    const int nt = K / BK;
    int RA[2], CA[2]; unsigned voffB[2];
#pragma unroll
    for (int i = 0; i < 2; ++i) { int R, C; stage_rc(tid * 16 + i * 8192, R, C); const int Rb = Epi::PERM ? ((R & ~31) + perm32(R & 31)) : R;
        RA[i] = R; CA[i] = C; voffB[i] = (unsigned)(Rb * P + C) * 2u; }
    const size_t kstep = (size_t)(BK * 2);
    const size_t hstep = (size_t)HALF * P * 2;
    const unsigned ldsw = (unsigned)wid * 1024u;
    const int aoff = lds_byte(wr * 64 + fr, fq * 8), boff = lds_byte(wc * 32 + fr, fq * 8);
#define PG8_SA(b, h) (((b) * 2 + (h)) * HTB)
#define PG8_SB(b, h) ((4 + (b) * 2 + (h)) * HTB)
#define PG8_STAGE(bufoff, gbase, voff) do { _Pragma("unroll") for (int _i = 0; _i < 2; ++_i) \
        __builtin_amdgcn_global_load_lds((const unsigned*)((const char*)(gbase) + (voff)[_i]), (LAS unsigned*)(lds + (bufoff) + ldsw + _i * 8192), 16, 0, 0); } while (0)
#define PG8_LDA(dst, b, h) do { _Pragma("unroll") for (int m = 0; m < 4; ++m) _Pragma("unroll") for (int k = 0; k < 2; ++k) dst[m][k] = *(const LAS bf16x8*)(lds + PG8_SA(b, h) + aoff + m * 2048 + k * 1024); } while (0)
#define PG8_LDB(dst, b, h) do { _Pragma("unroll") for (int n = 0; n < 2; ++n) _Pragma("unroll") for (int k = 0; k < 2; ++k) dst[n][k] = *(const LAS bf16x8*)(lds + PG8_SB(b, h) + boff + n * 2048 + k * 1024); } while (0)
#define PG8_MMA(ai, bj, At, Bt) do { __builtin_amdgcn_s_setprio(1); _Pragma("unroll") for (int m = 0; m < 4; ++m) _Pragma("unroll") for (int n = 0; n < 2; ++n) _Pragma("unroll") for (int k = 0; k < 2; ++k) \
        acc[ai][bj][m][n] = __builtin_amdgcn_mfma_f32_16x16x32_bf16(Bt[n][k], At[m][k], acc[ai][bj][m][n], 0, 0, 0); __builtin_amdgcn_s_setprio(0); } while (0)
#define PG8_WAIT_V(n) asm volatile("s_waitcnt vmcnt(" #n ")" ::: "memory")
#define PG8_WAIT_L(n) asm volatile("s_waitcnt lgkmcnt(" #n ")" ::: "memory")
#define PG8_BAR __builtin_amdgcn_s_barrier()
#define PG8_SCHED __builtin_amdgcn_sched_barrier(0)
    Unit cur, nxt; int ui = 0;
    if (!S.next(0, cur)) return;
    f32x4 acc[2][2][4][2];
#pragma unroll
    for (int a = 0; a < 2; ++a)
#pragma unroll
        for (int b = 0; b < 2; ++b)
#pragma unroll
            for (int m = 0; m < 4; ++m)
#pragma unroll
                for (int n = 0; n < 2; ++n) acc[a][b][m][n] = (f32x4){0.f, 0.f, 0.f, 0.f};
    bf16x8 At[4][2], B0[2][2], B1[2][2];
    unsigned voC[2][2], voN[2][2];
    const char* cA = S.a_ptr(cur); const char* cB = S.b_ptr(cur);
    S.a_off(cur, RA, CA, voC);
    PG8_STAGE(PG8_SB(0, 0), cB, voffB); PG8_STAGE(PG8_SB(0, 1), cB + hstep, voffB); PG8_STAGE(PG8_SA(0, 0), cA, voC[0]); PG8_STAGE(PG8_SA(0, 1), cA, voC[1]);
    if (wr == 1) PG8_BAR;
    PG8_WAIT_V(2); PG8_BAR;
    PG8_STAGE(PG8_SB(1, 0), cB + kstep, voffB); PG8_STAGE(PG8_SA(1, 0), cA + kstep, voC[0]); PG8_STAGE(PG8_SB(1, 1), cB + hstep + kstep, voffB);
    PG8_WAIT_V(6); PG8_BAR;
    for (;;) {
        const bool has_next = S.next(ui + 1, nxt);
        const bool hu = HALFU && cur.hm != 0;
        const char* nA = has_next ? S.a_ptr(nxt) : cA; const char* nB = has_next ? S.b_ptr(nxt) : cB;
        if (has_next) S.a_off(nxt, RA, CA, voN);
        else {
#pragma unroll
            for (int h = 0; h < 2; ++h)
#pragma unroll
                for (int i = 0; i < 2; ++i) voN[h][i] = voC[h][i]; }
#pragma nounroll
        for (int t = 0; t < nt; t += 2) {
            const bool last = (t == nt - 2);
            const char* a1 = cA + (size_t)(t + 1) * kstep;
            const char* a2 = last ? nA : cA + (size_t)(t + 2) * kstep; const char* b2 = last ? nB : cB + (size_t)(t + 2) * kstep;
            const char* a3 = a2 + kstep; const char* b3 = b2 + kstep;
            unsigned v2[2][2];
#pragma unroll
            for (int h = 0; h < 2; ++h)
#pragma unroll
                for (int i = 0; i < 2; ++i) v2[h][i] = last ? voN[h][i] : voC[h][i];
            PG8_LDB(B0, 0, 0); PG8_LDB(B1, 0, 1); PG8_SCHED; PG8_LDA(At, 0, 0); PG8_STAGE(PG8_SA(1, 1), a1, voC[1]);
            PG8_WAIT_V(8); PG8_WAIT_L(0); PG8_BAR; PG8_MMA(0, 0, At, B0); PG8_MMA(0, 1, At, B1); PG8_BAR; PG8_SCHED;
            if (!hu) PG8_LDA(At, 0, 1); PG8_STAGE(PG8_SB(0, 0), b2, voffB); PG8_STAGE(PG8_SB(0, 1), b2 + hstep, voffB); PG8_STAGE(PG8_SA(0, 0), a2, v2[0]);
            PG8_WAIT_V(8); PG8_WAIT_L(0); PG8_BAR; if (!hu) { PG8_MMA(1, 0, At, B0); PG8_MMA(1, 1, At, B1); } PG8_BAR; PG8_SCHED;
            PG8_LDB(B0, 1, 0); PG8_LDB(B1, 1, 1); PG8_SCHED; PG8_LDA(At, 1, 0); PG8_STAGE(PG8_SA(0, 1), a2, v2[1]);
            PG8_WAIT_V(8); PG8_WAIT_L(0); PG8_BAR; PG8_MMA(0, 0, At, B0); PG8_MMA(0, 1, At, B1); PG8_BAR; PG8_SCHED;
            if (!hu) PG8_LDA(At, 1, 1); PG8_STAGE(PG8_SB(1, 0), b3, voffB); PG8_STAGE(PG8_SB(1, 1), b3 + hstep, voffB); PG8_STAGE(PG8_SA(1, 0), a3, v2[0]);
            PG8_WAIT_V(8); PG8_WAIT_L(0); PG8_BAR; if (!hu) { PG8_MMA(1, 0, At, B0); PG8_MMA(1, 1, At, B1); } PG8_BAR; PG8_SCHED;
        }
        if (wr == 0) PG8_BAR;
        E(acc, cur, wr, wc, fr, fq);
        if (!has_next) break;
#pragma unroll
        for (int a = 0; a < 2; ++a)
#pragma unroll
            for (int b = 0; b < 2; ++b)
#pragma unroll
                for (int m = 0; m < 4; ++m)
#pragma unroll
                    for (int n = 0; n < 2; ++n) acc[a][b][m][n] = (f32x4){0.f, 0.f, 0.f, 0.f};
        cur = nxt; cA = nA; cB = nB; ++ui;
#pragma unroll
        for (int h = 0; h < 2; ++h)
#pragma unroll
            for (int i = 0; i < 2; ++i) voC[h][i] = voN[h][i];
        if (wr == 1) PG8_BAR;
    }
    PG8_WAIT_V(0);
    PG8_BAR;
#undef PG8_SA
#undef PG8_SB
#undef PG8_STAGE
#undef PG8_LDA
#undef PG8_LDB
#undef PG8_MMA
#undef PG8_WAIT_V
#undef PG8_WAIT_L
#undef PG8_BAR
#undef PG8_SCHED
}

typedef f32x4 Acc[2][2][4][2];
#define EPI_ROW(u, ai, wr, m, fr) ((u).pm * 256 + (ai) * 128 + (wr) * 64 + (m) * 16 + (fr))

struct EpiZ {
    static constexpr bool PERM = true;
    bf16_t *U, *V, *GA, *GB, *CQ, *CKV, *KPE; float *vpart, *cqpart, *ckvpart; const float *ropeC, *ropeS;
    __device__ __forceinline__ void operator()(const Acc& acc, const Unit& u, int wr, int wc, int fr, int fq) const {
        const int row0 = u.pm * 256 + wr * 64 + fr;
#define ZROWS(...) _Pragma("unroll") for (int ai = 0; ai < 2; ++ai) _Pragma("unroll") for (int m = 0; m < 4; ++m) { const int row = row0 + 128 * ai + 16 * m; const f32x4 a0 = acc[ai][bj][m][0], a1 = acc[ai][bj][m][1]; __VA_ARGS__ }
#pragma unroll
        for (int bj = 0; bj < 2; ++bj) {
            const int cb = u.pn * 256 + bj * 128 + wc * 32;
            const int c0 = cb + 8 * fq;
            if (cb < SEG_V) {
                bf16_t* p = U + (size_t)row0 * GWID + c0;
                ZROWS( __builtin_nontemporal_store(pack8u(gelu4(a0), gelu4(a1)), (u32x4*)(p + (size_t)(128 * ai + 16 * m) * GWID)); )
            } else if (cb < SEG_GA) {
                bf16_t* p = V + (size_t)row0 * GWID + (c0 - SEG_V); float* sp = vpart + ((size_t)row0 * 48 + ((cb - SEG_V) >> 5)) * 2;
                ZROWS( const f32x4 v0 = gelu4(a0), v1 = gelu4(a1); __builtin_nontemporal_store(pack8u(v0, v1), (u32x4*)(p + (size_t)(128 * ai + 16 * m) * GWID));
                       const f32x4 sv = v0 + v1, qv = v0 * v0 + v1 * v1; float s_ = quad_sum((sv[0] + sv[1]) + (sv[2] + sv[3])), q_ = quad_sum((qv[0] + qv[1]) + (qv[2] + qv[3]));
                       if (fq == 0) *(f32x2*)(sp + (size_t)(128 * ai + 16 * m) * 96) = (f32x2){s_, q_}; )
            } else if (cb < SEG_CQ) {
                bf16_t* p = (cb < SEG_GB ? GA + (c0 - SEG_GA) : GB + (c0 - SEG_GB)) + (size_t)row0 * DM;
                ZROWS( __builtin_nontemporal_store(pack8u(sigmoid4(a0), sigmoid4(a1)), (u32x4*)(p + (size_t)(128 * ai + 16 * m) * DM)); )
            } else if (cb < SEG_CKV) {
                bf16_t* p = CQ + (size_t)row0 * QL + (c0 - SEG_CQ); float* sp = cqpart + (size_t)row0 * 12 + ((cb - SEG_CQ) >> 5);
                ZROWS( __builtin_nontemporal_store(pack8u(a0, a1), (u32x4*)(p + (size_t)(128 * ai + 16 * m) * QL)); const f32x4 qv = a0 * a0 + a1 * a1; const float q_ = quad_sum((qv[0] + qv[1]) + (qv[2] + qv[3]));
                       if (fq == 0) sp[(size_t)(128 * ai + 16 * m) * 12] = q_; )
            } else if (cb < SEG_KR) {
                bf16_t* p = CKV + (size_t)row0 * KVL + (c0 - SEG_CKV); float* sp = ckvpart + (size_t)row0 * 8 + ((cb - SEG_CKV) >> 5);
                ZROWS( __builtin_nontemporal_store(pack8u(a0, a1), (u32x4*)(p + (size_t)(128 * ai + 16 * m) * KVL)); const f32x4 qv = a0 * a0 + a1 * a1; const float q_ = quad_sum((qv[0] + qv[1]) + (qv[2] + qv[3]));
                       if (fq == 0) sp[(size_t)(128 * ai + 16 * m) * 8] = q_; )
            } else if (cb < SEG_PAD) {
                const int j0 = (c0 - SEG_KR) >> 1;
                ZROWS( const int s = row & (NS - 1); const f32x4 cs = *(const f32x4*)(ropeC + s * 32 + j0), sn = *(const f32x4*)(ropeS + s * 32 + j0);
                       f32x4 o0, o1;
                       o0[0] = a0[0] * cs[0] - a0[1] * sn[0]; o0[1] = a0[0] * sn[0] + a0[1] * cs[0];
                       o0[2] = a0[2] * cs[1] - a0[3] * sn[1]; o0[3] = a0[2] * sn[1] + a0[3] * cs[1];
                       o1[0] = a1[0] * cs[2] - a1[1] * sn[2]; o1[1] = a1[0] * sn[2] + a1[1] * cs[2];
                       o1[2] = a1[2] * cs[3] - a1[3] * sn[3]; o1[3] = a1[2] * sn[3] + a1[3] * cs[3];
                       __builtin_nontemporal_store(pack8u(o0, o1), (u32x4*)(KPE + (size_t)row * RD + (c0 - SEG_KR))); )
            }
        }
#undef ZROWS
    }
};
struct EpiMul {
    static constexpr bool PERM = true;
    bf16_t* G;
    __device__ __forceinline__ void operator()(const Acc& acc, const Unit& u, int wr, int wc, int fr, int fq) const {
#pragma unroll
        for (int ai = 0; ai < 2; ++ai) {
            u32x4 g[4][2];
#pragma unroll
            for (int m = 0; m < 4; ++m)
#pragma unroll
                for (int bj = 0; bj < 2; ++bj) g[m][bj] = __builtin_nontemporal_load((const u32x4*)(G + (size_t)EPI_ROW(u, ai, wr, m, fr) * DM + u.pn * 256 + bj * 128 + wc * 32 + 8 * fq));
#pragma unroll
            for (int m = 0; m < 4; ++m)
#pragma unroll
                for (int bj = 0; bj < 2; ++bj) { f32x4 g0, g1; unpack8(g[m][bj], g0, g1);
                    __builtin_nontemporal_store(pack8u(g0 * acc[ai][bj][m][0], g1 * acc[ai][bj][m][1]), (u32x4*)(G + (size_t)EPI_ROW(u, ai, wr, m, fr) * DM + u.pn * 256 + bj * 128 + wc * 32 + 8 * fq)); }
            asm volatile("" ::: "memory");
        }
    }
};
struct EpiMulAdd {
    static constexpr bool PERM = true;
    bf16_t* MA; const bf16_t* GB;
    __device__ __forceinline__ void operator()(const Acc& acc, const Unit& u, int wr, int wc, int fr, int fq) const {
#pragma unroll
        for (int ai = 0; ai < 2; ++ai) {
            u32x4 a[4][2], g[4][2];
#pragma unroll
            for (int m = 0; m < 4; ++m)
#pragma unroll
                for (int bj = 0; bj < 2; ++bj) { const size_t off = (size_t)EPI_ROW(u, ai, wr, m, fr) * DM + u.pn * 256 + bj * 128 + wc * 32 + 8 * fq; a[m][bj] = __builtin_nontemporal_load((const u32x4*)(MA + off)); g[m][bj] = __builtin_nontemporal_load((const u32x4*)(GB + off)); }
#pragma unroll
            for (int m = 0; m < 4; ++m)
#pragma unroll
                for (int bj = 0; bj < 2; ++bj) { const size_t off = (size_t)EPI_ROW(u, ai, wr, m, fr) * DM + u.pn * 256 + bj * 128 + wc * 32 + 8 * fq;
                    f32x4 a0, a1, g0, g1; unpack8(a[m][bj], a0, a1); unpack8(g[m][bj], g0, g1);
                    *(u32x4*)(MA + off) = pack8u(a0 + g0 * acc[ai][bj][m][0], a1 + g1 * acc[ai][bj][m][1]); }
            asm volatile("" ::: "memory");
        }
    }
};
struct EpiRes {
    static constexpr bool PERM = true;
    const float* X; bf16_t* Hb; float* hpart;
    __device__ __forceinline__ void operator()(const Acc& acc, const Unit& u, int wr, int wc, int fr, int fq) const {
#pragma unroll
        for (int ai = 0; ai < 2; ++ai) {
            f32x4 xv[4][2][2];
#pragma unroll
            for (int m = 0; m < 4; ++m)
#pragma unroll
                for (int bj = 0; bj < 2; ++bj) { const size_t off = (size_t)EPI_ROW(u, ai, wr, m, fr) * DM + u.pn * 256 + bj * 128 + wc * 32 + 8 * fq; xv[m][bj][0] = __builtin_nontemporal_load((const f32x4*)(X + off)); xv[m][bj][1] = __builtin_nontemporal_load((const f32x4*)(X + off + 4)); }
#pragma unroll
            for (int m = 0; m < 4; ++m)
#pragma unroll
                for (int bj = 0; bj < 2; ++bj) {
                    const int row = EPI_ROW(u, ai, wr, m, fr), c0 = u.pn * 256 + bj * 128 + wc * 32 + 8 * fq;
                    const f32x4 v0 = xv[m][bj][0] + acc[ai][bj][m][0], v1 = xv[m][bj][1] + acc[ai][bj][m][1];
                    *(u32x4*)(Hb + (size_t)row * DM + c0) = pack8u(v0, v1);
                    float q = (v0[0] * v0[0] + v0[1] * v0[1]) + (v0[2] * v0[2] + v0[3] * v0[3]) + (v1[0] * v1[0] + v1[1] * v1[1]) + (v1[2] * v1[2] + v1[3] * v1[3]);
                    q = quad_sum(q);
                    if (fq == 0) hpart[(size_t)row * 32 + (c0 >> 5)] = q;
                }
            asm volatile("" ::: "memory");
        }
    }
};
struct EpiQ {
    static constexpr bool PERM = true;
    bf16_t *QN, *QR; const float* rq; const float *ropeC, *ropeS;
    __device__ __forceinline__ void operator()(const Acc& acc, const Unit& u, int wr, int wc, int fr, int fq) const {
        float rs[2][4];
#pragma unroll
        for (int ai = 0; ai < 2; ++ai)
#pragma unroll
            for (int m = 0; m < 4; ++m) rs[ai][m] = rq[EPI_ROW(u, ai, wr, m, fr)];
        if (u.pn < 4) {
#pragma unroll
            for (int ai = 0; ai < 2; ++ai)
#pragma unroll
                for (int m = 0; m < 4; ++m) { const int row = EPI_ROW(u, ai, wr, m, fr), b = row >> 12, s = row & (NS - 1); const float rstd = rs[ai][m];
#pragma unroll
                    for (int bj = 0; bj < 2; ++bj) { const int c0 = u.pn * 256 + bj * 128 + wc * 32 + 8 * fq, h = c0 >> 7, d = c0 & 127;
                        *(u32x4*)(QN + (((size_t)(b * NH + h)) * NS + s) * 128 + d) = pack8u(acc[ai][bj][m][0] * rstd, acc[ai][bj][m][1] * rstd); } }
        } else {
#pragma unroll
            for (int ai = 0; ai < 2; ++ai) {
                f32x4 cs[4][2], sn[4][2];
#pragma unroll
                for (int m = 0; m < 4; ++m)
#pragma unroll
                    for (int bj = 0; bj < 2; ++bj) { const int s = EPI_ROW(u, ai, wr, m, fr) & (NS - 1), j0 = ((u.pn * 256 + bj * 128 + wc * 32 + 8 * fq - 1024) & 63) >> 1;
                        cs[m][bj] = *(const f32x4*)(ropeC + s * 32 + j0); sn[m][bj] = *(const f32x4*)(ropeS + s * 32 + j0); }
#pragma unroll
                for (int m = 0; m < 4; ++m) { const int row = EPI_ROW(u, ai, wr, m, fr), b = row >> 12, s = row & (NS - 1); const float rstd = rs[ai][m];
#pragma unroll
                    for (int bj = 0; bj < 2; ++bj) { const int cc = u.pn * 256 + bj * 128 + wc * 32 + 8 * fq - 1024, h = cc >> 6, i0 = cc & 63;
                        const f32x4 v0 = acc[ai][bj][m][0] * rstd, v1 = acc[ai][bj][m][1] * rstd, c = cs[m][bj], n = sn[m][bj];
                        f32x4 o0, o1;
                        o0[0] = v0[0] * c[0] - v0[1] * n[0]; o0[1] = v0[0] * n[0] + v0[1] * c[0];
                        o0[2] = v0[2] * c[1] - v0[3] * n[1]; o0[3] = v0[2] * n[1] + v0[3] * c[1];
                        o1[0] = v1[0] * c[2] - v1[1] * n[2]; o1[1] = v1[0] * n[2] + v1[1] * c[2];
                        o1[2] = v1[2] * c[3] - v1[3] * n[3]; o1[3] = v1[2] * n[3] + v1[3] * c[3];
                        *(u32x4*)(QR + (((size_t)(b * NH + h)) * NS + s) * RD + i0) = pack8u(o0, o1); } }
                asm volatile("" ::: "memory");
            }
        }
    }
};
struct EpiKV {
    static constexpr bool PERM = true;
    bf16_t *KN, *VV; const float* rkv;
    __device__ __forceinline__ void operator()(const Acc& acc, const Unit& u, int wr, int wc, int fr, int fq) const {
        float rs[2][4];
#pragma unroll
        for (int ai = 0; ai < 2; ++ai)
#pragma unroll
            for (int m = 0; m < 4; ++m) rs[ai][m] = rkv[EPI_ROW(u, ai, wr, m, fr)];
#pragma unroll
        for (int ai = 0; ai < 2; ++ai)
#pragma unroll
            for (int m = 0; m < 4; ++m) {
                const int row = EPI_ROW(u, ai, wr, m, fr); const float rstd = rs[ai][m];
                const int b = row >> 12, s = row & (NS - 1);
                const size_t o = (((size_t)(b * NH + u.pn)) * NS + s) * 128 + wc * 32 + 8 * fq;
                *(u32x4*)(KN + o) = pack8u(acc[ai][0][m][0] * rstd, acc[ai][0][m][1] * rstd);
                *(u32x4*)(VV + o) = pack8u(acc[ai][1][m][0] * rstd, acc[ai][1][m][1] * rstd);
            }
    }
};
struct EpiRouter {
    static constexpr bool PERM = false;
    float* LOG;
    __device__ __forceinline__ void operator()(const Acc& acc, const Unit& u, int wr, int wc, int fr, int fq) const {
        if (wc > 2) return;
#pragma unroll
        for (int ai = 0; ai < 2; ++ai)
#pragma unroll
            for (int m = 0; m < 4; ++m) {
                const int row = EPI_ROW(u, ai, wr, m, fr);
#pragma unroll
                for (int n = 0; n < 2; ++n) { const int c = wc * 32 + 16 * n + 4 * fq; if (c < 72) *(f32x4*)(LOG + ((size_t)u.ex * MROWS + row) * 72 + c) = acc[ai][0][m][n]; }
            }
    }
};
struct EpiGU {
    static constexpr bool PERM = true;
    bf16_t* HID; const float* rowrs;
    __device__ __forceinline__ void operator()(const Acc& acc, const Unit& u, int wr, int wc, int fr, int fq) const {
#pragma unroll
        for (int ai = 0; ai < 2; ++ai)
#pragma unroll
            for (int m = 0; m < 4; ++m) {
                if (ai == 1 && u.hm) continue;
                const int slot = EPI_ROW(u, ai, wr, m, fr) + u.ro;
                const float rs = rowrs[slot];
                const f32x4 g0 = acc[ai][0][m][0] * rs, g1 = acc[ai][0][m][1] * rs;
                const f32x4 h0 = g0 * sigmoid4(g0) * (acc[ai][1][m][0] * rs), h1 = g1 * sigmoid4(g1) * (acc[ai][1][m][1] * rs);
                *(u32x4*)(HID + (size_t)slot * DEXP + u.pn * 128 + wc * 32 + 8 * fq) = pack8u(h0, h1);
            }
    }
};
struct EpiDown {
    static constexpr bool PERM = true;
    bf16_t* YS; const int* rowtok; const float* roww;
    __device__ __forceinline__ void operator()(const Acc& acc, const Unit& u, int wr, int wc, int fr, int fq) const {
        int tk[2][4]; float ww[2][4];
#pragma unroll
        for (int ai = 0; ai < 2; ++ai)
#pragma unroll
            for (int m = 0; m < 4; ++m) { const int slot = EPI_ROW(u, ai, wr, m, fr) + u.ro; tk[ai][m] = (ai == 1 && u.hm) ? -1 : rowtok[slot]; ww[ai][m] = roww[slot]; }
#pragma unroll
        for (int ai = 0; ai < 2; ++ai)
#pragma unroll
            for (int m = 0; m < 4; ++m) {
                const int t = tk[ai][m];
                if (t >= 0) {
                    const float w = ww[ai][m];
                    bf16_t* dst = YS + ((size_t)(t & 1) * MROWS + (t >> 1)) * DM + u.pn * 256 + wc * 32 + 8 * fq;
#pragma unroll
                    for (int bj = 0; bj < 2; ++bj) __builtin_nontemporal_store(pack8u(acc[ai][bj][m][0] * w, acc[ai][bj][m][1] * w), (u32x4*)(dst + bj * 128));
                }
            }
    }
};
struct EpiPP {
    static constexpr bool PERM = true;
    bf16_t* PP;
    __device__ __forceinline__ void operator()(const Acc& acc, const Unit& u, int wr, int wc, int fr, int fq) const {
#pragma unroll
        for (int ai = 0; ai < 2; ++ai)
#pragma unroll
            for (int m = 0; m < 4; ++m) {
                const int row = EPI_ROW(u, ai, wr, m, fr);
#pragma unroll
                for (int bj = 0; bj < 2; ++bj) *(u32x4*)(PP + (size_t)row * DM + u.pn * 256 + bj * 128 + wc * 32 + 8 * fq) = pack8u(acc[ai][bj][m][0], acc[ai][bj][m][1]);
            }
    }
};
struct EpiPLE {
    static constexpr bool PERM = true;
    const bf16_t* H2b; bf16_t* H3b; const bf16_t* PP; const float* rstd3;
    __device__ __forceinline__ void operator()(const Acc& acc, const Unit& u, int wr, int wc, int fr, int fq) const {
        float rs[2][4];
#pragma unroll
        for (int ai = 0; ai < 2; ++ai)
#pragma unroll
            for (int m = 0; m < 4; ++m) rs[ai][m] = rstd3[EPI_ROW(u, ai, wr, m, fr)];
#pragma unroll
        for (int ai = 0; ai < 2; ++ai)
#pragma unroll
            for (int mh = 0; mh < 2; ++mh) {
                u32x4 hv[2][2], pv[2][2];
#pragma unroll
                for (int mm = 0; mm < 2; ++mm)
#pragma unroll
                    for (int bj = 0; bj < 2; ++bj) { const size_t off = (size_t)EPI_ROW(u, ai, wr, 2 * mh + mm, fr) * DM + u.pn * 256 + bj * 128 + wc * 32 + 8 * fq; hv[mm][bj] = *(const u32x4*)(H2b + off); pv[mm][bj] = *(const u32x4*)(PP + off); }
#pragma unroll
                for (int mm = 0; mm < 2; ++mm)
#pragma unroll
                    for (int bj = 0; bj < 2; ++bj) { const int m = 2 * mh + mm; const size_t off = (size_t)EPI_ROW(u, ai, wr, m, fr) * DM + u.pn * 256 + bj * 128 + wc * 32 + 8 * fq;
                        f32x4 h0, h1, p0, p1; unpack8(hv[mm][bj], h0, h1); unpack8(pv[mm][bj], p0, p1);
                        const f32x4 a0 = acc[ai][bj][m][0], a1 = acc[ai][bj][m][1]; const float r = rs[ai][m];
                        h0 += sigmoid4(a0 * r) * p0; h1 += sigmoid4(a1 * r) * p1;
                        *(u32x4*)(H3b + off) = pack8u(h0, h1); }
                asm volatile("" ::: "memory");
            }
    }
};
}

namespace att {
constexpr int SHM_V = 16384, SHM_KN = 16384, SHM_KR = 8192;
constexpr int OFF_V = 0, OFF_KN = 32768, OFF_KR = 65536, OFF_WS = 81920;
constexpr float SCALE = 0.07216878364870322f;
constexpr float THR = 8.f;
#define KSWZ(row, colB) ((row) * 256 + ((colB) ^ (((row) & 15) << 4)))
#define KRSWZ(row, colB) ((row) * 128 + ((colB) ^ ((((row) >> 1) & 7) << 4)))
#define SBAR() __builtin_amdgcn_sched_barrier(0)
__device__ __forceinline__ int v_st(int k, int c) { const int kk = (k & ~0xC) | ((k & 4) << 1) | ((k & 8) >> 1); return ((kk >> 3) * 4 + (c >> 5)) * 512 + ((kk & 7) * 32 + (c & 31)) * 2; }
__device__ __forceinline__ int v_rd_base(int lane) { return ((lane & 3) << 3) | (((lane >> 2) & 3) << 6) | (((lane >> 4) & 1) << 5) | (((lane >> 5) & 1) << 8); }
constexpr int v_rd_off(int d0, int ks, int half) { return d0 * 512 + ks * 4096 + half * 2048; }
__device__ __forceinline__ int crow(int r, int hi) { return (r & 3) + 8 * (r >> 2) + 4 * hi; }

__device__ __forceinline__ void partialSM(f32x16& p0, f32x16& p1, float& m_reg, float& mn, float& alpha) {
    float pmax = p0[0];
#pragma unroll
    for (int r = 1; r < 16; ++r) pmax = fmaxf(pmax, p0[r]);
#pragma unroll
    for (int r = 0; r < 16; ++r) pmax = fmaxf(pmax, p1[r]);
    { auto rr = __builtin_amdgcn_permlane32_swap(__float_as_uint(pmax), __float_as_uint(pmax), false, false);
      pmax = fmaxf(__uint_as_float(rr[0]), __uint_as_float(rr[1])); }
    constexpr float C2 = 1.4426950408889634f * SCALE;
    if (__builtin_expect(__all((pmax - m_reg) * SCALE <= THR), 1)) { mn = m_reg; alpha = 1.f; }
    else { mn = fmaxf(m_reg, pmax); alpha = __builtin_amdgcn_exp2f((m_reg - mn) * C2); m_reg = mn; }
    const float mnL = -mn * C2;
#pragma unroll
    for (int r = 0; r < 16; ++r) p0[r] = fmaf(p0[r], C2, mnL);
#pragma unroll
    for (int r = 0; r < 16; ++r) p1[r] = fmaf(p1[r], C2, mnL);
#pragma unroll
    for (int r = 0; r < 16; ++r) p0[r] = __builtin_amdgcn_exp2f(p0[r]);
}
__device__ __forceinline__ void finishSM(f32x16& p0, f32x16& p1, float alpha, float& l_reg, bf16x8& pa0, bf16x8& pa1, bf16x8& pa2, bf16x8& pa3) {
#pragma unroll
    for (int r = 0; r < 16; ++r) p1[r] = __builtin_amdgcn_exp2f(p1[r]);
    float ps = 0;
#pragma unroll
    for (int r = 0; r < 16; ++r) ps += p0[r];
#pragma unroll
    for (int r = 0; r < 16; ++r) ps += p1[r];
    { auto rr = __builtin_amdgcn_permlane32_swap(__float_as_uint(ps), __float_as_uint(ps), false, false);
      ps = __uint_as_float(rr[0]) + __uint_as_float(rr[1]); }
    l_reg = l_reg * alpha + ps;
#define PK4(P, B_, OUT) do { unsigned a0 = cvtpk(P[B_+0], P[B_+1]), a1 = cvtpk(P[B_+2], P[B_+3]);                          \
        unsigned b0 = cvtpk(P[B_+4], P[B_+5]), b1 = cvtpk(P[B_+6], P[B_+7]);                                             \
        auto r0 = __builtin_amdgcn_permlane32_swap(a0, b0, false, false); auto r1 = __builtin_amdgcn_permlane32_swap(a1, b1, false, false); \
        u32x4 w = {r0[0], r1[0], r0[1], r1[1]}; OUT = *reinterpret_cast<bf16x8*>(&w); } while (0)
    PK4(p0, 0, pa0); PK4(p0, 8, pa1); PK4(p1, 0, pa2); PK4(p1, 8, pa3);
#undef PK4
}
#define KRD(dst, addr, off) asm volatile("ds_read_b128 %0, %1 offset:%2" : "=&v"(dst) : "v"(addr), "i"(off) : "memory")
template <int KB>
__device__ __forceinline__ void qkt(f32x16& p0, f32x16& p1, const char* lds, int r32, int hi, const bf16x8* qr) {
    p0 = f32x16{}; p1 = f32x16{};
    const int kn = (int)(uintptr_t)(lds + OFF_KN + KB * SHM_KN), kr = (int)(uintptr_t)(lds + OFF_KR + KB * SHM_KR);
    int ko[4], kq[4];
#pragma unroll
    for (int dd = 0; dd < 4; ++dd) { ko[dd] = KSWZ(r32, (dd * 16 + hi * 8) * 2); kq[dd] = kr + KRSWZ(r32, (dd * 16 + hi * 8) * 2); }
    bf16x8 x0, x1, y0, y1;
#define QK_RDN(A, B, s) do { const int a_ = kn + (((s) >> 2) ? (ko[(s) & 3] ^ 128) : ko[(s) & 3]); KRD(A, a_, 0); KRD(B, a_, 8192); } while (0)
#define QK_RDR(A, B, s) do { const int a_ = kq[(s) - 8]; KRD(A, a_, 0); KRD(B, a_, 4096); } while (0)
#define QK_MM(A, B, s) do { p0 = __builtin_amdgcn_mfma_f32_32x32x16_bf16(A, qr[s], p0, 0, 0, 0); p1 = __builtin_amdgcn_mfma_f32_32x32x16_bf16(B, qr[s], p1, 0, 0, 0); } while (0)
#define QK_W2() do { asm volatile("s_waitcnt lgkmcnt(2)" ::: "memory"); SBAR(); } while (0)
    QK_RDN(x0, x1, 0); QK_RDN(y0, y1, 1);
    QK_W2(); QK_MM(x0, x1, 0); SBAR(); QK_RDN(x0, x1, 2);
    QK_W2(); QK_MM(y0, y1, 1); SBAR(); QK_RDN(y0, y1, 3);
    QK_W2(); QK_MM(x0, x1, 2); SBAR(); QK_RDN(x0, x1, 4);
    QK_W2(); QK_MM(y0, y1, 3); SBAR(); QK_RDN(y0, y1, 5);
    QK_W2(); QK_MM(x0, x1, 4); SBAR(); QK_RDN(x0, x1, 6);
    QK_W2(); QK_MM(y0, y1, 5); SBAR(); QK_RDN(y0, y1, 7);
    QK_W2(); QK_MM(x0, x1, 6); SBAR(); QK_RDR(x0, x1, 8);
    QK_W2(); QK_MM(y0, y1, 7); SBAR(); QK_RDR(y0, y1, 9);
    QK_W2(); QK_MM(x0, x1, 8); SBAR(); QK_RDR(x0, x1, 10);
    QK_W2(); QK_MM(y0, y1, 9); SBAR(); QK_RDR(y0, y1, 11);
    QK_W2(); QK_MM(x0, x1, 10); SBAR();
    asm volatile("s_waitcnt lgkmcnt(0)" ::: "memory"); SBAR(); QK_MM(y0, y1, 11);
#undef QK_RDN
#undef QK_RDR
#undef QK_MM
#undef QK_W2
}
#define TRRD(dst, off) asm volatile("ds_read_b64_tr_b16 %0, %1 offset:%2" : "=&v"(dst) : "v"(vb0), "i"(off) : "memory")
template <int VB, int D0, int OI>
__device__ __forceinline__ void pv_d0(f32x16* o, int vb0, bf16x8 pa0, bf16x8 pa1, bf16x8 pa2, bf16x8 pa3) {
    s16x4 l0, l1, l2, l3, h0, h1, h2, h3; constexpr int b_ = VB * SHM_V + v_rd_off(D0, 0, 0);
    TRRD(l0, b_); TRRD(h0, b_ + 2048); TRRD(l1, b_ + 4096); TRRD(h1, b_ + 6144); TRRD(l2, b_ + 8192); TRRD(h2, b_ + 10240); TRRD(l3, b_ + 12288); TRRD(h3, b_ + 14336);
    asm volatile("s_waitcnt lgkmcnt(0)" ::: "memory"); SBAR();
    o[OI] = __builtin_amdgcn_mfma_f32_32x32x16_bf16(pa0, (bf16x8){l0[0], l0[1], l0[2], l0[3], h0[0], h0[1], h0[2], h0[3]}, o[OI], 0, 0, 0);
    o[OI] = __builtin_amdgcn_mfma_f32_32x32x16_bf16(pa1, (bf16x8){l1[0], l1[1], l1[2], l1[3], h1[0], h1[1], h1[2], h1[3]}, o[OI], 0, 0, 0);
    o[OI] = __builtin_amdgcn_mfma_f32_32x32x16_bf16(pa2, (bf16x8){l2[0], l2[1], l2[2], l2[3], h2[0], h2[1], h2[2], h2[3]}, o[OI], 0, 0, 0);
    o[OI] = __builtin_amdgcn_mfma_f32_32x32x16_bf16(pa3, (bf16x8){l3[0], l3[1], l3[2], l3[3], h3[0], h3[1], h3[2], h3[3]}, o[OI], 0, 0, 0);
}
#define PV_RD(L, H, ks) do { TRRD(L[0], VB * SHM_V + v_rd_off(0, ks, 0)); TRRD(H[0], VB * SHM_V + v_rd_off(0, ks, 1)); TRRD(L[1], VB * SHM_V + v_rd_off(1, ks, 0)); TRRD(H[1], VB * SHM_V + v_rd_off(1, ks, 1)); \
        TRRD(L[2], VB * SHM_V + v_rd_off(2, ks, 0)); TRRD(H[2], VB * SHM_V + v_rd_off(2, ks, 1)); TRRD(L[3], VB * SHM_V + v_rd_off(3, ks, 0)); TRRD(H[3], VB * SHM_V + v_rd_off(3, ks, 1)); } while (0)
#define PV_MM(L, H, pa) do { _Pragma("unroll") for (int d_ = 0; d_ < 4; ++d_) \
        o[d_] = __builtin_amdgcn_mfma_f32_32x32x16_bf16(pa, (bf16x8){L[d_][0], L[d_][1], L[d_][2], L[d_][3], H[d_][0], H[d_][1], H[d_][2], H[d_][3]}, o[d_], 0, 0, 0); } while (0)
template <int VB>
__device__ __forceinline__ void pv_pre(int vb0, s16x4 (&la)[4], s16x4 (&ha)[4]) { PV_RD(la, ha, 0); }
template <int VB>
__device__ __forceinline__ void pv_tile(f32x16* o, int vb0, s16x4 (&la)[4], s16x4 (&ha)[4], s16x4 (&lb)[4], s16x4 (&hb)[4], bf16x8 pa0, bf16x8 pa1, bf16x8 pa2, bf16x8 pa3) {
    PV_RD(lb, hb, 1);
    asm volatile("s_waitcnt lgkmcnt(8)" ::: "memory"); SBAR(); PV_MM(la, ha, pa0); SBAR();
    PV_RD(la, ha, 2);
    asm volatile("s_waitcnt lgkmcnt(8)" ::: "memory"); SBAR(); PV_MM(lb, hb, pa1); SBAR();
    PV_RD(lb, hb, 3);
    asm volatile("s_waitcnt lgkmcnt(8)" ::: "memory"); SBAR(); PV_MM(la, ha, pa2); SBAR();
    asm volatile("s_waitcnt lgkmcnt(0)" ::: "memory"); SBAR(); PV_MM(lb, hb, pa3);
}
#undef PV_RD
#undef PV_MM
template <int VB, int CH>
__device__ __forceinline__ void pv_half(f32x16* o, int vb0, bf16x8 pa0, bf16x8 pa1, bf16x8 pa2, bf16x8 pa3) {
    s16x4 la[2], ha[2], lb[2], hb[2];
#define PH_RD(L, H, ks) do { TRRD(L[0], VB * SHM_V + v_rd_off(2 * CH, ks, 0)); TRRD(H[0], VB * SHM_V + v_rd_off(2 * CH, ks, 1)); TRRD(L[1], VB * SHM_V + v_rd_off(2 * CH + 1, ks, 0)); TRRD(H[1], VB * SHM_V + v_rd_off(2 * CH + 1, ks, 1)); } while (0)
#define PH_MM(L, H, pa) do { _Pragma("unroll") for (int d_ = 0; d_ < 2; ++d_) \
        o[d_] = __builtin_amdgcn_mfma_f32_32x32x16_bf16(pa, (bf16x8){L[d_][0], L[d_][1], L[d_][2], L[d_][3], H[d_][0], H[d_][1], H[d_][2], H[d_][3]}, o[d_], 0, 0, 0); } while (0)
    PH_RD(la, ha, 0); PH_RD(lb, hb, 1);
    asm volatile("s_waitcnt lgkmcnt(4)" ::: "memory"); SBAR(); PH_MM(la, ha, pa0); SBAR();
    PH_RD(la, ha, 2);
    asm volatile("s_waitcnt lgkmcnt(4)" ::: "memory"); SBAR(); PH_MM(lb, hb, pa1); SBAR();
    PH_RD(lb, hb, 3);
    asm volatile("s_waitcnt lgkmcnt(4)" ::: "memory"); SBAR(); PH_MM(la, ha, pa2); SBAR();
    asm volatile("s_waitcnt lgkmcnt(0)" ::: "memory"); SBAR(); PH_MM(lb, hb, pa3);
#undef PH_RD
#undef PH_MM
}

__device__ __forceinline__ void attn_block(char* lds, const bf16_t* QN, const bf16_t* QR, const bf16_t* KN, const bf16_t* KPE, const bf16_t* VV, bf16_t* O, int bh, int qb) {
    int tid = threadIdx.x; asm volatile("" : "+v"(tid));
    const int wid = __builtin_amdgcn_readfirstlane(tid >> 6), lane = tid & 63, r32 = lane & 31, hi = lane >> 5;
    const int b = bh >> 3, h = bh & 7, P0 = qb * 256, NT = 4 * qb + 4;
    const int cw = (P0 + 32 * wid) >> 6;
    bf16x8 qr[12];
    { const bf16_t* qn = QN + ((size_t)bh * NS + P0 + wid * 32 + r32) * 128; const bf16_t* qp = QR + ((size_t)bh * NS + P0 + wid * 32 + r32) * RD;
#pragma unroll
      for (int d0 = 0; d0 < 8; ++d0) qr[d0] = *(const bf16x8*)(qn + d0 * 16 + hi * 8);
#pragma unroll
      for (int dd = 0; dd < 4; ++dd) qr[8 + dd] = *(const bf16x8*)(qp + dd * 16 + hi * 8); }
    const bf16_t* Kh = KN + (size_t)bh * NS * 128; const bf16_t* Vh = VV + (size_t)bh * NS * 128; const bf16_t* Kp = KPE + (size_t)b * NS * RD;
    const int sr = tid >> 4, sc = (tid & 15) * 8, rr = tid >> 3, rc = (tid & 7) * 8;
    const int kws = KSWZ(sr, sc * 2), vst0 = v_st(sr, sc), vst1 = v_st(32 + sr, sc), krw = KRSWZ(rr, rc * 2);
    const int vb0 = (int)(uintptr_t)(lds + OFF_V) + v_rd_base(lane);
    float* wsf = (float*)(lds + OFF_WS) + wid * 64; float* li_l = wsf; float* al_l = wsf + 32;
    bf16x8 sk0, sk1, sv0, sv1, skr;
#define SLOAD(k0) do { sk0 = *(const bf16x8*)(Kh + (size_t)((k0) + sr) * 128 + sc); sk1 = *(const bf16x8*)(Kh + (size_t)((k0) + 32 + sr) * 128 + sc); \
        sv0 = *(const bf16x8*)(Vh + (size_t)((k0) + sr) * 128 + sc); sv1 = *(const bf16x8*)(Vh + (size_t)((k0) + 32 + sr) * 128 + sc); \
        skr = *(const bf16x8*)(Kp + (size_t)((k0) + rr) * RD + rc); } while (0)
#define SWRITE(bf) do { *(bf16x8*)(lds + OFF_KN + (bf) * SHM_KN + kws) = sk0; *(bf16x8*)(lds + OFF_KN + (bf) * SHM_KN + kws + 32 * 256) = sk1; \
        *(bf16x8*)(lds + OFF_V + (bf) * SHM_V + vst0) = sv0; *(bf16x8*)(lds + OFF_V + (bf) * SHM_V + vst1) = sv1; \
        *(bf16x8*)(lds + OFF_KR + (bf) * SHM_KR + krw) = skr; } while (0)
    float m_reg = -1e30f, l_reg = 0.f; f32x16 o[4] = {};
    __syncthreads();
    SLOAD(0); SWRITE(0);
    __syncthreads();
#define COMPUTE(KB) do { f32x16 p0, p1; float mn, alpha; bf16x8 pa0, pa1, pa2, pa3; \
        s16x4 la[4], ha[4], lb[4], hb[4]; \
        qkt<KB>(p0, p1, lds, r32, hi, qr); pv_pre<KB>(vb0, la, ha); partialSM(p0, p1, m_reg, mn, alpha); \
        if (__any(alpha < 1.f)) { if (hi == 0) al_l[r32] = alpha; asm volatile("s_waitcnt lgkmcnt(0)" ::: "memory"); \
            _Pragma("unroll") for (int r = 0; r < 16; ++r) { const float a_ = al_l[crow(r, hi)]; _Pragma("unroll") for (int d_ = 0; d_ < 4; ++d_) o[d_][r] *= a_; } } \
        finishSM(p0, p1, alpha, l_reg, pa0, pa1, pa2, pa3); SBAR(); \
        pv_tile<KB>(o, vb0, la, ha, lb, hb, pa0, pa1, pa2, pa3); } while (0)
    for (int t = 0; t < NT; t += 2) {
        SLOAD((t + 1) * 64);
        if (t <= cw) COMPUTE(0);
        SWRITE(1);
        __syncthreads();
        if (t + 2 < NT) SLOAD((t + 2) * 64);
        if (t + 1 <= cw) COMPUTE(1);
        if (t + 2 < NT) SWRITE(0);
        __syncthreads();
    }
#undef COMPUTE
#undef SLOAD
#undef SWRITE
    if (hi == 0) li_l[r32] = l_reg;
    asm volatile("s_waitcnt lgkmcnt(0)" ::: "memory");
    float rli[16];
#pragma unroll
    for (int r = 0; r < 16; ++r) rli[r] = __builtin_amdgcn_rcpf(li_l[crow(r, hi)]);
    bf16_t* Ow = O + ((size_t)b * NS + P0 + wid * 32) * DM + h * 128;
    char* ot = lds + wid * 8192;
#pragma unroll
    for (int r = 0; r < 16; ++r) { const int orow = crow(r, hi);
#pragma unroll
        for (int d0 = 0; d0 < 4; ++d0) *(__bf16*)(ot + orow * 256 + (d0 * 32 + r32) * 2) = (__bf16)(o[d0][r] * rli[r]); }
    asm volatile("s_waitcnt lgkmcnt(0)" ::: "memory");
#pragma unroll
    for (int j = 0; j < 8; ++j) { const int id = lane + 64 * j, row = id >> 4, cc = id & 15;
        *(u32x4*)(Ow + (size_t)row * DM + cc * 8) = *(const u32x4*)(ot + row * 256 + cc * 16); }
}
__device__ __forceinline__ void attn_phase(char* lds, const bf16_t* QN, const bf16_t* QR, const bf16_t* KN, const bf16_t* KPE, const bf16_t* VV, bf16_t* O, int G, int blk) {
    for (int L = blk; L < 512; L += G) {
        const int xcd = L & 7, k = L >> 3, bh = xcd * 8 + (k >> 3), y = k & 7;
        attn_block(lds, QN, QR, KN, KPE, VV, O, bh, 15 - y);
        attn_block(lds, QN, QR, KN, KPE, VV, O, bh, y);
    }
}

__device__ __forceinline__ void spatial_phase(char* lds, const bf16_t* U, const bf16_t* V, const float* vpart, const float* g_gv, const bf16_t* Wsp, const float* bsp, bf16_t* Y, int G, int blk0) {
    int tid = threadIdx.x; asm volatile("" : "+v"(tid));
    const int wid = __builtin_amdgcn_readfirstlane(tid >> 6), lane = tid & 63, r32 = lane & 31, hi = lane >> 5;
    constexpr int OFF_S = 32768, SP = 132, OFF_MU = OFF_S + 128 * SP * 4;
    float* S_l = (float*)(lds + OFF_S); float* mu_l = (float*)(lds + OFF_MU); float* rs_l = mu_l + 128;
    const int vb0 = (int)(uintptr_t)(lds + OFF_V) + v_rd_base(lane);
    const int sr = tid >> 4, sc = (tid & 15) * 8;
    const int ts = (wid & 3) * 32, ch = wid >> 2;
    for (int blk = blk0; blk < MROWS / 128; blk += G) {
        __syncthreads();
        if (tid < 128) { const f32x2* pp = (const f32x2*)(vpart + (size_t)(blk * 128 + tid) * 96); float s = 0.f, q = 0.f;
            for (int i = 0; i < 48; ++i) { const f32x2 v = pp[i]; s += v.x; q += v.y; }
            const float mean = s * (1.f / GWID); float var = q * (1.f / GWID) - mean * mean; var = var < 0.f ? 0.f : var;
            mu_l[tid] = mean; rs_l[tid] = __builtin_amdgcn_rsqf(var + EPS); }
        float* bs_l = rs_l + 128;
        for (int i = tid; i < 12 * 128; i += 512) bs_l[i] = bsp[i];
        float* g_l = bs_l + 12 * 128;
        for (int i = tid; i < GWID; i += 512) g_l[i] = g_gv[i];
        const size_t rowbase = (size_t)(blk * 128 + sr) * GWID + sc;
        u32x4 vv[4], uu[4]; bf16x8 pw[8];
        const bf16_t* wrow0 = Wsp + ((size_t)(ts + r32)) * 128 + hi * 8;
#pragma unroll
        for (int q = 0; q < 4; ++q) { vv[q] = __builtin_nontemporal_load((const u32x4*)(V + rowbase + (size_t)(32 * q) * GWID)); uu[q] = __builtin_nontemporal_load((const u32x4*)(U + rowbase + (size_t)(32 * q) * GWID)); }
#pragma unroll
        for (int k = 0; k < 8; ++k) pw[k] = *(const bf16x8*)(wrow0 + 16 * k);
        __syncthreads();
        for (int g = 0; g < 12; ++g) {
            u32x4 uc[4]; bf16x8 pc[8];
            { const f32x4 gg0 = *(const f32x4*)(g_l + g * 128 + sc), gg1 = *(const f32x4*)(g_l + g * 128 + sc + 4);
#pragma unroll
              for (int q = 0; q < 4; ++q) { const int s = sr + 32 * q; f32x4 a, b2; unpack8(vv[q], a, b2); const float mu = mu_l[s], rs = rs_l[s];
                a = (a - mu) * rs * gg0; b2 = (b2 - mu) * rs * gg1;
                *(bf16x8*)(lds + OFF_V + (q >> 1) * SHM_V + v_st(s & 63, sc)) = pack8(a, b2); uc[q] = uu[q]; } }
#pragma unroll
            for (int k = 0; k < 8; ++k) pc[k] = pw[k];
            if (g + 1 < 12) {
#pragma unroll
                for (int q = 0; q < 4; ++q) { vv[q] = __builtin_nontemporal_load((const u32x4*)(V + rowbase + (size_t)(32 * q) * GWID + (g + 1) * 128)); uu[q] = __builtin_nontemporal_load((const u32x4*)(U + rowbase + (size_t)(32 * q) * GWID + (g + 1) * 128)); }
#pragma unroll
                for (int k = 0; k < 8; ++k) pw[k] = *(const bf16x8*)(wrow0 + (size_t)(g + 1) * 128 * 128 + 16 * k); }
            __syncthreads();
            f32x16 o[2] = {};
            if (ch == 0) pv_half<0, 0>(o, vb0, pc[0], pc[1], pc[2], pc[3]); else pv_half<0, 1>(o, vb0, pc[0], pc[1], pc[2], pc[3]);
            if (ts >= 64) { if (ch == 0) pv_half<1, 0>(o, vb0, pc[4], pc[5], pc[6], pc[7]); else pv_half<1, 1>(o, vb0, pc[4], pc[5], pc[6], pc[7]); }
#pragma unroll
            for (int r = 0; r < 16; ++r) { const int t = ts + crow(r, hi); const float bb = bs_l[g * 128 + t];
#pragma unroll
                for (int dd = 0; dd < 2; ++dd) S_l[t * SP + (2 * ch + dd) * 32 + r32] = o[dd][r] + bb; }
            __syncthreads();
#pragma unroll
            for (int q = 0; q < 4; ++q) { const int s = sr + 32 * q; const f32x4 s0 = *(const f32x4*)(S_l + s * SP + sc), s1 = *(const f32x4*)(S_l + s * SP + sc + 4);
                f32x4 a, b2; unpack8(uc[q], a, b2);
                *(u32x4*)(Y + rowbase + (size_t)(32 * q) * GWID + g * 128) = pack8u(a * s0, b2 * s1); }
        }
    }
}
#undef TRRD
#undef KSWZ
#undef KRSWZ
#undef SBAR
}


#define XB_TMO      128
#define XB_XCNT(j)  (256  + 64 * (j))
#define XB_XSUB(j)  (1280 + 64 * (j))
#define XB_XGEN(j)  (2304 + 64 * (j))
#define XB_TOP      3328
#define XB_TOPGEN   3392
#define XCD_BAR_WORDS 3456
#define XB_SPIN_CAP (1u << 18)
__device__ __forceinline__ unsigned xb_ld(unsigned* p)              { return __hip_atomic_load(p, __ATOMIC_RELAXED, __HIP_MEMORY_SCOPE_AGENT); }
__device__ __forceinline__ unsigned xb_add(unsigned* p, unsigned v) { return __hip_atomic_fetch_add(p, v, __ATOMIC_RELAXED, __HIP_MEMORY_SCOPE_AGENT); }
__device__ __forceinline__ unsigned xb_xcc_id() { return (unsigned)__builtin_amdgcn_s_getreg((3 << 11) | 20) & 0xFu; }
#define XB_SPIN(cond, bar) do { unsigned _sp = 0; while (cond) { __builtin_amdgcn_s_sleep(1); \
    if ((++_sp & 255u) == 0u) { if (xb_ld(&(bar)[XB_TMO])) break; if (_sp > XB_SPIN_CAP) { atomicAdd(&(bar)[XB_TMO], 1u); break; } } } } while (0)
struct XcdBarrier { unsigned* bar; unsigned x; volatile LAS unsigned* st; };
__device__ __forceinline__ XcdBarrier xcd_barrier_post(unsigned* bar, volatile LAS unsigned* st) {
    XcdBarrier b; b.bar = bar; b.x = xb_xcc_id(); b.st = st;
    if (threadIdx.x == 0) (void)xb_add(&bar[XB_XCNT(b.x)], 1u);
    return b;
}
__device__ __forceinline__ void xcd_barrier_complete(unsigned* bar, unsigned x, unsigned& nloc, unsigned& nx) {
    const unsigned G = gridDim.x * gridDim.y * gridDim.z;
    unsigned sum, cnt, mine, sp = 0u;
    for (;;) {
        sum = 0u; cnt = 0u; mine = 0u;
#pragma unroll
        for (unsigned j = 0; j < 16; ++j) { const unsigned c = xb_ld(&bar[XB_XCNT(j)]); sum += c; cnt += (c > 0u) ? 1u : 0u; mine = (j == x) ? c : mine; }
        if (sum == G) break;
        __builtin_amdgcn_s_sleep(1);
        if ((++sp & 255u) == 0u) { if (xb_ld(&bar[XB_TMO])) break; if (sp > XB_SPIN_CAP) { atomicAdd(&bar[XB_TMO], 1u); break; } }
    }
    nloc = mine > 0u ? mine : 1u; nx = cnt > 0u ? cnt : 1u;
}
__device__ __forceinline__ void xcd_barrier(const XcdBarrier& b) {
    asm volatile("s_waitcnt vmcnt(0)" ::: "memory");
    __syncthreads();
    if (threadIdx.x == 0) {
        unsigned* bar = b.bar;
        __builtin_amdgcn_s_waitcnt(0);
        unsigned nloc = b.st[0], nx = b.st[1];
        if (nloc == 0u) { xcd_barrier_complete(bar, b.x, nloc, nx); b.st[0] = nloc; b.st[1] = nx; }
        const unsigned old = xb_add(&bar[XB_XSUB(b.x)], 1u);
        const unsigned gen = old / nloc;
        if (old + 1u == (gen + 1u) * nloc) {
            __builtin_amdgcn_fence(__ATOMIC_RELEASE, "agent");
            asm volatile("s_waitcnt vmcnt(0)" ::: "memory");
            const unsigned og = xb_add(&bar[XB_TOP], 1u);
            const unsigned tg = og / nx;
            if (og + 1u == (tg + 1u) * nx) xb_add(&bar[XB_TOPGEN], 1u);
            else XB_SPIN(xb_ld(&bar[XB_TOPGEN]) == tg, bar);
            __builtin_amdgcn_fence(__ATOMIC_ACQUIRE, "agent");
            xb_add(&bar[XB_XGEN(b.x)], 1u);
            asm volatile("s_waitcnt vmcnt(0)" ::: "memory");
        } else {
            XB_SPIN(xb_ld(&bar[XB_XGEN(b.x)]) == gen, bar);
            __builtin_amdgcn_fence(__ATOMIC_ACQUIRE, "agent");
            asm volatile("s_waitcnt vmcnt(0)" ::: "memory");
        }
    }
    __syncthreads();
}

constexpr int NWAVES = 8, NTHREADS = 512;
constexpr int LDS_BYTES = 147456;
constexpr int NPHASE = 17;

struct Args {
    const float* in[26]; float* out; unsigned char* ws; int ph_lo, ph_hi;
};

enum { MAP_ID = 0, MAP_WIN = 1, MAP_WUQ = 2, MAP_GATE = 3, MAP_UP = 4 };
__device__ __forceinline__ int rowmap(int kind, int n) {
    if (kind == MAP_WIN) {
        if (n < 3072) return n;
        if (n < 3456) return SEG_CQ + (n - 3072);
        if (n < 3712) return SEG_CKV + (n - 3456);
        if (n < 3776) { const int j = n - 3712; return SEG_KR + (j < 32 ? 2 * j : 2 * (j - 32) + 1); }
        if (n < 4800) return SEG_GA + (n - 3776);
        return SEG_GB + (n - 4800);
    }
    if (kind == MAP_WUQ) { const int h = n / 192, r = n % 192; if (r < 128) return h * 128 + r; const int j = r - 128; return 1024 + h * 64 + (j < 32 ? 2 * j : 2 * (j - 32) + 1); }
    if (kind == MAP_GATE) return (n >> 7) * 256 + (n & 127);
    if (kind == MAP_UP) return (n >> 7) * 256 + 128 + (n & 127);
    return n;
}
__device__ __forceinline__ void transpose_item(const float* W, int K, int N, const float* kscale, bf16_t* WT, int kind, LAS float* scr, int item, int lane) {
    const int nblk = N / 32, kb = item / nblk, nb = item % nblk, k0 = 64 * kb, n0 = 32 * nb;
    float tv[32];
#pragma unroll
    for (int i = 0; i < 32; ++i) { const int kk = 2 * i + (lane >> 5); tv[i] = __builtin_nontemporal_load(W + (size_t)(k0 + kk) * N + n0 + (lane & 31)); }
    if (kscale) {
#pragma unroll
        for (int i = 0; i < 32; ++i) tv[i] *= kscale[k0 + 2 * i + (lane >> 5)]; }
#pragma unroll
    for (int i = 0; i < 32; ++i) scr[(2 * i + (lane >> 5)) * 33 + (lane & 31)] = tv[i];
    asm volatile("s_waitcnt lgkmcnt(0)" ::: "memory");
    const int c = lane & 7;
#pragma unroll
    for (int j = 0; j < 4; ++j) { const int n = (lane >> 3) + 8 * j; const LAS float* s = scr + (8 * c) * 33 + n;
        u32x4 o; o.x = cvtpk(s[0 * 33], s[1 * 33]); o.y = cvtpk(s[2 * 33], s[3 * 33]); o.z = cvtpk(s[4 * 33], s[5 * 33]); o.w = cvtpk(s[6 * 33], s[7 * 33]);
        *(u32x4*)(WT + (size_t)rowmap(kind, n0 + n) * K + k0 + 8 * c) = o; }
    asm volatile("s_waitcnt lgkmcnt(0)" ::: "memory");
}
__device__ __forceinline__ void transpose_job(const float* W, int K, int N, const float* kscale, bf16_t* WT, int kind, LAS float* scr, int gw, int NGW, int lane) {
    const int nitems = (K / 64) * (N / 32);
    for (int it = gw; it < nitems; it += NGW) transpose_item(W, K, N, kscale, WT, kind, scr, it, lane);
}
template <int NR>
__device__ __forceinline__ void rms_rows_to_bf16(const float* x, const float* gain, bf16_t* o, int m0, int mstride, int lane) {
    f32x4 v[NR][4];
#pragma unroll
    for (int r = 0; r < NR; ++r) { const f32x4* xr = (const f32x4*)(x + (size_t)(m0 + r * mstride) * DM) + lane;
#pragma unroll
        for (int j = 0; j < 4; ++j) v[r][j] = __builtin_nontemporal_load(xr + 64 * j); }
    f32x4 g[4];
#pragma unroll
    for (int j = 0; j < 4; ++j) g[j] = ((const f32x4*)gain)[lane + 64 * j];
#pragma unroll
    for (int r = 0; r < NR; ++r) { float s = 0.f;
#pragma unroll
        for (int j = 0; j < 4; ++j) s += (v[r][j][0] * v[r][j][0] + v[r][j][1] * v[r][j][1]) + (v[r][j][2] * v[r][j][2] + v[r][j][3] * v[r][j][3]);
        const float rstd = 1.f / sqrtf(wave_sum(s) * (1.f / DM) + EPS);
        u32x2* o8 = (u32x2*)(o + (size_t)(m0 + r * mstride) * DM) + lane;
#pragma unroll
        for (int j = 0; j < 4; ++j) { const f32x4 w = v[r][j] * rstd * g[j]; o8[64 * j] = (u32x2){cvtpk(w[0], w[1]), cvtpk(w[2], w[3])}; } }
}

__global__ void __launch_bounds__(NTHREADS, 2) fwd_kernel(Args args) {
    extern __shared__ __attribute__((aligned(16))) unsigned char lds[];
    LAS unsigned char* ldsl = (LAS unsigned char*)lds;
    const int tid = threadIdx.x, lane = tid & 63, wave = __builtin_amdgcn_readfirstlane(tid >> 6);
    const int G = gridDim.x, blk = blockIdx.x;
    const int gw = blk * NWAVES + wave, NGW = G * NWAVES;
    unsigned char* ws = args.ws;
    const float* x = args.in[0]; const float* p_in = args.in[1]; const float* g_mix = args.in[2]; const float* w_in = args.in[3]; const float* g_gv = args.in[4];
    const float* w_spatial = args.in[5]; const float* b_spatial = args.in[6]; const float* w_gproj = args.in[7]; const float* g_cq = args.in[8]; const float* w_uq = args.in[9];
    const float* g_ckv = args.in[10]; const float* w_ukv = args.in[11]; const float* w_mla_o = args.in[12]; const float* w_out = args.in[13]; const float* g_moe = args.in[14];
    const float* w_router_g = args.in[15]; const float* b_router_g = args.in[16]; const float* w_router_e = args.in[17]; const float* b_router_e = args.in[18];
    const float* w_e_gate = args.in[19]; const float* w_e_up = args.in[20]; const float* w_e_down = args.in[21]; const float* g_ple = args.in[22];
    const float* w_ple_gate = args.in[23]; const float* w_ple_proj = args.in[24]; const float* g_final = args.in[25];
    float* out = args.out;
    int* ctl = (int*)(ws + WS_CTL); int* chunkcnt = (int*)(ws + WS_CHUNKCNT); u32x4* tokinfo = (u32x4*)(ws + WS_TOKINFO);
    int* rowtok = (int*)(ws + WS_ROWTOK); float* roww = (float*)(ws + WS_ROWW);
    float* ropeC = (float*)(ws + WS_ROPEC); float* ropeS = (float*)(ws + WS_ROPES);
    bf16_t* Win_t = (bf16_t*)(ws + WS_WIN); bf16_t* Wgp_t = (bf16_t*)(ws + WS_WGP); bf16_t* Wuq_t = (bf16_t*)(ws + WS_WUQ); bf16_t* Wukv_t = (bf16_t*)(ws + WS_WUKV);
    bf16_t* Wo_t = (bf16_t*)(ws + WS_WO); bf16_t* Wout_t = (bf16_t*)(ws + WS_WOUT); bf16_t* Wr_t = (bf16_t*)(ws + WS_WR); bf16_t* Wpg_t = (bf16_t*)(ws + WS_WPG);
    bf16_t* Wpp_t = (bf16_t*)(ws + WS_WPP); bf16_t* Wsp = (bf16_t*)(ws + WS_WSP); bf16_t* Pb = (bf16_t*)(ws + WS_PB);
    float* vpart = (float*)(ws + WS_VPART); float* cqpart = (float*)(ws + WS_CQPART); float* ckvpart = (float*)(ws + WS_CKVPART); float* rstd3 = (float*)(ws + WS_RSTD3);
    float* rq = (float*)(ws + WS_RQ); float* rkv = (float*)(ws + WS_RKV); float* hpart = (float*)(ws + WS_HPART); float* tokrs = (float*)(ws + WS_TOKRS); float* rowrs = (float*)(ws + WS_ROWRS); bf16_t* H3b = (bf16_t*)(ws + WS_H3B);
    bf16_t* Ub = (bf16_t*)(ws + WS_U); bf16_t* Vb = (bf16_t*)(ws + WS_V); bf16_t* GA = (bf16_t*)(ws + WS_GA); bf16_t* GB = (bf16_t*)(ws + WS_GB);
    bf16_t* CQ = (bf16_t*)(ws + WS_CQ); bf16_t* CKV = (bf16_t*)(ws + WS_CKV); bf16_t* KPE = (bf16_t*)(ws + WS_KPE);
    bf16_t* QN = (bf16_t*)(ws + WS_QN); bf16_t* KN = (bf16_t*)(ws + WS_KN); bf16_t* VV = (bf16_t*)(ws + WS_VV); bf16_t* QR = (bf16_t*)(ws + WS_QR);
    bf16_t* Mb = (bf16_t*)(ws + WS_MB); bf16_t* Wgu_t = (bf16_t*)(ws + WS_WGU); bf16_t* Wd_t = (bf16_t*)(ws + WS_WD); float* LOG = (float*)(ws + WS_LOG);
    bf16_t* HID = (bf16_t*)(ws + WS_HID); bf16_t* YS = (bf16_t*)(ws + WS_YS); bf16_t* H2b = (bf16_t*)(ws + WS_H2B); bf16_t* PP = (bf16_t*)(ws + WS_PP);
    bf16_t* XA = (bf16_t*)out; bf16_t* Yb = (bf16_t*)out; bf16_t* Ob = (bf16_t*)out;

    const int lo = args.ph_lo, hi = args.ph_hi;
#ifndef PHMASK
#define PHMASK 0xFFFFFFFFu
#endif
#define IN(k) (((PHMASK >> (k)) & 1u) && lo <= (k) && (k) < hi)
#ifndef CG_SEAM0
#define CG_SEAM0 0
#endif
#ifdef PROBE_LO
#define STAMP(k) do { if (blk == 0 && tid == 0) ((unsigned long long*)(ws + 4096))[(k)] = __builtin_amdgcn_s_memrealtime(); } while (0)
#else
#define STAMP(k) do { } while (0)
#endif
#define SEAM(k) do { if (IN(k) && (IN((k) + 1) || ((k) == 6 && IN(8)))) { if (CG_SEAM0 && (k) == 0) { __threadfence(); cg::this_grid().sync(); } else xcd_barrier(bar); } STAMP((k) + 1); } while (0)
    volatile LAS unsigned* bst = (volatile LAS unsigned*)(ldsl + LDS_BYTES - 16);
    if (tid < 4) bst[tid] = 0u;
    __syncthreads();
    XcdBarrier bar; bar.bar = (unsigned*)(ws + WS_BAR); bar.x = 0; bar.st = nullptr;
    if (hi - lo > 1) bar = xcd_barrier_post((unsigned*)(ws + WS_BAR), bst);

    STAMP(0);
    if (IN(0)) {
        LAS float* scr = (LAS float*)(ldsl + wave * 16384);
        transpose_job(w_in, DM, 5824, nullptr, Win_t, MAP_WIN, scr, gw, NGW, lane);
        if (G != 256) {
        transpose_job(w_gproj, GWID, DM, nullptr, Wgp_t, MAP_ID, scr, gw, NGW, lane);
        transpose_job(w_uq, QL, 1536, g_cq, Wuq_t, MAP_WUQ, scr, gw, NGW, lane);
        transpose_job(w_ukv, KVL, 2048, g_ckv, Wukv_t, MAP_ID, scr, gw, NGW, lane);
        transpose_job(w_mla_o, DM, DM, nullptr, Wo_t, MAP_ID, scr, gw, NGW, lane);
        transpose_job(w_out, DM, DM, nullptr, Wout_t, MAP_ID, scr, gw, NGW, lane);
        transpose_job(w_ple_gate, DM, DM, g_ple, Wpg_t, MAP_ID, scr, gw, NGW, lane);
        transpose_job(w_ple_proj, PLE, DM, nullptr, Wpp_t, MAP_ID, scr, gw, NGW, lane);
        }
        for (int m = gw; m < MROWS; m += 4 * NGW) rms_rows_to_bf16<4>(x, g_mix, XA, m, NGW, lane);
        const int gt = blk * NTHREADS + tid, NGT = G * NTHREADS;
        for (int i = gt; i < 64 * DM; i += NGT) Win_t[(size_t)SEG_PAD * DM + i] = 0;
        for (int i = gt; i < 256 * DM; i += NGT) { const int n = i >> 10, k = i & 1023; float v = 0.f;
            if (n < 8) v = w_router_g[k * 8 + n] * g_moe[k]; else if (n < 72) v = w_router_e[k * 64 + (n - 8)] * g_moe[k];
            Wr_t[i] = (bf16_t)(cvtpk(v, 0.f) & 0xffffu); }
        for (int i = gt; i < 12 * 128 * 128; i += NGT) { const int t = (i >> 7) & 127, s = i & 127; const float v = ((s >> 6) <= (t >> 6)) ? w_spatial[i] : 0.f; Wsp[i] = (bf16_t)(cvtpk(v, 0.f) & 0xffffu); }
        for (int i = gt; i < NS * 32; i += NGT) { const int s = i >> 5, j = i & 31; const double inv = exp(-(double)j * (1.0 / 32.0) * 9.210340371976184); const double a = (double)s * inv;
            ropeC[i] = (float)cos(a); ropeS[i] = (float)sin(a); }
        if (G != 256) for (int i = gt; i < MROWS * PLE / 4; i += 4 * NGT) { f32x4 v[4];
#pragma unroll
            for (int q = 0; q < 4; ++q) v[q] = __builtin_nontemporal_load((const f32x4*)p_in + i + q * NGT);
#pragma unroll
            for (int q = 0; q < 4; ++q) __builtin_nontemporal_store((u32x2){cvtpk(v[q][0], v[q][1]), cvtpk(v[q][2], v[q][3])}, (u32x2*)Pb + i + q * NGT); }
    }
    SEAM(0);
    if (IN(1)) {
        pg8::SchedDense S; S.init(XA, Win_t, MROWS, ZN, DM, G, blk);
        pg8::EpiZ E{Ub, Vb, GA, GB, CQ, CKV, KPE, vpart, cqpart, ckvpart, ropeC, ropeS};
        pg8::gemm_phase(ldsl, DM, S, E);
        if (G == 256 && blk >= 128) {
            __syncthreads();
            LAS float* scr = (LAS float*)(ldsl + wave * 16384); const int gw2 = (blk - 128) * NWAVES + wave, NGW2 = 128 * NWAVES;
            transpose_job(w_gproj, GWID, DM, nullptr, Wgp_t, MAP_ID, scr, gw2, NGW2, lane);
            transpose_job(w_uq, QL, 1536, g_cq, Wuq_t, MAP_WUQ, scr, gw2, NGW2, lane);
            transpose_job(w_ukv, KVL, 2048, g_ckv, Wukv_t, MAP_ID, scr, gw2, NGW2, lane);
            transpose_job(w_mla_o, DM, DM, nullptr, Wo_t, MAP_ID, scr, gw2, NGW2, lane);
            transpose_job(w_out, DM, DM, nullptr, Wout_t, MAP_ID, scr, gw2, NGW2, lane);
            transpose_job(w_ple_gate, DM, DM, g_ple, Wpg_t, MAP_ID, scr, gw2, NGW2, lane);
            transpose_job(w_ple_proj, PLE, DM, nullptr, Wpp_t, MAP_ID, scr, gw2, NGW2, lane);
        }
    }
    SEAM(1);
    if (IN(2)) { for (int row = blk * NTHREADS + tid; row < MROWS; row += G * NTHREADS) {
            const f32x4* a = (const f32x4*)(cqpart + (size_t)row * 12); const f32x4* b = (const f32x4*)(ckvpart + (size_t)row * 8);
            const f32x4 a0 = a[0], a1 = a[1], a2 = a[2], b0 = b[0], b1 = b[1];
            rq[row] = 1.f / sqrtf((((a0[0] + a0[1]) + (a0[2] + a0[3])) + ((a1[0] + a1[1]) + (a1[2] + a1[3])) + ((a2[0] + a2[1]) + (a2[2] + a2[3]))) * (1.f / QL) + EPS);
            rkv[row] = 1.f / sqrtf((((b0[0] + b0[1]) + (b0[2] + b0[3])) + ((b1[0] + b1[1]) + (b1[2] + b1[3]))) * (1.f / KVL) + EPS); }
        att::spatial_phase((char*)lds, Ub, Vb, vpart, g_gv, Wsp, b_spatial, Yb, G, blk); }
    SEAM(2);
    if (IN(3)) {
#ifndef SUBMASK
#define SUBMASK 7
#endif
        if (SUBMASK & 1) { pg8::SchedDense S; S.init(Yb, Wgp_t, MROWS, DM, GWID, G, blk); pg8::EpiMul E{GA}; pg8::gemm_phase(ldsl, GWID, S, E); }
        __syncthreads();
        if (SUBMASK & 2) { pg8::SchedDense S; S.init(CQ, Wuq_t, MROWS, 1536, QL, G, blk); pg8::EpiQ E{QN, QR, rq, ropeC, ropeS}; pg8::gemm_phase(ldsl, QL, S, E); }
        __syncthreads();
        if (SUBMASK & 4) { pg8::SchedDense S; S.init(CKV, Wukv_t, MROWS, 2048, KVL, G, blk); pg8::EpiKV E{KN, VV, rkv}; pg8::gemm_phase(ldsl, KVL, S, E); }
    }
    SEAM(3);
    if (IN(4)) { att::attn_phase((char*)lds, QN, QR, KN, KPE, VV, Ob, G, blk); }
    SEAM(4);
    if (IN(5)) {
        { pg8::SchedDense S; S.init(Ob, Wo_t, MROWS, DM, DM, G, blk); pg8::EpiMulAdd E{GA, GB}; pg8::gemm_phase(ldsl, DM, S, E); }
    }
    SEAM(5);
    if (IN(6)) { pg8::SchedDense S; S.init(GA, Wout_t, MROWS, DM, DM, G, blk); pg8::EpiRes E{x, Mb, hpart}; pg8::gemm_phase(ldsl, DM, S, E); }
    SEAM(6);
    if (IN(8)) { pg8::SchedRouter S{Mb, Wr_t, G == 256 ? blk : 256}; pg8::EpiRouter E{LOG}; pg8::gemm_phase(ldsl, 512, S, E, DM);
        if (G != 256) for (int c2 = blk; c2 < 256; c2 += G) { __syncthreads(); pg8::SchedRouter S2{Mb, Wr_t, c2}; pg8::gemm_phase(ldsl, 512, S2, E, DM); } }
    SEAM(8);
    if (IN(9)) {
        LAS int* hist = (LAS int*)ldsl;
        for (int chunk = blk; chunk < MROWS / 128; chunk += G) {
            __syncthreads();
            if (tid < 64) hist[tid] = 0;
            __syncthreads();
            if (tid < 128) {
                const int tok = chunk * 128 + tid; const float* lg = LOG + (size_t)tok * 72; const float* lg2 = lg + (size_t)MROWS * 72;
                float rs;
                { const f32x4* hp = (const f32x4*)(hpart + (size_t)tok * 32); float ss = 0.f;
#pragma unroll
                  for (int i = 0; i < 8; ++i) { const f32x4 v = hp[i]; ss += (v[0] + v[1]) + (v[2] + v[3]); }
                  rs = 1.f / sqrtf(ss * (1.f / DM) + EPS); tokrs[tok] = rs; }
                float gl[8]; float gm = -1e30f;
#pragma unroll
                for (int i = 0; i < 8; ++i) { gl[i] = (lg[i] + lg2[i]) * rs; gm = fmaxf(gm, gl[i]); }
                float gs = 0.f;
#pragma unroll
                for (int i = 0; i < 8; ++i) { gl[i] = expf(gl[i] - gm); gs += gl[i]; }
                int gi = 0; float gbest = -1e30f, gw_ = 0.f;
#pragma unroll
                for (int i = 0; i < 8; ++i) { const float pr = gl[i] / gs; const float sc_ = pr + b_router_g[i]; if (sc_ > gbest) { gbest = sc_; gi = i; gw_ = pr; } }
                float el[8]; float em = -1e30f;
#pragma unroll
                for (int i = 0; i < 8; ++i) { el[i] = (lg[8 + gi * 8 + i] + lg2[8 + gi * 8 + i]) * rs; em = fmaxf(em, el[i]); }
                float es = 0.f;
#pragma unroll
                for (int i = 0; i < 8; ++i) { el[i] = expf(el[i] - em); es += el[i]; }
                int i0 = 0, i1 = 0; float s0 = -1e30f, s1 = -1e30f, p0 = 0.f, p1 = 0.f;
#pragma unroll
                for (int i = 0; i < 8; ++i) { const float pr = el[i] / es; const float sc_ = pr + b_router_e[gi * 8 + i];
                    if (sc_ > s0) { s1 = s0; i1 = i0; p1 = p0; s0 = sc_; i0 = i; p0 = pr; } else if (sc_ > s1) { s1 = sc_; i1 = i; p1 = pr; } }
                const float den = p0 + p1; const float w0 = gw_ * (p0 / den), w1 = gw_ * (p1 / den);
                const int e0 = gi * 8 + i0, e1 = gi * 8 + i1;
                const int r0 = __hip_atomic_fetch_add(&hist[e0], 1, __ATOMIC_RELAXED, __HIP_MEMORY_SCOPE_WORKGROUP);
                const int r1 = __hip_atomic_fetch_add(&hist[e1], 1, __ATOMIC_RELAXED, __HIP_MEMORY_SCOPE_WORKGROUP);
                tokinfo[tok] = (u32x4){(unsigned)(e0 | (r0 << 8)), (unsigned)(e1 | (r1 << 8)), __float_as_uint(w0), __float_as_uint(w1)};
            }
            __syncthreads();
            if (tid < 64) chunkcnt[chunk * 64 + tid] = hist[tid];
        }
    }
    SEAM(9);
    if (IN(10)) {
        LAS int* cn = (LAS int*)ldsl;
        LAS int* part = cn + 256 * 64; LAS int* tot = part + 8 * 64; LAS int* base = tot + 64; LAS int* cbase = base + 64;
        for (int i = tid; i < 256 * 64 / 4; i += NTHREADS) ((LAS u32x4*)cn)[i] = ((const u32x4*)chunkcnt)[i];
        __syncthreads();
        { const int e = tid & 63, p8 = tid >> 6; int s2 = 0; for (int c = p8 * 32; c < p8 * 32 + 32; ++c) s2 += cn[c * 64 + e]; part[p8 * 64 + e] = s2; }
        __syncthreads();
        if (tid < 64) { int s2 = 0; for (int p8 = 0; p8 < 8; ++p8) s2 += part[p8 * 64 + tid]; tot[tid] = s2; }
        __syncthreads();
        if (tid == 0) { int acc = 0; for (int e = 0; e < 64; ++e) { base[e] = acc; acc += (tot[e] + 255) & ~255; }
            if (blk == 0) { ctl[0] = acc >> 8; int rt = 0; for (int e = 0; e < 64; ++e) { const int n = (tot[e] + 255) >> 8; for (int i = 0; i < n; ++i) ctl[16 + rt++] = e; } } }
        __syncthreads();
        for (int e = blk; e < 64; e += G) { const int b0 = base[e] + tot[e], b1 = base[e] + ((tot[e] + 255) & ~255); for (int s2 = b0 + tid; s2 < b1; s2 += NTHREADS) { rowtok[s2] = -1; roww[s2] = 0.f; rowrs[s2] = 0.f; } }
        for (int chunk = blk; chunk < MROWS / 128; chunk += G) {
            __syncthreads();
            if (tid < 64) { int s2 = 0; const int pf = chunk >> 5; for (int p8 = 0; p8 < pf; ++p8) s2 += part[p8 * 64 + tid]; for (int c = pf * 32; c < chunk; ++c) s2 += cn[c * 64 + tid]; cbase[tid] = s2; }
            __syncthreads();
            if (tid < 128) { const int tok = chunk * 128 + tid; const u32x4 ti = tokinfo[tok];
                const int e0 = ti.x & 255, r0 = ti.x >> 8, e1 = ti.y & 255, r1 = ti.y >> 8;
                const int s0 = base[e0] + cbase[e0] + r0, s1 = base[e1] + cbase[e1] + r1;
                const float rs = tokrs[tok]; rowrs[s0] = rs; rowrs[s1] = rs;
                rowtok[s0] = tok * 2; roww[s0] = __uint_as_float(ti.z); rowtok[s1] = tok * 2 + 1; roww[s1] = __uint_as_float(ti.w); }
        }
    }
    if (IN(10)) {
        __syncthreads();
        LAS float* scr = (LAS float*)(ldsl + wave * 16384);
        for (int it = gw; it < NEXP * 128; it += NGW) { const int e = it >> 7, sub = it & 127;
            transpose_item(w_e_gate + (size_t)e * DM * DEXP, DM, DEXP, g_moe, Wgu_t + (size_t)e * 512 * DM, MAP_GATE, scr, sub, lane);
            transpose_item(w_e_up + (size_t)e * DM * DEXP, DM, DEXP, g_moe, Wgu_t + (size_t)e * 512 * DM, MAP_UP, scr, sub, lane);
            transpose_item(w_e_down + (size_t)e * DEXP * DM, DEXP, DM, nullptr, Wd_t + (size_t)e * DM * DEXP, MAP_ID, scr, sub, lane); }
    }
    SEAM(10);
    if (IN(11)) {
        LAS int* te_l = (LAS int*)(ldsl + 131072); LAS int* rt_l = te_l + 512;
        const int ntl = ctl[0];
        for (int i = tid; i < ntl; i += NTHREADS) te_l[i] = ctl[16 + i];
        for (int i = 0; i < 12; ++i) { int L = i * G + blk, ro_ = 0; if (G == 256 && i >= 2) { L = (i == 2 && blk < 2 * (2 * ntl - 512)) ? 512 + (blk >> 1) : 2 * ntl; ro_ = (blk & 1) * 128; }
            if (L < 2 * ntl && tid < 256) rt_l[i * 256 + tid] = rowtok[(L >> 1) * 256 + ((tid + ro_) & 255)]; }
        __syncthreads();
        pg8::SchedGU S{Mb, rt_l, Wgu_t, te_l, ntl, G, blk}; pg8::EpiGU E{HID, rowrs}; pg8::gemm_phase<pg8::EpiGU, pg8::SchedGU, true>(ldsl, DM, S, E);
        if (G == 256) {
            int nh = 2 * (2 * ctl[0] - 512); nh = nh < 0 ? 0 : (nh > 192 ? 0 : nh);
            if (blk >= nh) { const int NT2 = (256 - nh) * NTHREADS;
                for (int i = (blk - nh) * NTHREADS + tid; i < MROWS * PLE / 4; i += 4 * NT2) { f32x4 v[4];
#pragma unroll
                    for (int q = 0; q < 4; ++q) if (i + q * NT2 < MROWS * PLE / 4) v[q] = __builtin_nontemporal_load((const f32x4*)p_in + i + q * NT2);
#pragma unroll
                    for (int q = 0; q < 4; ++q) if (i + q * NT2 < MROWS * PLE / 4) __builtin_nontemporal_store((u32x2){cvtpk(v[q][0], v[q][1]), cvtpk(v[q][2], v[q][3])}, (u32x2*)Pb + i + q * NT2); } } } }
    SEAM(11);
    if (IN(12)) {
        LAS int* te_l = (LAS int*)(ldsl + 131072);
        const int ntl = ctl[0];
        for (int i = tid; i < ntl; i += NTHREADS) te_l[i] = ctl[16 + i];
        __syncthreads();
        pg8::SchedDown S{HID, Wd_t, te_l, ntl, G, blk}; pg8::EpiDown E{YS, rowtok, roww}; pg8::gemm_phase<pg8::EpiDown, pg8::SchedDown, true>(ldsl, DEXP, S, E); }
    SEAM(12);
    if (IN(13)) {
        for (int m0 = gw; m0 < MROWS; m0 += 2 * NGW) {
            u32x2 hv[2][4], y0[2][4], y1[2][4];
#pragma unroll
            for (int r = 0; r < 2; ++r) { const int m = m0 + r * NGW;
#pragma unroll
                for (int j = 0; j < 4; ++j) { hv[r][j] = __builtin_nontemporal_load((const u32x2*)(Mb + (size_t)m * DM) + lane + 64 * j); y0[r][j] = __builtin_nontemporal_load((const u32x2*)(YS + (size_t)m * DM) + lane + 64 * j); y1[r][j] = __builtin_nontemporal_load((const u32x2*)(YS + ((size_t)MROWS + m) * DM) + lane + 64 * j); } }
#pragma unroll
            for (int r = 0; r < 2; ++r) { const int m = m0 + r * NGW; float s = 0.f;
#pragma unroll
                for (int j = 0; j < 4; ++j) { const u32x2 h = hv[r][j], a = y0[r][j], b = y1[r][j];
                    const float v0 = bflo(h.x) + bflo(a.x) + bflo(b.x), v1 = bfhi(h.x) + bfhi(a.x) + bfhi(b.x), v2 = bflo(h.y) + bflo(a.y) + bflo(b.y), v3 = bfhi(h.y) + bfhi(a.y) + bfhi(b.y);
                    ((u32x2*)(H2b + (size_t)m * DM))[lane + 64 * j] = (u32x2){cvtpk(v0, v1), cvtpk(v2, v3)};
                    s += (v0 * v0 + v1 * v1) + (v2 * v2 + v3 * v3); }
                s = wave_sum(s);
                if (lane == 0) rstd3[m] = 1.f / sqrtf(s * (1.f / DM) + EPS); }
        }
    }
    SEAM(13);
    if (IN(14)) {
        { pg8::SchedDense S; S.init(Pb, Wpp_t, MROWS, DM, PLE, G, blk); pg8::EpiPP E{PP}; pg8::gemm_phase(ldsl, PLE, S, E); }
        __syncthreads();
        { pg8::SchedDense S; S.init(H2b, Wpg_t, MROWS, DM, DM, G, blk); pg8::EpiPLE E{H2b, H3b, PP, rstd3}; pg8::gemm_phase(ldsl, DM, S, E); }
    }
    SEAM(14);
    if (IN(15)) {
        f32x4 gf[4];
#pragma unroll
        for (int j = 0; j < 4; ++j) gf[j] = ((const f32x4*)g_final)[lane + 64 * j];
        for (int m0 = gw; m0 < MROWS; m0 += 4 * NGW) {
            u32x2 hv[4][4];
#pragma unroll
            for (int r = 0; r < 4; ++r)
#pragma unroll
                for (int j = 0; j < 4; ++j) hv[r][j] = __builtin_nontemporal_load((const u32x2*)(H3b + (size_t)(m0 + r * NGW) * DM) + lane + 64 * j);
#pragma unroll
            for (int r = 0; r < 4; ++r) { float s = 0.f; f32x4 v[4];
#pragma unroll
                for (int j = 0; j < 4; ++j) { v[j] = (f32x4){bflo(hv[r][j].x), bfhi(hv[r][j].x), bflo(hv[r][j].y), bfhi(hv[r][j].y)}; s += (v[j][0] * v[j][0] + v[j][1] * v[j][1]) + (v[j][2] * v[j][2] + v[j][3] * v[j][3]); }
                const float rstd = 1.f / sqrtf(wave_sum(s) * (1.f / DM) + EPS);
                f32x4* orow = (f32x4*)(out + (size_t)(m0 + r * NGW) * DM) + lane;
#pragma unroll
                for (int j = 0; j < 4; ++j) __builtin_nontemporal_store(v[j] * rstd * gf[j], orow + 64 * j); }
        }
    }
#ifdef PROBE_LO
    if (blk == 0 && tid == 0) {
        const unsigned long long tend = __builtin_amdgcn_s_memrealtime();
        volatile unsigned long long* st = (volatile unsigned long long*)(ws + 4096);
        const unsigned long long t1 = (PROBE_HI >= 16) ? tend : st[PROBE_HI];
        const unsigned long long span = (t1 - st[PROBE_LO]) * PROBE_MULT;
        while (__builtin_amdgcn_s_memrealtime() - tend < span) __builtin_amdgcn_s_sleep(8);
    }
#endif
#undef IN
#undef SEAM
}

extern "C" void kernel_launch(void* const* d_in, const int* in_sizes, int n_in, void* d_out, int out_size, void* d_ws, size_t ws_size, hipStream_t stream) {
    static int grid = 0;
    if (grid == 0) {
        if (n_in != 26 || out_size != MROWS * DM || ws_size < WS_END) { fprintf(stderr, "kernel_launch: unexpected shapes (n_in %d out %d ws %zu)\n", n_in, out_size, ws_size); grid = -1; return; }
        int dev = 0, cus = 0, per_cu = 0;
        (void)hipGetDevice(&dev); (void)hipDeviceGetAttribute(&cus, hipDeviceAttributeMultiprocessorCount, dev);
        if (hipFuncSetAttribute((const void*)fwd_kernel, hipFuncAttributeMaxDynamicSharedMemorySize, LDS_BYTES) != hipSuccess) { fprintf(stderr, "kernel_launch: hipFuncSetAttribute failed\n"); grid = -1; return; }
        if (hipOccupancyMaxActiveBlocksPerMultiprocessor(&per_cu, (const void*)fwd_kernel, NTHREADS, LDS_BYTES) != hipSuccess || per_cu < 1) { fprintf(stderr, "kernel_launch: occupancy query says %d\n", per_cu); per_cu = 1; }
        (void)hipGetLastError();
        grid = cus > 0 ? cus : 256;
    }
    if (grid < 0) return;
    Args a{};
    for (int i = 0; i < 26; ++i) a.in[i] = (const float*)d_in[i];
    a.out = (float*)d_out; a.ws = (unsigned char*)d_ws;
    if (hipMemsetAsync((char*)d_ws + WS_BAR, 0, BAR_ZERO_BYTES, stream) != hipSuccess) { fprintf(stderr, "kernel_launch: memset failed\n"); return; }
#if MK_N_LAUNCHES == 1
    a.ph_lo = 0; a.ph_hi = NPHASE;
    void* params[] = {&a};
    hipError_t e = hipLaunchCooperativeKernel((const void*)fwd_kernel, dim3(grid), dim3(NTHREADS), params, LDS_BYTES, stream);
    if (e != hipSuccess) fprintf(stderr, "kernel_launch: cooperative launch failed: %s\n", hipGetErrorString(e));
#else
    for (int ph = 0; ph < 16; ++ph) { a.ph_lo = ph; a.ph_hi = ph + 1; hipLaunchKernelGGL(fwd_kernel, dim3(grid), dim3(NTHREADS), LDS_BYTES, stream, a); }
#endif
}
```
